# Optimizing an MI355X kernel written in HIP

```python
import math
import jax, jax.numpy as jnp
from jax import lax
import numpy as np

D_MODEL = 2048
BATCH = 32
SEQ = 256
DEPTH = 4
DEC_BATCH = 2
DEC_SEQ = 1024
PAST_LEN = 512

GRID_W = 64
N_MIXERS = 2
N_GDN = (DEPTH + 1) // 2
N_POOL = DEPTH // 2
GDN_HEADS = 16
GDN_DK = 128
GDN_DV = 128
GDN_QK = GDN_HEADS * GDN_DK
GDN_VW = GDN_HEADS * GDN_DV
GDN_PROJ = 2 * GDN_QK + 2 * GDN_VW + 4 * GDN_HEADS
CONV_K = 5
CONV_PAD = CONV_K // 2
CHUNK = 64
POOL_WINDOWS = (2, 4, 8, 16)
POOL_GROUP = D_MODEL // len(POOL_WINDOWS)
D_FF = 128 * ((8 * D_MODEL // 3 + 127) // 128)
N_MOD = 9
RMS_EPS = 1e-6
L2_EPS = 1e-6
POS_BASE = 10000.0

kernel_name = 'hybrid_gdn_pool_macaron_diffusion_step'


def rmsnorm(x, g):
    xf = x.astype(jnp.float32)
    y = xf * lax.rsqrt(jnp.mean(xf * xf, axis=-1, keepdims=True) + RMS_EPS)
    return (y * g.astype(jnp.float32)).astype(x.dtype)


def mod_norm(x, mod, s, g):
    return rmsnorm(x, g) * (1 + mod[:, :, 3 * s + 1]) + mod[:, :, 3 * s]


def grid_pos_embed(n_tok, dtype):
    rows = n_tok // GRID_W
    idx = jnp.arange(rows * GRID_W)
    r = (idx // GRID_W).astype(jnp.float32)
    col = (idx % GRID_W).astype(jnp.float32)
    n_freq = D_MODEL // 4
    freqs = jnp.exp(-math.log(POS_BASE) * jnp.arange(n_freq, dtype=jnp.float32) / n_freq)
    ar = r[:, None] * freqs
    ac = col[:, None] * freqs
    return jnp.concatenate([jnp.sin(ar), jnp.cos(ar), jnp.sin(ac), jnp.cos(ac)], axis=-1).astype(dtype)


def swiglu(h, w_in, w_out):
    gu = jnp.einsum('btd,df->btf', h, w_in)
    gate, up = jnp.split(gu, 2, axis=-1)
    return jnp.einsum('btf,fd->btd', jax.nn.silu(gate) * up, w_out)


def centred_short_conv(u, w):
    t = u.shape[1]
    up = jnp.pad(u, ((0, 0), (CONV_PAD, CONV_PAD), (0, 0)))
    acc = up[:, 0:t] * w[0]
    for j in range(1, CONV_K):
        acc = acc + up[:, j:j + t] * w[j]
    return jax.nn.silu(acc)


def l2norm(x):
    return x * lax.rsqrt(jnp.sum(x * x, axis=-1, keepdims=True) + L2_EPS)


def gated_delta_chunked(q, k, v, g, beta, s0):
    b, t, h, _ = q.shape
    dv = v.shape[-1]
    n = t // CHUNK

    def blk(a):
        a = a.reshape((b, n, CHUNK, h) + a.shape[3:])
        return jnp.moveaxis(a, 3, 1)

    q, k, v, g, beta = blk(q), blk(k), blk(v), blk(g), blk(beta)
    gam = jnp.cumsum(g, axis=-1)
    diff = gam[..., :, None] - gam[..., None, :]
    idx = jnp.arange(CHUNK)
    incl = idx[:, None] >= idx[None, :]
    strict = idx[:, None] > idx[None, :]
    dec_incl = jnp.exp(jnp.where(incl, diff, -jnp.inf))
    dec_strict = jnp.where(strict, dec_incl, 0.0)
    a_kk = beta[..., None] * jnp.einsum('bhncd,bhnsd->bhncs', k, k) * dec_strict
    rhs_w = k * (beta * jnp.exp(gam))[..., None]
    rhs_u = v * beta[..., None]
    w_mat = lax.linalg.triangular_solve(a_kk, rhs_w, left_side=True, lower=True, unit_diagonal=True)
    u_mat = lax.linalg.triangular_solve(a_kk, rhs_u, left_side=True, lower=True, unit_diagonal=True)
    a_qk = jnp.einsum('bhncd,bhnsd->bhncs', q, k) * dec_incl
    q_g = q * jnp.exp(gam)[..., None]
    k_d = k * jnp.exp(gam[..., -1:] - gam)[..., None]
    c_dec = jnp.exp(gam[..., -1])
    xs = tuple(jnp.moveaxis(a, 2, 0) for a in (w_mat, u_mat, a_qk, q_g, k_d, c_dec))

    def step(s, inp):
        w_c, u_c, aqk_c, qg_c, kd_c, dec_c = inp
        v_new = u_c - jnp.einsum('bhcd,bhde->bhce', w_c, s)
        o_c = jnp.einsum('bhcd,bhde->bhce', qg_c, s) + jnp.einsum('bhcs,bhse->bhce', aqk_c, v_new)
        s = s * dec_c[..., None, None] + jnp.einsum('bhcd,bhce->bhde', kd_c, v_new)
        return s, o_c

    s_fin, o = lax.scan(step, s0, xs)
    o = jnp.transpose(o, (1, 0, 3, 2, 4)).reshape(b, t, h, dv)
    return o, s_fin


def gdn_mixer(h, s0, w_in, conv_w, a_log, dt_bias, norm_g, w_out):
    b, t, _ = h.shape
    f32 = jnp.float32
    proj = jnp.einsum('btd,dp->btp', h, w_in)
    qkv = centred_short_conv(proj[..., :2 * GDN_QK + GDN_VW], conv_w).astype(f32)
    q = l2norm(qkv[..., :GDN_QK].reshape(b, t, GDN_HEADS, GDN_DK)) * (GDN_DK ** -0.5)
    k = l2norm(qkv[..., GDN_QK:2 * GDN_QK].reshape(b, t, GDN_HEADS, GDN_DK))
    v = qkv[..., 2 * GDN_QK:].reshape(b, t, GDN_HEADS, GDN_DV)
    z = proj[..., 2 * GDN_QK + GDN_VW:2 * GDN_QK + 2 * GDN_VW].astype(f32).reshape(b, t, GDN_HEADS, GDN_DV)
    ab = proj[..., 2 * GDN_QK + 2 * GDN_VW:].astype(f32).reshape(b, t, 2, 2, GDN_HEADS)
    g = -jnp.exp(a_log.astype(f32)) * jax.nn.softplus(ab[..., 0, :] + dt_bias.astype(f32))
    beta = jax.nn.sigmoid(ab[..., 1, :])
    s0 = s0.astype(f32)
    o_f, s_f = gated_delta_chunked(q, k, v, g[:, :, 0], beta[:, :, 0], s0[:, 0])
    fl = lambda a: jnp.flip(a, axis=1)
    o_b, s_b = gated_delta_chunked(fl(q), fl(k), fl(v), fl(g[:, :, 1]), fl(beta[:, :, 1]), s0[:, 1])
    o = o_f + fl(o_b)
    o = o * lax.rsqrt(jnp.mean(o * o, axis=-1, keepdims=True) + RMS_EPS) * norm_g.astype(f32) * jax.nn.silu(z)
    out = jnp.einsum('btv,vd->btd', o.reshape(b, t, GDN_VW).astype(h.dtype), w_out)
    return out, jnp.stack([s_f, s_b], axis=1)


def pool_mixer(h, w, scale):
    b, t, _ = h.shape
    hf = h.astype(jnp.float32)
    cs = jnp.concatenate([jnp.zeros((b, 1, D_MODEL), jnp.float32), jnp.cumsum(hf, axis=1)], axis=1)
    pos = jnp.arange(t)
    outs = []
    for gi, win in enumerate(POOL_WINDOWS):
        lo = jnp.maximum(pos - win // 2, 0)
        hi = jnp.minimum(pos + win - win // 2, t)
        sl = slice(gi * POOL_GROUP, (gi + 1) * POOL_GROUP)
        csg = cs[..., sl]
        mean = (jnp.take(csg, hi, axis=1) - jnp.take(csg, lo, axis=1)) / (hi - lo).astype(jnp.float32)[None, :, None]
        outs.append(jnp.einsum('btc,cd->btd', (mean - hf[..., sl]).astype(h.dtype), w[gi]))
    return jnp.concatenate(outs, axis=-1) * scale


def setup_inputs(seed: int = 0) -> dict:
    key = jax.random.key(seed)
    ks = jax.random.split(key, 24)
    nrm = lambda k, shape, s: jax.random.normal(k, shape, jnp.float32) * s
    dt = jnp.exp(jax.random.uniform(ks[13], (N_GDN, 2, GDN_HEADS), jnp.float32, math.log(0.001), math.log(0.1)))
    return {
        'x_prompt': nrm(ks[0], (BATCH, SEQ, D_MODEL), 1.0),
        'x_sample': nrm(ks[1], (DEC_BATCH, DEC_SEQ, D_MODEL), 1.0),
        'state_gdn': nrm(ks[2], (DEC_BATCH, N_GDN, 2, GDN_HEADS, GDN_DK, GDN_DV), 0.5),
        'c': nrm(ks[3], (DEC_BATCH, D_MODEL), 1.0),
        'c_ctx': nrm(ks[4], (D_MODEL,), 1.0),
        'w_mod': nrm(ks[5], (DEPTH, D_MODEL, N_MOD * D_MODEL), 0.5 * D_MODEL ** -0.5),
        'b_mod': nrm(ks[6], (DEPTH, N_MOD * D_MODEL), 0.01),
        'norm_g': 1.0 + nrm(ks[7], (DEPTH, 3, D_MODEL), 0.02),
        'ffn_w_in': nrm(ks[8], (DEPTH, 2, D_MODEL, 2 * D_FF), D_MODEL ** -0.5),
        'ffn_w_out': nrm(ks[9], (DEPTH, 2, D_FF, D_MODEL), D_FF ** -0.5),
        'gdn_w_in': nrm(ks[10], (N_GDN, D_MODEL, GDN_PROJ), D_MODEL ** -0.5),
        'gdn_conv': nrm(ks[11], (N_GDN, CONV_K, 2 * GDN_QK + GDN_VW), CONV_K ** -0.5),
        'gdn_a_log': jnp.log(jax.random.uniform(ks[12], (N_GDN, 2, GDN_HEADS), jnp.float32, 1.0, 16.0)),
        'gdn_dt_bias': dt + jnp.log(-jnp.expm1(-dt)),
        'gdn_norm_g': 1.0 + nrm(ks[14], (N_GDN, GDN_DV), 0.02),
        'gdn_w_out': nrm(ks[15], (N_GDN, GDN_VW, D_MODEL), GDN_VW ** -0.5),
        'pool_w': nrm(ks[16], (N_POOL, len(POOL_WINDOWS), POOL_GROUP, POOL_GROUP), POOL_GROUP ** -0.5),
        'pool_scale': 1.0 + nrm(ks[17], (N_POOL, D_MODEL), 0.02),
        'final_g': 1.0 + nrm(ks[18], (D_MODEL,), 0.02),
    }


def reference(x_prompt, x_sample, state_gdn, c, c_ctx, w_mod, b_mod, norm_g, ffn_w_in, ffn_w_out,
              gdn_w_in, gdn_conv, gdn_a_log, gdn_dt_bias, gdn_norm_g, gdn_w_out, pool_w, pool_scale, final_g):
    xp = x_prompt
    xs = x_sample + grid_pos_embed(x_sample.shape[1], x_sample.dtype)[None]
    sc = jax.nn.silu(c)
    sctx = jax.nn.silu(c_ctx)[None]
    new_states = []
    for l in range(DEPTH):
        mp = (sctx @ w_mod[l] + b_mod[l]).reshape(1, 1, N_MOD, D_MODEL)
        ms = (sc @ w_mod[l] + b_mod[l]).reshape(-1, 1, N_MOD, D_MODEL)
        xp = xp + 0.5 * mp[:, :, 2] * swiglu(mod_norm(xp, mp, 0, norm_g[l, 0]), ffn_w_in[l, 0], ffn_w_out[l, 0])
        xs = xs + 0.5 * ms[:, :, 2] * swiglu(mod_norm(xs, ms, 0, norm_g[l, 0]), ffn_w_in[l, 0], ffn_w_out[l, 0])
        hp = mod_norm(xp, mp, 1, norm_g[l, 1])
        hs = mod_norm(xs, ms, 1, norm_g[l, 1])
        mi = l // N_MIXERS
        if l % N_MIXERS == 0:
            gw = (gdn_w_in[mi], gdn_conv[mi], gdn_a_log[mi], gdn_dt_bias[mi], gdn_norm_g[mi], gdn_w_out[mi])
            s_zero = jnp.zeros((xp.shape[0], 2, GDN_HEADS, GDN_DK, GDN_DV), jnp.float32)
            op, sp = gdn_mixer(hp, s_zero, *gw)
            os_, _ = gdn_mixer(hs, state_gdn[:, mi], *gw)
            new_states.append(sp)
        else:
            op = pool_mixer(hp, pool_w[mi], pool_scale[mi])
            os_ = pool_mixer(hs, pool_w[mi], pool_scale[mi])
        xp = xp + mp[:, :, 5] * op
        xs = xs + ms[:, :, 5] * os_
        xp = xp + 0.5 * mp[:, :, 8] * swiglu(mod_norm(xp, mp, 2, norm_g[l, 2]), ffn_w_in[l, 1], ffn_w_out[l, 1])
        xs = xs + 0.5 * ms[:, :, 8] * swiglu(mod_norm(xs, ms, 2, norm_g[l, 2]), ffn_w_in[l, 1], ffn_w_out[l, 1])
    y_prompt = rmsnorm(xp, final_g)
    y_sample = rmsnorm(xs, final_g)
    new_state_gdn = jnp.stack(new_states, axis=1).astype(state_gdn.dtype)
    return (y_prompt, y_sample, new_state_gdn)
```

```cpp
#include <hip/hip_runtime.h>
#include <cstdio>
#include <cstdint>

#define GAS __attribute__((address_space(1)))
#define LAS __attribute__((address_space(3)))
typedef unsigned short bf16_t;
typedef short bf16x8 __attribute__((ext_vector_type(8)));
typedef short bf16x4 __attribute__((ext_vector_type(4)));
typedef float f32x4 __attribute__((ext_vector_type(4)));
typedef float f32x2 __attribute__((ext_vector_type(2)));
typedef unsigned u32x4 __attribute__((ext_vector_type(4)));
typedef unsigned u32x2 __attribute__((ext_vector_type(2)));

constexpr int D = 2048, NCTX = 8192, NLAT = 2048, MTOK = 10240, DEPTH = 4, DFF = 5504, NGU = 11008;
constexpr int NPROJ = 8256, NPROJ_PAD = 8448, NMOD = 9, NQKV = 6144, NMODC = NMOD * D;
constexpr int SEQ = 256, DSEQ = 1024, NB = 32, NDB = 2, HEADS = 16, DKV = 128, CHUNK = 64;
constexpr float RMS_EPS = 1e-6f, L2_EPS = 1e-6f;

constexpr size_t MiB = 1u << 20;
constexpr size_t WS_CTL = 0, CTL_ZERO_BYTES = 1 * MiB;
constexpr size_t WS_MODP = 1 * MiB;
constexpr size_t WS_MODS = 8 * MiB;
constexpr size_t WS_RSTD = 9 * MiB;
constexpr size_t WS_GG = 10 * MiB;
constexpr size_t WS_GB = 12 * MiB;
constexpr size_t WS_AB = 14 * MiB;
constexpr size_t WS_BT1 = 32 * MiB;
constexpr size_t SZ_BT1 = (size_t)NGU * D * 2;
constexpr size_t WS_BT2 = WS_BT1 + 8 * SZ_BT1;
constexpr size_t SZ_BT2 = (size_t)D * DFF * 2;
constexpr size_t WS_BTG = WS_BT2 + 8 * SZ_BT2;
constexpr size_t SZ_BTG = (size_t)NPROJ_PAD * D * 2;
constexpr size_t WS_BTO = WS_BTG + 2 * SZ_BTG;
constexpr size_t SZ_BTO = (size_t)D * D * 2;
constexpr size_t WS_BTP = WS_BTO + 2 * SZ_BTO;
constexpr size_t SZ_BTP = (size_t)D * 512 * 2;
constexpr size_t WS_X = ((WS_BTP + 2 * SZ_BTP + MiB - 1) / MiB) * MiB;
constexpr size_t WS_H = WS_X + (size_t)MTOK * D * 4;
constexpr size_t WS_ACT = WS_H + (size_t)MTOK * D * 2;
constexpr size_t WS_P = WS_ACT + (size_t)MTOK * DFF * 2;
constexpr size_t WS_QKV = WS_P + (size_t)MTOK * 8192 * 2;
constexpr size_t WS_O = WS_QKV + (size_t)MTOK * NQKV * 2;
constexpr size_t WS_END = WS_O + (size_t)2 * MTOK * D * 4;

constexpr int LDS_BYTES = 163840;
constexpr int MISC_OFF = 163328;
constexpr int NWAVES = 8;

#define LDS_WAIT() asm volatile("s_waitcnt lgkmcnt(0)" ::: "memory")
#define VM_WAIT() asm volatile("s_waitcnt vmcnt(0)" ::: "memory")
typedef __bf16 bf16x2_t __attribute__((ext_vector_type(2)));
__device__ __forceinline__ unsigned cvt_pk_bf16(float lo, float hi) { const f32x2 v = {lo, hi}; const bf16x2_t b = __builtin_convertvector(v, bf16x2_t); return __builtin_bit_cast(unsigned, b); }
__device__ __forceinline__ float bf_lo(unsigned u) { return __uint_as_float(u << 16); }
__device__ __forceinline__ float bf_hi(unsigned u) { return __uint_as_float(u & 0xffff0000u); }
__device__ __forceinline__ float fast_exp(float x) { return __builtin_amdgcn_exp2f(x * 1.44269504089f); }
__device__ __forceinline__ float silu_f(float x) { return x * __builtin_amdgcn_rcpf(1.0f + fast_exp(-x)); }
__device__ __forceinline__ float wave_sum(float v) {
#pragma unroll
    for (int o = 1; o < 64; o <<= 1) v += __shfl_xor(v, o);
    return v;
}

#define XB_TMO      128
#define XB_XCNT(j)  (256  + 64 * (j))
#define XB_XSUB(j)  (1280 + 64 * (j))
#define XB_XGEN(j)  (2304 + 64 * (j))
#define XB_TOP      3328
#define XB_TOPGEN   3392
#define XCD_BAR_WORDS 3456
#define XB_SPIN_CAP (1u << 20)

__device__ __forceinline__ unsigned xb_ld(unsigned* p)              { return __hip_atomic_load(p, __ATOMIC_RELAXED, __HIP_MEMORY_SCOPE_AGENT); }
__device__ __forceinline__ unsigned xb_add(unsigned* p, unsigned v) { return __hip_atomic_fetch_add(p, v, __ATOMIC_RELAXED, __HIP_MEMORY_SCOPE_AGENT); }
__device__ __forceinline__ unsigned xb_xcc_id() { return (unsigned)__builtin_amdgcn_s_getreg((3 << 11) | 20) & 0xFu; }
#define XB_SPIN(cond, bar) do { unsigned _sp = 0; while (cond) { __builtin_amdgcn_s_sleep(1); \
    if ((++_sp & 255u) == 0u) { if (xb_ld(&(bar)[XB_TMO])) break; if (_sp > XB_SPIN_CAP) { atomicAdd(&(bar)[XB_TMO], 1u); break; } } } } while (0)

struct XcdBarrier { unsigned* bar; unsigned x; volatile LAS unsigned* st; };

__device__ __forceinline__ XcdBarrier xcd_barrier_post(unsigned* bar, volatile LAS unsigned* st) {
    XcdBarrier b; b.bar = bar; b.x = xb_xcc_id(); b.st = st;
    if (threadIdx.x == 0) (void)xb_add(&bar[XB_XCNT(b.x)], 1u);
    return b;
}
__device__ __forceinline__ void xcd_barrier_complete(unsigned* bar, unsigned x, unsigned& nloc, unsigned& nx) {
    const unsigned G = gridDim.x * gridDim.y * gridDim.z;
    unsigned sum, cnt, mine, sp = 0u;
    for (;;) {
        sum = 0u; cnt = 0u; mine = 0u;
#pragma unroll
        for (unsigned j = 0; j < 16; ++j) { const unsigned c = xb_ld(&bar[XB_XCNT(j)]); sum += c; cnt += (c > 0u) ? 1u : 0u; mine = (j == x) ? c : mine; }
        if (sum == G) break;
        __builtin_amdgcn_s_sleep(1);
        if ((++sp & 255u) == 0u) { if (xb_ld(&bar[XB_TMO])) break; if (sp > XB_SPIN_CAP) { atomicAdd(&bar[XB_TMO], 1u); break; } }
    }
    nloc = mine > 0u ? mine : 1u; nx = cnt > 0u ? cnt : 1u;
}
__device__ __forceinline__ void xcd_barrier(const XcdBarrier& b) {
    asm volatile("s_waitcnt vmcnt(0)" ::: "memory");
    __syncthreads();
    if (threadIdx.x == 0) {
        unsigned* bar = b.bar; unsigned bx = b.x;
        asm volatile("" : "+s"(bar), "+s"(bx));
        __builtin_amdgcn_s_waitcnt(0);
        unsigned nloc = b.st[0], nx = b.st[1];
        if (nloc == 0u) { xcd_barrier_complete(bar, bx, nloc, nx); b.st[0] = nloc; b.st[1] = nx; }
        const unsigned old = xb_add(&bar[XB_XSUB(bx)], 1u);
        const unsigned gen = old / nloc;
        if (old + 1u == (gen + 1u) * nloc) {
            __builtin_amdgcn_fence(__ATOMIC_RELEASE, "agent");
            asm volatile("s_waitcnt vmcnt(0)" ::: "memory");
            const unsigned og = xb_add(&bar[XB_TOP], 1u);
            const unsigned tg = og / nx;
            if (og + 1u == (tg + 1u) * nx) xb_add(&bar[XB_TOPGEN], 1u);
            else XB_SPIN(xb_ld(&bar[XB_TOPGEN]) == tg, bar);
            __builtin_amdgcn_fence(__ATOMIC_ACQUIRE, "agent");
            xb_add(&bar[XB_XGEN(bx)], 1u);
            asm volatile("s_waitcnt vmcnt(0)" ::: "memory");
        } else {
            XB_SPIN(xb_ld(&bar[XB_XGEN(bx)]) == gen, bar);
            __builtin_amdgcn_fence(__ATOMIC_ACQUIRE, "agent");
            asm volatile("s_waitcnt vmcnt(0)" ::: "memory");
        }
    }
    __syncthreads();
}

namespace pg8 {
constexpr int BM = 256, BK = 64, HALF = 128, HTB = HALF * BK * 2, STAGE_BYTES = 8 * HTB, NXCD = 8, WGM = 8;
__device__ __forceinline__ int lds_byte(int r, int c) { const int st = (r >> 4) * 2 + (c >> 5), rr = r & 15, cc = c & 31, ob = rr * 64 + cc * 2; return st * 1024 + (ob ^ (((ob >> 9) & 1) << 5)); }
__device__ __forceinline__ void stage_rc(int b, int& R, int& C) { const int st = b / 1024, sb = b % 1024, swz = sb ^ (((sb >> 9) & 1) << 5); R = (st >> 1) * 16 + swz / 64; C = (st & 1) * 32 + (swz % 64) / 2; }
__device__ __forceinline__ int perm32(int rho) { const int n = rho >> 4, i = rho & 15; return 8 * (i >> 2) + 4 * n + (i & 3); }

struct Unit { int pm, pn, ak; };
struct Gemm { const bf16_t* A; const bf16_t* Bt; int lda, ldb, K; };

struct StaticOrder {
    int nM, nN, nwg, G, c, pool;
    __device__ void init(int nM_, int nN_, int G_, int c_, int pool_) { nM = nM_; nN = nN_; nwg = nM * nN; G = G_; c = c_; pool = pool_; }
    __device__ bool next(int i, Unit& u) const {
        const long L = (long)i * G + c; if (L >= nwg) return false;
        int wgid = (int)L; { const int q = nwg / NXCD, r = nwg % NXCD, xcd = wgid % NXCD, off = wgid / NXCD; wgid = (xcd < r ? xcd * (q + 1) : r * (q + 1) + (xcd - r) * q) + off; }
        const int nig = WGM * nN, gid = wgid / nig, fm = gid * WGM, gsz = (nM - fm) < WGM ? (nM - fm) : WGM;
        u.pm = fm + ((wgid % nig) % gsz); u.pn = (wgid % nig) / gsz; u.ak = pool ? (u.pn >> 1) * 512 : 0; return true;
    }
};

template <class Epi, bool ALIGN_EPI = true>
__device__ __forceinline__ void gemm_phase(LAS unsigned char* lds, const Gemm g, const StaticOrder& S, const Epi& E) {
    int tid = threadIdx.x; asm volatile("" : "+v"(tid)); const int wid = __builtin_amdgcn_readfirstlane(tid >> 6), lane = tid & 63, wr = wid >> 2, wc = wid & 3, fr = lane & 15, fq = lane >> 4;
    const int K = g.K, nt = K / BK;
    unsigned voffA[2], voffB[2];
#pragma unroll
    for (int i = 0; i < 2; ++i) { int R, C; stage_rc(tid * 16 + i * 8192, R, C); const int Rb = Epi::PERM ? ((R & ~31) + perm32(R & 31)) : R;
        voffA[i] = (unsigned)(R * g.lda + C) * 2u; voffB[i] = (unsigned)(Rb * g.ldb + C) * 2u; }
    const size_t kstep = (size_t)(BK * 2);
    const size_t hstepA = (size_t)HALF * g.lda * 2, hstepB = (size_t)HALF * g.ldb * 2;
    const size_t tstepA = 2 * hstepA, tstepB = 2 * hstepB;
    const unsigned ldsw = (unsigned)wid * 1024u;
    const int aoff = lds_byte(wr * 64 + fr, fq * 8), boff = lds_byte(wc * 32 + fr, fq * 8);
#define PG8_SA(b, h) (((b) * 2 + (h)) * HTB)
#define PG8_SB(b, h) ((4 + (b) * 2 + (h)) * HTB)
#define PG8_STAGE(bufoff, gbase, voff) do { _Pragma("unroll") for (int _i = 0; _i < 2; ++_i) \
        __builtin_amdgcn_global_load_lds((const GAS unsigned*)((const char*)(gbase) + (voff)[_i]), (LAS unsigned*)(lds + (bufoff) + ldsw + _i * 8192), 16, 0, 0); } while (0)
#define PG8_LDA(dst, b, h) do { _Pragma("unroll") for (int m = 0; m < 4; ++m) _Pragma("unroll") for (int k = 0; k < 2; ++k) dst[m][k] = *(const LAS bf16x8*)(lds + PG8_SA(b, h) + aoff + m * 2048 + k * 1024); } while (0)
#define PG8_LDB(dst, b, h) do { _Pragma("unroll") for (int n = 0; n < 2; ++n) _Pragma("unroll") for (int k = 0; k < 2; ++k) dst[n][k] = *(const LAS bf16x8*)(lds + PG8_SB(b, h) + boff + n * 2048 + k * 1024); } while (0)
#define PG8_MMA(ai, bj, At, Bt) do { __builtin_amdgcn_s_setprio(1); _Pragma("unroll") for (int m = 0; m < 4; ++m) _Pragma("unroll") for (int n = 0; n < 2; ++n) _Pragma("unroll") for (int k = 0; k < 2; ++k) \
        acc[ai][bj][m][n] = __builtin_amdgcn_mfma_f32_16x16x32_bf16(Bt[n][k], At[m][k], acc[ai][bj][m][n], 0, 0, 0); __builtin_amdgcn_s_setprio(0); } while (0)
#define PG8_WAIT_V(n) asm volatile("s_waitcnt vmcnt(" #n ")" ::: "memory")
#define PG8_WAIT_L(n) asm volatile("s_waitcnt lgkmcnt(" #n ")" ::: "memory")
#define PG8_BAR __builtin_amdgcn_s_barrier()
#define PG8_SCHED __builtin_amdgcn_sched_barrier(0)
    Unit cur, nxt; int ui = 0;
    if (!S.next(0, cur)) return;
    f32x4 acc[2][2][4][2];
#pragma unroll
    for (int a = 0; a < 2; ++a)
#pragma unroll
        for (int b = 0; b < 2; ++b)
#pragma unroll
            for (int m = 0; m < 4; ++m)
#pragma unroll
                for (int n = 0; n < 2; ++n) acc[a][b][m][n] = (f32x4){0.f, 0.f, 0.f, 0.f};
    bf16x8 At[4][2], B0[2][2], B1[2][2];
    const char* cA = (const char*)g.A + (size_t)cur.pm * tstepA + (size_t)cur.ak * 2; const char* cB = (const char*)g.Bt + (size_t)cur.pn * tstepB;
    PG8_STAGE(PG8_SB(0, 0), cB, voffB); PG8_STAGE(PG8_SB(0, 1), cB + hstepB, voffB); PG8_STAGE(PG8_SA(0, 0), cA, voffA); PG8_STAGE(PG8_SA(0, 1), cA + hstepA, voffA);
    if (wr == 1) PG8_BAR;
    PG8_WAIT_V(2); PG8_BAR;
    PG8_STAGE(PG8_SB(1, 0), cB + kstep, voffB); PG8_STAGE(PG8_SA(1, 0), cA + kstep, voffA); PG8_STAGE(PG8_SB(1, 1), cB + hstepB + kstep, voffB);
    PG8_WAIT_V(6); PG8_BAR;
    for (;;) {
        const bool has_next = S.next(ui + 1, nxt);
        const char* nA = has_next ? (const char*)g.A + (size_t)nxt.pm * tstepA + (size_t)nxt.ak * 2 : cA; const char* nB = has_next ? (const char*)g.Bt + (size_t)nxt.pn * tstepB : cB;
        for (int t = 0; t < nt; t += 2) {
            const bool last = (t == nt - 2);
            const char* a1 = cA + (size_t)(t + 1) * kstep;
            const char* a2 = last ? nA : cA + (size_t)(t + 2) * kstep; const char* b2 = last ? nB : cB + (size_t)(t + 2) * kstep;
            const char* a3 = a2 + kstep; const char* b3 = b2 + kstep;
            PG8_LDB(B0, 0, 0); PG8_LDB(B1, 0, 1); PG8_SCHED; PG8_LDA(At, 0, 0); PG8_STAGE(PG8_SA(1, 1), a1 + hstepA, voffA);
            PG8_WAIT_V(8); PG8_WAIT_L(0); PG8_BAR; PG8_MMA(0, 0, At, B0); PG8_MMA(0, 1, At, B1); PG8_BAR; PG8_SCHED;
            PG8_LDA(At, 0, 1); PG8_STAGE(PG8_SB(0, 0), b2, voffB); PG8_STAGE(PG8_SB(0, 1), b2 + hstepB, voffB); PG8_STAGE(PG8_SA(0, 0), a2, voffA);
            PG8_WAIT_V(8); PG8_WAIT_L(0); PG8_BAR; PG8_MMA(1, 0, At, B0); PG8_MMA(1, 1, At, B1); PG8_BAR; PG8_SCHED;
            PG8_LDB(B0, 1, 0); PG8_LDB(B1, 1, 1); PG8_SCHED; PG8_LDA(At, 1, 0); PG8_STAGE(PG8_SA(0, 1), a2 + hstepA, voffA);
            PG8_WAIT_V(8); PG8_WAIT_L(0); PG8_BAR; PG8_MMA(0, 0, At, B0); PG8_MMA(0, 1, At, B1); PG8_BAR; PG8_SCHED;
            PG8_LDA(At, 1, 1); PG8_STAGE(PG8_SB(1, 0), b3, voffB); PG8_STAGE(PG8_SB(1, 1), b3 + hstepB, voffB); PG8_STAGE(PG8_SA(1, 0), a3, voffA);
            PG8_WAIT_V(8); PG8_WAIT_L(0); PG8_BAR; PG8_MMA(1, 0, At, B0); PG8_MMA(1, 1, At, B1); PG8_BAR; PG8_SCHED;
        }
        if constexpr (ALIGN_EPI) { if (wr == 0) PG8_BAR; }
        E(acc, cur, wr, wc, fr, fq);
        if (!has_next) break;
#pragma unroll
        for (int a = 0; a < 2; ++a)
#pragma unroll
            for (int b = 0; b < 2; ++b)
#pragma unroll
                for (int m = 0; m < 4; ++m)
#pragma unroll
                    for (int n = 0; n < 2; ++n) acc[a][b][m][n] = (f32x4){0.f, 0.f, 0.f, 0.f};
        cur = nxt; cA = nA; cB = nB; ++ui;
        if constexpr (ALIGN_EPI) { if (wr == 1) PG8_BAR; }
    }
    PG8_WAIT_V(0);
    if constexpr (!ALIGN_EPI) { if (wr == 0) PG8_BAR; }
    PG8_BAR;
#undef PG8_SA
#undef PG8_SB
#undef PG8_STAGE
#undef PG8_LDA
#undef PG8_LDB
#undef PG8_MMA
#undef PG8_WAIT_V
#undef PG8_WAIT_L
#undef PG8_BAR
#undef PG8_SCHED
}

struct EpiSwiGLU {
    static constexpr bool PERM = true;
    bf16_t* O;
    __device__ __forceinline__ void operator()(const f32x4 (&acc)[2][2][4][2], const Unit& u, int wr, int wc, int fr, int fq) const {
        const int row0 = u.pm * BM + wr * 64 + fr, col0 = u.pn * 128 + wc * 32 + 8 * fq;
#pragma unroll
        for (int ai = 0; ai < 2; ++ai)
#pragma unroll
            for (int m = 0; m < 4; ++m) {
                GAS bf16_t* rowp = (GAS bf16_t*)O + (size_t)(row0 + ai * HALF + m * 16) * DFF + col0;
                float v[8];
#pragma unroll
                for (int n = 0; n < 2; ++n)
#pragma unroll
                    for (int j = 0; j < 4; ++j) { const float gt = acc[ai][0][m][n][j], up = acc[ai][1][m][n][j]; v[n * 4 + j] = silu_f(gt) * up; }
                u32x4 w; w.x = cvt_pk_bf16(v[0], v[1]); w.y = cvt_pk_bf16(v[2], v[3]); w.z = cvt_pk_bf16(v[4], v[5]); w.w = cvt_pk_bf16(v[6], v[7]);
                *(GAS u32x4*)rowp = w;
            }
    }
};
struct EpiResid {
    static constexpr bool PERM = false;
    float* X; const float* gate; const float* ps; float coef;
    __device__ __forceinline__ void operator()(const f32x4 (&acc)[2][2][4][2], const Unit& u, int wr, int wc, int fr, int fq) const {
        const int row0 = u.pm * BM + wr * 64 + fr, col0 = u.pn * BM + wc * 32 + 4 * fq;
        const int grp = u.pm < 32 ? 0 : 1 + ((u.pm - 32) >> 2);
        const GAS float* gp = (const GAS float*)gate + (size_t)grp * NMODC + col0;
        f32x4 bv[2][2];
#pragma unroll
        for (int bj = 0; bj < 2; ++bj)
#pragma unroll
            for (int n = 0; n < 2; ++n) { f32x4 t = *(const GAS f32x4*)(gp + bj * HALF + n * 16) * coef; if (ps) t = t * *(const GAS f32x4*)((const GAS float*)ps + col0 + bj * HALF + n * 16); bv[bj][n] = t; }
#pragma unroll
        for (int ai = 0; ai < 2; ++ai)
#pragma unroll
            for (int m = 0; m < 4; ++m) { GAS float* rowp = (GAS float*)X + (size_t)(row0 + ai * HALF + m * 16) * D + col0;
#pragma unroll
                for (int bj = 0; bj < 2; ++bj)
#pragma unroll
                    for (int n = 0; n < 2; ++n) { const f32x4 x = *(const GAS f32x4*)(rowp + bj * HALF + n * 16); *(GAS f32x4*)(rowp + bj * HALF + n * 16) = x + bv[bj][n] * acc[ai][bj][m][n]; }
                asm volatile("" ::: "memory"); }
    }
};
struct EpiProj {
    static constexpr bool PERM = true;
    bf16_t* P; float* AB;
    __device__ __forceinline__ void operator()(const f32x4 (&acc)[2][2][4][2], const Unit& u, int wr, int wc, int fr, int fq) const {
        const int row0 = u.pm * BM + wr * 64 + fr;
        if (u.pn < 32) {
            const int col0 = u.pn * BM + wc * 32 + 8 * fq;
#pragma unroll
            for (int ai = 0; ai < 2; ++ai)
#pragma unroll
                for (int m = 0; m < 4; ++m) { GAS bf16_t* rowp = (GAS bf16_t*)P + (size_t)(row0 + ai * HALF + m * 16) * 8192 + col0;
#pragma unroll
                    for (int bj = 0; bj < 2; ++bj) { const f32x4 v0 = acc[ai][bj][m][0], v1 = acc[ai][bj][m][1];
                        u32x4 w; w.x = cvt_pk_bf16(v0[0], v0[1]); w.y = cvt_pk_bf16(v0[2], v0[3]); w.z = cvt_pk_bf16(v1[0], v1[1]); w.w = cvt_pk_bf16(v1[2], v1[3]);
                        *(GAS u32x4*)(rowp + bj * HALF) = w; } }
        } else if (wc < 2) {
            const int col0 = wc * 32 + 8 * fq;
#pragma unroll
            for (int ai = 0; ai < 2; ++ai)
#pragma unroll
                for (int m = 0; m < 4; ++m) { GAS float* rowp = (GAS float*)AB + (size_t)(row0 + ai * HALF + m * 16) * 64 + col0;
                    *(GAS f32x4*)rowp = acc[ai][0][m][0]; *(GAS f32x4*)(rowp + 4) = acc[ai][0][m][1]; }
        }
    }
};
}

struct Args {
    const float* x_prompt; const float* x_sample; const float* state_gdn; const float* c; const float* c_ctx;
    const float* w_mod; const float* b_mod; const float* norm_g; const float* ffn_w_in; const float* ffn_w_out;
    const float* gdn_w_in; const float* gdn_conv; const float* gdn_a_log; const float* gdn_dt_bias; const float* gdn_norm_g; const float* gdn_w_out;
    const float* pool_w; const float* pool_scale; const float* final_g;
    float* out; unsigned char* ws;
};

struct Frame {
    LAS unsigned char* lds;
    int tid, lane, wave, vcu, G;
};

#define OPAQUE_FRAME(F) Frame F = F##_in; asm volatile("" : "+v"(F.tid), "+v"(F.lane), "+s"(F.vcu), "+s"(F.wave))
__device__ __forceinline__ void transpose_item(const float* src, int ld_src, int k0, int n0s, bf16_t* dst, int ld_dst, int n0d, LAS float* scr, int lane) {
    const GAS float* sp = (const GAS float*)src + (size_t)k0 * ld_src + n0s + (lane & 31) + (size_t)(lane >> 5) * ld_src;
#pragma unroll 8
    for (int i = 0; i < 32; ++i) { const int kk = 2 * i + (lane >> 5); scr[kk * 33 + (lane & 31)] = sp[(size_t)(2 * i) * ld_src]; }
    LDS_WAIT(); asm volatile("" ::: "memory");
    const int c = lane & 7;
#pragma unroll
    for (int j = 0; j < 4; ++j) { const int n = (lane >> 3) + 8 * j; const LAS float* s = scr + (8 * c) * 33 + n;
        u32x4 o; o.x = cvt_pk_bf16(s[0 * 33], s[1 * 33]); o.y = cvt_pk_bf16(s[2 * 33], s[3 * 33]); o.z = cvt_pk_bf16(s[4 * 33], s[5 * 33]); o.w = cvt_pk_bf16(s[6 * 33], s[7 * 33]);
        *(GAS u32x4*)((GAS bf16_t*)dst + (size_t)(n0d + n) * ld_dst + k0 + 8 * c) = o; }
    LDS_WAIT(); asm volatile("" ::: "memory");
}

__device__ __forceinline__ void sincos_small(float x, float& s, float& c) {
    const float k = rintf(x * 0.636619772367581f);
    float y = fmaf(k, -1.57079637050628662109375f, x); y = fmaf(k, 4.37113882867379e-8f, y);
    const float y2 = y * y;
    float sp = fmaf(y2, 2.7557319e-6f, -1.9841270e-4f); sp = fmaf(sp, y2, 8.3333333e-3f); sp = fmaf(sp, y2, -1.6666667e-1f); sp = fmaf(sp * y2, y, y);
    float cp = fmaf(y2, -2.7557319e-7f, 2.4801587e-5f); cp = fmaf(cp, y2, -1.3888889e-3f); cp = fmaf(cp, y2, 4.1666667e-2f); cp = fmaf(cp, y2, -0.5f); cp = fmaf(cp, y2, 1.0f);
    const int q = ((int)k) & 3;
    s = (q == 0) ? sp : (q == 1) ? cp : (q == 2) ? -sp : -cp;
    c = (q == 0) ? cp : (q == 1) ? -sp : (q == 2) ? -cp : sp;
}

__device__ __forceinline__ void prologue_a(const Frame& F_in, const Args& a) {
    OPAQUE_FRAME(F);
    unsigned char* ws = a.ws;
    LAS float* scr = (LAS float*)(F.lds + F.wave * 8704);
    LAS float* sv = (LAS float*)(F.lds + 69632);
    for (int i = F.tid; i < 3 * D; i += NWAVES * 64) { const int g = i / D, k = i % D; const float v = (g == 0) ? a.c_ctx[k] : a.c[(g - 1) * D + k]; sv[i] = v / (1.0f + expf(-v)); }
    __syncthreads();
    const int gw = F.vcu * NWAVES + F.wave, NGW = F.G * NWAVES;
    for (int t = gw; t < 4 * 72 * 8; t += NGW) {
        const int l = t / 576, rem = t % 576, cb = rem >> 3, ks = rem & 7;
        const GAS float* wp = (const GAS float*)a.w_mod + ((size_t)l * D + ks * 256) * NMODC + cb * 256 + F.lane * 4;
        f32x4 acc0 = {0.f, 0.f, 0.f, 0.f}, acc1 = acc0, acc2 = acc0;
        const LAS float* s0 = sv + ks * 256, *s1 = sv + D + ks * 256, *s2 = sv + 2 * D + ks * 256;
#pragma unroll 8
        for (int k = 0; k < 256; ++k) { const f32x4 w = *(const GAS f32x4*)(wp + (size_t)k * NMODC); acc0 += w * s0[k]; acc1 += w * s1[k]; acc2 += w * s2[k]; }
        GAS float* pp = (GAS float*)(ws + WS_MODP) + ((size_t)(ks * 4 + l) * 3) * NMODC + cb * 256 + F.lane * 4;
        *(GAS f32x4*)pp = acc0; *(GAS f32x4*)(pp + NMODC) = acc1; *(GAS f32x4*)(pp + 2 * NMODC) = acc2;
    }
    for (int m = gw; m < MTOK; m += NGW) {
        GAS f32x4* xo = (GAS f32x4*)(ws + WS_X) + (size_t)m * (D / 4) + F.lane;
        if (m < NCTX) { const GAS f32x4* xi = (const GAS f32x4*)a.x_prompt + (size_t)m * (D / 4) + F.lane;
#pragma unroll
            for (int j = 0; j < 8; ++j) xo[64 * j] = xi[64 * j];
        } else {
            const int tok = (m - NCTX) & (DSEQ - 1); const float rr = (float)(tok >> 6), cc = (float)(tok & 63);
            const GAS f32x4* xi = (const GAS f32x4*)a.x_sample + (size_t)(m - NCTX) * (D / 4) + F.lane;
#pragma unroll
            for (int j = 0; j < 8; ++j) { f32x4 v = xi[64 * j]; const int e0 = 4 * (F.lane + 64 * j), qd = e0 >> 9, f0 = e0 & 511; const float pos = (qd < 2) ? rr : cc;
#pragma unroll
                for (int i = 0; i < 4; ++i) { const float fr = expf(-9.210340371976184f * (float)(f0 + i) * (1.0f / 512.0f)); float s, c; sincos_small(pos * fr, s, c); v[i] += (qd & 1) ? c : s; }
                xo[64 * j] = v; }
        }
    }
    constexpr int I1 = 32 * 344, I2 = 86 * 64, I3 = 32 * 258, I4 = 32 * 64, I5 = 8 * 16;
    constexpr int R1 = 8 * I1, R2 = R1 + 8 * I2, R3 = R2 + 2 * I3, R4 = R3 + 2 * I4, R5 = R4 + 8 * I5, R6 = R5 + 2 * 192;
    for (int it = gw; it < R6; it += NGW) {
        if (it < R1) { const int mt = it / I1, r = it % I1, kb = r / 344, nb = r % 344, n0s = 32 * nb;
            const int n0d = (n0s < DFF) ? 256 * (n0s >> 7) + (n0s & 127) : 256 * ((n0s - DFF) >> 7) + 128 + ((n0s - DFF) & 127);
            transpose_item(a.ffn_w_in + (size_t)mt * D * NGU, NGU, 64 * kb, n0s, (bf16_t*)(ws + WS_BT1 + mt * SZ_BT1), D, n0d, scr, F.lane); }
        else if (it < R2) { const int q = it - R1, mt = q / I2, r = q % I2, kb = r >> 6, nb = r & 63;
            transpose_item(a.ffn_w_out + (size_t)mt * DFF * D, D, 64 * kb, 32 * nb, (bf16_t*)(ws + WS_BT2 + mt * SZ_BT2), DFF, 32 * nb, scr, F.lane); }
        else if (it < R3) { const int q = it - R2, mt = q / I3, r = q % I3, kb = r / 258, nb = r % 258;
            transpose_item(a.gdn_w_in + (size_t)mt * D * NPROJ, NPROJ, 64 * kb, 32 * nb, (bf16_t*)(ws + WS_BTG + mt * SZ_BTG), D, 32 * nb, scr, F.lane); }
        else if (it < R4) { const int q = it - R3, mt = q / I4, r = q % I4, kb = r >> 6, nb = r & 63;
            transpose_item(a.gdn_w_out + (size_t)mt * D * D, D, 64 * kb, 32 * nb, (bf16_t*)(ws + WS_BTO + mt * SZ_BTO), D, 32 * nb, scr, F.lane); }
        else if (it < R5) { const int q = it - R4, mg = q / I5, r = q % I5, kb = r >> 4, nb = r & 15, mi = mg >> 2, gi = mg & 3;
            transpose_item(a.pool_w + (size_t)mg * 512 * 512, 512, 64 * kb, 32 * nb, (bf16_t*)(ws + WS_BTP + mi * SZ_BTP), 512, gi * 512 + 32 * nb, scr, F.lane); }
        else { const int q = it - R5, mi = q / 192, row = NPROJ + q % 192; GAS u32x4* p = (GAS u32x4*)((GAS bf16_t*)(ws + WS_BTG + mi * SZ_BTG) + (size_t)row * D) + F.lane;
#pragma unroll
            for (int j = 0; j < 4; ++j) p[64 * j] = (u32x4){0u, 0u, 0u, 0u}; }
    }
}
__device__ __forceinline__ void prologue_b(const Frame& F_in, const Args& a) {
    OPAQUE_FRAME(F);
    const GAS float* pp = (const GAS float*)(a.ws + WS_MODP); GAS float* mo = (GAS float*)(a.ws + WS_MODS);
    for (int i = F.vcu * 512 + F.tid; i < 4 * 3 * NMODC; i += F.G * 512) {
        const int l = i / (3 * NMODC), n = i % NMODC; float s = a.b_mod[l * NMODC + n];
#pragma unroll
        for (int ks = 0; ks < 8; ++ks) s += pp[(size_t)ks * (4 * 3 * NMODC) + i];
        mo[i] = s;
    }
}

__device__ __forceinline__ void norm_phase(const Frame& F_in, const Args& a, const float* ng, const float* modbase  , int s) {
    OPAQUE_FRAME(F);
    const int gw = F.vcu * NWAVES + F.wave, NGW = F.G * NWAVES;
    const GAS f32x4* g4 = (const GAS f32x4*)ng + F.lane;
    for (int m = gw; m < MTOK; m += NGW) {
        const int grp = m < NCTX ? 0 : 1 + ((m - NCTX) >> 10);
        const GAS f32x4* xr = (const GAS f32x4*)(a.ws + WS_X) + (size_t)m * (D / 4) + F.lane;
        const GAS f32x4* sh = (const GAS f32x4*)((const GAS float*)modbase + (size_t)grp * NMODC + (3 * s) * D) + F.lane;
        const GAS f32x4* sc = sh + D / 4;
        f32x4 v[8]; float ss = 0.f;
#pragma unroll
        for (int j = 0; j < 8; ++j) { v[j] = xr[64 * j]; ss += (v[j].x * v[j].x + v[j].y * v[j].y) + (v[j].z * v[j].z + v[j].w * v[j].w); }
        const float r = 1.0f / sqrtf(wave_sum(ss) * (1.0f / D) + RMS_EPS);
        GAS u32x2* o = (GAS u32x2*)((GAS bf16_t*)(a.ws + WS_H) + (size_t)m * D) + F.lane;
#pragma unroll
        for (int j = 0; j < 8; ++j) { const f32x4 gg = g4[64 * j], s1 = sc[64 * j], s0 = sh[64 * j]; const f32x4 h = (v[j] * r * gg) * (s1 + 1.0f) + s0;
            u32x2 w; w.x = cvt_pk_bf16(h.x, h.y); w.y = cvt_pk_bf16(h.z, h.w); o[64 * j] = w; }
    }
}
__device__ __forceinline__ void final_phase(const Frame& F_in, const Args& a) {
    OPAQUE_FRAME(F);
    const int gw = F.vcu * NWAVES + F.wave, NGW = F.G * NWAVES;
    const GAS f32x4* g4 = (const GAS f32x4*)a.final_g + F.lane;
    for (int m = gw; m < MTOK; m += NGW) {
        const GAS f32x4* xr = (const GAS f32x4*)(a.ws + WS_X) + (size_t)m * (D / 4) + F.lane;
        f32x4 v[8]; float ss = 0.f;
#pragma unroll
        for (int j = 0; j < 8; ++j) { v[j] = xr[64 * j]; ss += (v[j].x * v[j].x + v[j].y * v[j].y) + (v[j].z * v[j].z + v[j].w * v[j].w); }
        const float r = 1.0f / sqrtf(wave_sum(ss) * (1.0f / D) + RMS_EPS);
        GAS f32x4* o = (GAS f32x4*)a.out + (size_t)m * (D / 4) + F.lane;
#pragma unroll
        for (int j = 0; j < 8; ++j) o[64 * j] = v[j] * r * g4[64 * j];
    }
}
__device__ __forceinline__ void rstd_phase(const Frame& F_in, const Args& a) {
    OPAQUE_FRAME(F);
    const int gw = F.vcu * NWAVES + F.wave, NGW = F.G * NWAVES;
    for (int m = gw; m < MTOK; m += NGW) {
        const GAS f32x4* xr = (const GAS f32x4*)(a.ws + WS_X) + (size_t)m * (D / 4) + F.lane;
        float ss = 0.f;
#pragma unroll
        for (int j = 0; j < 8; ++j) { const f32x4 v = xr[64 * j]; ss += (v.x * v.x + v.y * v.y) + (v.z * v.z + v.w * v.w); }
        const float r = 1.0f / sqrtf(wave_sum(ss) * (1.0f / D) + RMS_EPS);
        if (F.lane == 0) __hip_atomic_store((GAS float*)(a.ws + WS_RSTD) + m, r, __ATOMIC_RELAXED, __HIP_MEMORY_SCOPE_AGENT);
    }
}
__device__ __forceinline__ void pool_pre_phase(const Frame& F_in, const Args& a, const float* ng, const float* modbase) {
    OPAQUE_FRAME(F);
    const GAS float* X = (const GAS float*)(a.ws + WS_X); const GAS float* RS = (const GAS float*)(a.ws + WS_RSTD);
    for (int task = F.vcu * 512 + F.tid; task < 640 * 512; task += F.G * 512) {
        const int seg = task >> 9, cq = task & 511, r0 = seg * 16, col = cq * 4, gi = cq >> 7, half = 1 << gi;
        const int s0 = r0 < NCTX ? (r0 & ~(SEQ - 1)) : NCTX + ((r0 - NCTX) & ~(DSEQ - 1));
        const int s1 = s0 + (r0 < NCTX ? SEQ : DSEQ);
        const int grp = r0 < NCTX ? 0 : 1 + ((r0 - NCTX) >> 10);
        const f32x4 gs = *(const GAS f32x4*)((const GAS float*)ng + col) * (*(const GAS f32x4*)((const GAS float*)modbase + (size_t)grp * NMODC + 4 * D + col) + 1.0f);
        int lo = r0 - half; if (lo < s0) lo = s0; int hi = r0 + half; if (hi > s1) hi = s1;
        f32x4 sum = {0.f, 0.f, 0.f, 0.f};
        for (int r = lo; r < hi; ++r) sum += *(const GAS f32x4*)(X + (size_t)r * D + col) * RS[r];
        for (int t = r0; t < r0 + 16; ++t) {
            const f32x4 own = *(const GAS f32x4*)(X + (size_t)t * D + col) * RS[t];
            const float inv = 1.0f / (float)(hi - lo);
            const f32x4 o = gs * (sum * inv - own);
            u32x2 w; w.x = cvt_pk_bf16(o.x, o.y); w.y = cvt_pk_bf16(o.z, o.w);
            *(GAS u32x2*)((GAS bf16_t*)(a.ws + WS_H) + (size_t)t * D + col) = w;
            if (t + half < s1) { sum += *(const GAS f32x4*)(X + (size_t)(t + half) * D + col) * RS[t + half]; ++hi; }
            if (t - half >= s0) { sum -= *(const GAS f32x4*)(X + (size_t)(t - half) * D + col) * RS[t - half]; ++lo; }
        }
    }
}

__device__ __forceinline__ void gdn_prep_phase(const Frame& F_in, const Args& a, int mi) {
    OPAQUE_FRAME(F);
    const GAS bf16_t* P = (const GAS bf16_t*)(a.ws + WS_P); GAS bf16_t* Q = (GAS bf16_t*)(a.ws + WS_QKV);
    const int ch8 = F.tid & 15, rr = F.tid >> 4;
    for (int unit = F.vcu; unit < 160 * 16; unit += F.G) {
        const int blk = unit >> 4, h = unit & 15, r0 = blk * 64;
        const int s0 = r0 < NCTX ? (r0 & ~(SEQ - 1)) : NCTX + ((r0 - NCTX) & ~(DSEQ - 1));
        const int s1 = s0 + (r0 < NCTX ? SEQ : DSEQ);
        if (F.tid < 128) {
            const int c = F.tid & 63, dir = F.tid >> 6, tok = r0 + c;
            const GAS float* ab = (const GAS float*)(a.ws + WS_AB) + (size_t)tok * 64 + dir * 32 + h;
            const float xa = ab[0] + a.gdn_dt_bias[(mi * 2 + dir) * 16 + h], xb = ab[16];
            const float sp = (xa > 20.f) ? xa : log1pf(expf(xa));
            const float g = -expf(a.gdn_a_log[(mi * 2 + dir) * 16 + h]) * sp;
            const float be = 1.0f / (1.0f + expf(-xb));
            __hip_atomic_store((GAS float*)(a.ws + WS_GG) + ((size_t)dir * MTOK + tok) * 16 + h, g, __ATOMIC_RELAXED, __HIP_MEMORY_SCOPE_AGENT);
            __hip_atomic_store((GAS float*)(a.ws + WS_GB) + ((size_t)dir * MTOK + tok) * 16 + h, be, __ATOMIC_RELAXED, __HIP_MEMORY_SCOPE_AGENT);
        }
#pragma unroll 1
        for (int ten = 0; ten < 3; ++ten) {
            const int chan = ten * D + h * DKV + ch8 * 8;
            float w[5][8];
#pragma unroll
            for (int j = 0; j < 5; ++j) { const GAS f32x4* wp = (const GAS f32x4*)((const GAS float*)a.gdn_conv + ((size_t)mi * 5 + j) * NQKV + chan); const f32x4 w0 = wp[0], w1 = wp[1];
                w[j][0] = w0.x; w[j][1] = w0.y; w[j][2] = w0.z; w[j][3] = w0.w; w[j][4] = w1.x; w[j][5] = w1.y; w[j][6] = w1.z; w[j][7] = w1.w; }
#pragma unroll
            for (int ps = 0; ps < 2; ++ps) {
                const int tok = r0 + rr + 32 * ps;
                float acc[8] = {0.f, 0.f, 0.f, 0.f, 0.f, 0.f, 0.f, 0.f};
#pragma unroll
                for (int j = 0; j < 5; ++j) { const int t = tok + j - 2;
                    u32x4 u = {0u, 0u, 0u, 0u}; if (t >= s0 && t < s1) u = *(const GAS u32x4*)(P + (size_t)t * 8192 + chan);
                    acc[0] = fmaf(bf_lo(u.x), w[j][0], acc[0]); acc[1] = fmaf(bf_hi(u.x), w[j][1], acc[1]); acc[2] = fmaf(bf_lo(u.y), w[j][2], acc[2]); acc[3] = fmaf(bf_hi(u.y), w[j][3], acc[3]);
                    acc[4] = fmaf(bf_lo(u.z), w[j][4], acc[4]); acc[5] = fmaf(bf_hi(u.z), w[j][5], acc[5]); acc[6] = fmaf(bf_lo(u.w), w[j][6], acc[6]); acc[7] = fmaf(bf_hi(u.w), w[j][7], acc[7]); }
                float ss = 0.f;
#pragma unroll
                for (int i = 0; i < 8; ++i) { acc[i] = silu_f(acc[i]); ss += acc[i] * acc[i]; }
                if (ten < 2) {
                    ss += __shfl_xor(ss, 1); ss += __shfl_xor(ss, 2); ss += __shfl_xor(ss, 4); ss += __shfl_xor(ss, 8);
                    float sc = 1.0f / sqrtf(ss + L2_EPS); if (ten == 0) sc *= 0.08838834764831845f;
#pragma unroll
                    for (int i = 0; i < 8; ++i) acc[i] *= sc;
                }
                u32x4 o; o.x = cvt_pk_bf16(acc[0], acc[1]); o.y = cvt_pk_bf16(acc[2], acc[3]); o.z = cvt_pk_bf16(acc[4], acc[5]); o.w = cvt_pk_bf16(acc[6], acc[7]);
                *(GAS u32x4*)(Q + (size_t)tok * NQKV + chan) = o;
            }
        }
    }
}
__device__ __forceinline__ void gdn_post_phase(const Frame& F_in, const Args& a, int mi) {
    OPAQUE_FRAME(F);
    const int gw = F.vcu * NWAVES + F.wave, NGW = F.G * NWAVES;
    const GAS float* O0 = (const GAS float*)(a.ws + WS_O); const GAS float* O1 = O0 + (size_t)MTOK * D;
    for (int m = gw; m < MTOK; m += NGW) {
#pragma unroll
        for (int j = 0; j < 8; ++j) {
            const int e0 = 4 * (F.lane + 64 * j);
            const f32x4 o = *(const GAS f32x4*)(O0 + (size_t)m * D + e0) + *(const GAS f32x4*)(O1 + (size_t)m * D + e0);
            float ss = (o.x * o.x + o.y * o.y) + (o.z * o.z + o.w * o.w);
            ss += __shfl_xor(ss, 1); ss += __shfl_xor(ss, 2); ss += __shfl_xor(ss, 4); ss += __shfl_xor(ss, 8); ss += __shfl_xor(ss, 16);
            const float r = 1.0f / sqrtf(ss * (1.0f / DKV) + RMS_EPS);
            const f32x4 ng = *(const GAS f32x4*)((const GAS float*)a.gdn_norm_g + mi * DKV + (e0 & 127));
            const u32x2 zz = *(const GAS u32x2*)((const GAS bf16_t*)(a.ws + WS_P) + (size_t)m * 8192 + NQKV + e0);
            f32x4 v = o * r * ng; v.x *= silu_f(bf_lo(zz.x)); v.y *= silu_f(bf_hi(zz.x)); v.z *= silu_f(bf_lo(zz.y)); v.w *= silu_f(bf_hi(zz.y));
            u32x2 w; w.x = cvt_pk_bf16(v.x, v.y); w.y = cvt_pk_bf16(v.z, v.w);
            *(GAS u32x2*)((GAS bf16_t*)(a.ws + WS_H) + (size_t)m * D + e0) = w;
        }
    }
}

constexpr int SC_Z = 0, SC_Q = 34816, SC_K = 52224, SC_V = 69632, SC_AKK = 88064, SC_TW = 106496, SC_TU = 115712, SC_AQK = 124928, SC_WN = 134144, SC_G = 151552;
__device__ __forceinline__ int off256(int row, int cb) { return row * 272 + cb; }
__device__ __forceinline__ int off128(int row, int cb) { return row * 144 + cb; }
__device__ __forceinline__ bf16x8 ldf256(LAS unsigned char* base, int row0, int ks, int fr, int fq) { return *(const LAS bf16x8*)(base + off256(row0 + fr, 64 * ks + 16 * fq)); }
__device__ __forceinline__ bf16x8 ldf128(LAS unsigned char* base, int row0, int ks, int fr, int fq) { return *(const LAS bf16x8*)(base + off128(row0 + fr, 64 * ks + 16 * fq)); }
__device__ __forceinline__ bf16x8 ldtr256(LAS unsigned char* base, int n0, int ks, int fr, int fq) {
    const int q = fr >> 2, p = fr & 3, r = 32 * ks + 8 * fq + q, cb = 2 * (n0 + 4 * p);
    const bf16x4 lo = __builtin_amdgcn_ds_read_tr16_b64_v4i16((LAS bf16x4*)(base + off256(r, cb)));
    const bf16x4 hi = __builtin_amdgcn_ds_read_tr16_b64_v4i16((LAS bf16x4*)(base + off256(r + 4, cb)));
    return __builtin_shufflevector(lo, hi, 0, 1, 2, 3, 4, 5, 6, 7);
}
#define MFMA16(a, b, c) __builtin_amdgcn_mfma_f32_16x16x32_bf16(a, b, c, 0, 0, 0)

__device__ __forceinline__ void scan_item(const Frame& F, const Args& a, int mi, int islat, int b, int h, int dir) {
    LAS unsigned char* L = F.lds;
    const int w = F.wave; int lane = F.lane; asm volatile("" : "+v"(lane)); const int fr = lane & 15, fq = lane >> 4;
    const int T = islat ? DSEQ : SEQ, t0 = islat ? NCTX + b * DSEQ : b * SEQ, nchunk = T / CHUNK;
    LAS float* gam = (LAS float*)(L + SC_G); LAS float* bet = gam + 64; LAS float* eg = gam + 128; LAS float* edl = gam + 192;
    const GAS bf16_t* Qc = (const GAS bf16_t*)(a.ws + WS_QKV);
    GAS float* Og = (GAS float*)(a.ws + WS_O) + (size_t)dir * MTOK * D;
    f32x4 accz[8];
    if (islat) {
        const GAS float* sp = (const GAS float*)a.state_gdn + ((((size_t)b * 2 + mi) * 2 + dir) * 16 + h) * (DKV * DKV);
#pragma unroll
        for (int dkt = 0; dkt < 8; ++dkt)
#pragma unroll
            for (int r = 0; r < 4; ++r) accz[dkt][r] = sp[(size_t)(16 * dkt + 4 * fq + r) * DKV + 16 * w + fr];
    } else {
#pragma unroll
        for (int dkt = 0; dkt < 8; ++dkt) accz[dkt] = (f32x4){0.f, 0.f, 0.f, 0.f};
    }
#pragma unroll
    for (int dkt = 0; dkt < 8; ++dkt) { u32x2 z; z.x = cvt_pk_bf16(accz[dkt][0], accz[dkt][1]); z.y = cvt_pk_bf16(accz[dkt][2], accz[dkt][3]);
        *(LAS u32x2*)(L + SC_Z + off256(16 * w + fr, 2 * (16 * dkt + 4 * fq))) = z; }

    for (int n = 0; n < nchunk; ++n) {
        LAS unsigned char *bZ = L + SC_Z, *bQ = L + SC_Q, *bK = L + SC_K, *bV = L + SC_V, *bAKK = L + SC_AKK, *bTW = L + SC_TW, *bTU = L + SC_TU, *bAQK = L + SC_AQK, *bWN = L + SC_WN;
        asm volatile("" : "+v"(bZ), "+v"(bQ), "+v"(bK), "+v"(bV), "+v"(bAKK), "+v"(bTW), "+v"(bTU), "+v"(bAQK), "+v"(bWN));
        if (w == 0) {
            const int tok = dir ? t0 + T - 1 - (64 * n + lane) : t0 + 64 * n + lane;
            const float g = ((const GAS float*)(a.ws + WS_GG))[((size_t)dir * MTOK + tok) * 16 + h];
            const float be = ((const GAS float*)(a.ws + WS_GB))[((size_t)dir * MTOK + tok) * 16 + h];
            float cs = g;
#pragma unroll
            for (int o = 1; o < 64; o <<= 1) { const float t = __shfl_up(cs, o); if (lane >= o) cs += t; }
            const float last = __shfl(cs, 63);
            gam[lane] = cs; bet[lane] = be; eg[lane] = fast_exp(cs); edl[lane] = fast_exp(last - cs);
        }
        {
            const int ch8 = F.tid & 15, rr = F.tid >> 4;
#pragma unroll
            for (int ps = 0; ps < 2; ++ps) {
                const int c = rr + 32 * ps; const int tok = dir ? t0 + T - 1 - (64 * n + c) : t0 + 64 * n + c;
                const GAS bf16_t* src = Qc + (size_t)tok * NQKV + h * DKV + ch8 * 8;
                const u32x4 q = *(const GAS u32x4*)src, k = *(const GAS u32x4*)(src + D), v = *(const GAS u32x4*)(src + 2 * D);
                const int o = off256(c, ch8 * 16);
                *(LAS u32x4*)(bQ + o) = q; *(LAS u32x4*)(bK + o) = k; *(LAS u32x4*)(bV + o) = v;
            }
        }
        __syncthreads();
        {
            const int tsel = w >> 2, st = w & 3;
            bf16x8 af[4];
#pragma unroll
            for (int ks = 0; ks < 4; ++ks) af[ks] = ldf256(bK, 16 * st, ks, fr, fq);
            LAS unsigned char* Bsrc = tsel ? bQ : bK;
#pragma unroll
            for (int ct = 0; ct < 4; ++ct) {
                f32x4 acc = {0.f, 0.f, 0.f, 0.f};
                if (ct >= st) {
#pragma unroll
                    for (int ks = 0; ks < 4; ++ks) acc = MFMA16(af[ks], ldf256(Bsrc, 16 * ct, ks, fr, fq), acc);
                }
                const int c = 16 * ct + fr, s0 = 16 * st + 4 * fq;
                const float gc = gam[c], bc = bet[c];
                f32x4 o;
#pragma unroll
                for (int r = 0; r < 4; ++r) { const int s = s0 + r; const float e = fast_exp(gc - gam[s]);
                    o[r] = tsel ? ((c >= s) ? acc[r] * e : 0.f) : ((c > s) ? bc * acc[r] * e : 0.f); }
                if (tsel) { u32x2 wv; wv.x = cvt_pk_bf16(o[0], o[1]); wv.y = cvt_pk_bf16(o[2], o[3]); *(LAS u32x2*)(bAQK + off128(c, 2 * s0)) = wv; }
                else *(LAS f32x4*)(bAKK + c * 256 + s0 * 4) = o;
            }
        }
        __syncthreads();
        if (w == 0) {
            float t[64];
#pragma unroll
            for (int c = 0; c < 64; ++c) {
                float a0 = -*(const LAS float*)(bAKK + c * 256 + lane * 4), a1 = 0.f, a2 = 0.f, a3 = 0.f;
#pragma unroll
                for (int s4 = 0; s4 < c; s4 += 4) {
                    const f32x4 av = *(const LAS f32x4*)(bAKK + c * 256 + s4 * 4);
                    a0 = fmaf(-av.x, t[s4], a0);
                    if (s4 + 1 < c) a1 = fmaf(-av.y, t[s4 + 1], a1);
                    if (s4 + 2 < c) a2 = fmaf(-av.z, t[s4 + 2], a2);
                    if (s4 + 3 < c) a3 = fmaf(-av.w, t[s4 + 3], a3);
                }
                t[c] = (a0 + a1) + (a2 + a3);
            }
            const float fu = bet[lane], fw = fu * eg[lane];
#pragma unroll
            for (int c = 0; c < 64; ++c) {
                *(LAS bf16_t*)(bTW + off128(c, 2 * lane)) = (bf16_t)(cvt_pk_bf16(t[c] * fw, 0.f) & 0xffffu);
                *(LAS bf16_t*)(bTU + off128(c, 2 * lane)) = (bf16_t)(cvt_pk_bf16(t[c] * fu, 0.f) & 0xffffu);
            }
            *(LAS bf16_t*)(bTW + off128(lane, 2 * lane)) = (bf16_t)(cvt_pk_bf16(fw, 0.f) & 0xffffu);
            *(LAS bf16_t*)(bTU + off128(lane, 2 * lane)) = (bf16_t)(cvt_pk_bf16(fu, 0.f) & 0xffffu);
        }
        __syncthreads();
        f32x4 accu[4];
        {
            bf16x8 kt[2], vt[2];
#pragma unroll
            for (int ks = 0; ks < 2; ++ks) { kt[ks] = ldtr256(bK, 16 * w, ks, fr, fq); vt[ks] = ldtr256(bV, 16 * w, ks, fr, fq); }
#pragma unroll
            for (int ct = 0; ct < 4; ++ct) {
                f32x4 aw = {0.f, 0.f, 0.f, 0.f}; accu[ct] = (f32x4){0.f, 0.f, 0.f, 0.f};
#pragma unroll
                for (int ks = 0; ks < 2; ++ks) { aw = MFMA16(kt[ks], ldf128(bTW, 16 * ct, ks, fr, fq), aw); accu[ct] = MFMA16(ldf128(bTU, 16 * ct, ks, fr, fq), vt[ks], accu[ct]); }
                u32x2 wv; wv.x = cvt_pk_bf16(-aw[0], -aw[1]); wv.y = cvt_pk_bf16(-aw[2], -aw[3]);
                *(LAS u32x2*)(bWN + off256(16 * ct + fr, 2 * (16 * w + 4 * fq))) = wv;
            }
        }
        __syncthreads();
        {
            bf16x8 zf[4];
#pragma unroll
            for (int ks = 0; ks < 4; ++ks) zf[ks] = ldf256(bZ, 16 * w, ks, fr, fq);
#pragma unroll
            for (int ct = 0; ct < 4; ++ct) {
#pragma unroll
                for (int ks = 0; ks < 4; ++ks) accu[ct] = MFMA16(ldf256(bWN, 16 * ct, ks, fr, fq), zf[ks], accu[ct]);
                const int c0 = 16 * ct + 4 * fq, dv = 16 * w + fr;
                u32x2 v1, v2; v1.x = cvt_pk_bf16(accu[ct][0], accu[ct][1]); v1.y = cvt_pk_bf16(accu[ct][2], accu[ct][3]);
                v2.x = cvt_pk_bf16(accu[ct][0] * edl[c0], accu[ct][1] * edl[c0 + 1]); v2.y = cvt_pk_bf16(accu[ct][2] * edl[c0 + 2], accu[ct][3] * edl[c0 + 3]);
                *(LAS u32x2*)(bV + off128(dv, 2 * c0)) = v1; *(LAS u32x2*)(bAKK + off128(dv, 2 * c0)) = v2;
            }
            bf16x8 vf[2], vd[2];
#pragma unroll
            for (int ks = 0; ks < 2; ++ks) { vf[ks] = ldf128(bV, 16 * w, ks, fr, fq); vd[ks] = ldf128(bAKK, 16 * w, ks, fr, fq); }
#pragma unroll
            for (int ct = 0; ct < 4; ++ct) {
                f32x4 ao = {0.f, 0.f, 0.f, 0.f};
#pragma unroll
                for (int ks = 0; ks < 4; ++ks) ao = MFMA16(zf[ks], ldf256(bQ, 16 * ct, ks, fr, fq), ao);
                const int c = 16 * ct + fr; ao = ao * eg[c];
#pragma unroll
                for (int ks = 0; ks < 2; ++ks) ao = MFMA16(vf[ks], ldf128(bAQK, 16 * ct, ks, fr, fq), ao);
                const int tok = dir ? t0 + T - 1 - (64 * n + c) : t0 + 64 * n + c;
                *(GAS f32x4*)(Og + (size_t)tok * D + h * DKV + 16 * w + 4 * fq) = ao;
            }
            const float cdec = eg[63];
#pragma unroll
            for (int dkt = 0; dkt < 8; ++dkt) {
                accz[dkt] = accz[dkt] * cdec;
#pragma unroll
                for (int ks = 0; ks < 2; ++ks) accz[dkt] = MFMA16(ldtr256(bK, 16 * dkt, ks, fr, fq), vd[ks], accz[dkt]);
                u32x2 z; z.x = cvt_pk_bf16(accz[dkt][0], accz[dkt][1]); z.y = cvt_pk_bf16(accz[dkt][2], accz[dkt][3]);
                *(LAS u32x2*)(bZ + off256(16 * w + fr, 2 * (16 * dkt + 4 * fq))) = z;
            }
        }
        __syncthreads();
    }
    if (!islat) {
        GAS float* sp = (GAS float*)a.out + (size_t)MTOK * D + ((((size_t)b * 2 + mi) * 2 + dir) * 16 + h) * (DKV * DKV);
#pragma unroll
        for (int dkt = 0; dkt < 8; ++dkt)
#pragma unroll
            for (int r = 0; r < 4; ++r) sp[(size_t)(16 * dkt + 4 * fq + r) * DKV + 16 * w + fr] = accz[dkt][r];
    }
}
__device__ __forceinline__ void gdn_scan_phase(const Frame& F, const Args& a, int mi) {
    const int c = F.vcu;
    const int nit = (F.G == 256) ? (c < 64 ? 2 : 5) : (64 + 1024 - c + F.G - 1) / F.G;
    for (int j = 0; j < nit; ++j) {
        int i;
        if (F.G == 256) i = (c < 64) ? (j == 0 ? c : 64 + c) : 64 + 64 + (c - 64) * 5 + j; else i = c + j * F.G;
        const int islat = i < 64; const int q = islat ? i : i - 64;
        scan_item(F, a, mi, islat, q >> 5, (q >> 1) & 15, q & 1);
    }
}

__global__ void __launch_bounds__(NWAVES * 64, 2) fwd_kernel(Args a) {
    extern __shared__ __attribute__((aligned(16))) unsigned char lds_raw[];
    Frame F;
    F.lds = (LAS unsigned char*)lds_raw;
    F.tid = threadIdx.x; F.lane = F.tid & 63; F.wave = __builtin_amdgcn_readfirstlane(F.tid >> 6);
    F.G = gridDim.x; { const int bx = blockIdx.x; F.vcu = (F.G % 8 == 0) ? (bx % 8) * (F.G / 8) + bx / 8 : bx; }
    volatile LAS unsigned* MISC = (volatile LAS unsigned*)(F.lds + MISC_OFF);
    for (int u = F.tid; u < (LDS_BYTES - MISC_OFF) / 4; u += NWAVES * 64) MISC[u] = 0u;
    __syncthreads();
    unsigned char* ws = a.ws;
    XcdBarrier bar = xcd_barrier_post((unsigned*)(ws + WS_CTL) + 4096, MISC + 8);
#define GRID_BAR() xcd_barrier(bar)
    const float* mods = (const float*)(ws + WS_MODS);

    prologue_a(F, a);
    GRID_BAR();
    prologue_b(F, a);
    GRID_BAR();

    for (int l = 0; l < DEPTH; ++l) {
        const float* modl = mods + (size_t)l * 3 * NMODC;
        const int mi = l >> 1;
        norm_phase(F, a, a.norm_g + (size_t)(l * 3 + 0) * D, modl, 0);
        GRID_BAR();
        { pg8::Gemm g{(const bf16_t*)(ws + WS_H), (const bf16_t*)(ws + WS_BT1 + (size_t)(l * 2 + 0) * SZ_BT1), D, D, D};
          pg8::StaticOrder S; S.init(MTOK / 256, NGU / 256, F.G, (int)blockIdx.x, 0);
          pg8::EpiSwiGLU E{(bf16_t*)(ws + WS_ACT)};
          pg8::gemm_phase<pg8::EpiSwiGLU>(F.lds, g, S, E); }
        GRID_BAR();
        { pg8::Gemm g{(const bf16_t*)(ws + WS_ACT), (const bf16_t*)(ws + WS_BT2 + (size_t)(l * 2 + 0) * SZ_BT2), DFF, DFF, DFF};
          pg8::StaticOrder S; S.init(MTOK / 256, D / 256, F.G, (int)blockIdx.x, 0);
          pg8::EpiResid E{(float*)(ws + WS_X), modl + 2 * D, nullptr, 0.5f};
          pg8::gemm_phase<pg8::EpiResid>(F.lds, g, S, E); }
        GRID_BAR();
        if ((l & 1) == 0) {
            norm_phase(F, a, a.norm_g + (size_t)(l * 3 + 1) * D, modl, 1);
            GRID_BAR();
            { pg8::Gemm g{(const bf16_t*)(ws + WS_H), (const bf16_t*)(ws + WS_BTG + (size_t)mi * SZ_BTG), D, D, D};
              pg8::StaticOrder S; S.init(MTOK / 256, NPROJ_PAD / 256, F.G, (int)blockIdx.x, 0);
              pg8::EpiProj E{(bf16_t*)(ws + WS_P), (float*)(ws + WS_AB)};
              pg8::gemm_phase<pg8::EpiProj>(F.lds, g, S, E); }
            GRID_BAR();
            gdn_prep_phase(F, a, mi);
            GRID_BAR();
            gdn_scan_phase(F, a, mi);
            GRID_BAR();
            gdn_post_phase(F, a, mi);
            GRID_BAR();
            { pg8::Gemm g{(const bf16_t*)(ws + WS_H), (const bf16_t*)(ws + WS_BTO + (size_t)mi * SZ_BTO), D, D, D};
              pg8::StaticOrder S; S.init(MTOK / 256, D / 256, F.G, (int)blockIdx.x, 0);
              pg8::EpiResid E{(float*)(ws + WS_X), modl + 5 * D, nullptr, 1.0f};
              pg8::gemm_phase<pg8::EpiResid>(F.lds, g, S, E); }
            GRID_BAR();
        } else {
            rstd_phase(F, a);
            GRID_BAR();
            pool_pre_phase(F, a, a.norm_g + (size_t)(l * 3 + 1) * D, modl);
            GRID_BAR();
            { pg8::Gemm g{(const bf16_t*)(ws + WS_H), (const bf16_t*)(ws + WS_BTP + (size_t)mi * SZ_BTP), D, 512, 512};
              pg8::StaticOrder S; S.init(MTOK / 256, D / 256, F.G, (int)blockIdx.x, 1);
              pg8::EpiResid E{(float*)(ws + WS_X), modl + 5 * D, a.pool_scale + (size_t)mi * D, 1.0f};
              pg8::gemm_phase<pg8::EpiResid>(F.lds, g, S, E); }
            GRID_BAR();
        }
        norm_phase(F, a, a.norm_g + (size_t)(l * 3 + 2) * D, modl, 2);
        GRID_BAR();
        { pg8::Gemm g{(const bf16_t*)(ws + WS_H), (const bf16_t*)(ws + WS_BT1 + (size_t)(l * 2 + 1) * SZ_BT1), D, D, D};
          pg8::StaticOrder S; S.init(MTOK / 256, NGU / 256, F.G, (int)blockIdx.x, 0);
          pg8::EpiSwiGLU E{(bf16_t*)(ws + WS_ACT)};
          pg8::gemm_phase<pg8::EpiSwiGLU>(F.lds, g, S, E); }
        GRID_BAR();
        { pg8::Gemm g{(const bf16_t*)(ws + WS_ACT), (const bf16_t*)(ws + WS_BT2 + (size_t)(l * 2 + 1) * SZ_BT2), DFF, DFF, DFF};
          pg8::StaticOrder S; S.init(MTOK / 256, D / 256, F.G, (int)blockIdx.x, 0);
          pg8::EpiResid E{(float*)(ws + WS_X), modl + 8 * D, nullptr, 0.5f};
          pg8::gemm_phase<pg8::EpiResid>(F.lds, g, S, E); }
        GRID_BAR();
    }
    final_phase(F, a);
}

extern "C" void kernel_launch(void* const* d_in, const int* in_sizes, int n_in, void* d_out, int out_size, void* d_ws, size_t ws_size, hipStream_t stream) {
    static int grid = 0;
    if (grid == 0) {
        if (n_in != 19 || ws_size < WS_END) { fprintf(stderr, "kernel_launch: unexpected n_in %d or ws_size %zu (need %zu)\n", n_in, ws_size, (size_t)WS_END); grid = -1; return; }
        int dev = 0, cus = 0, per_cu = 0;
        if (hipGetDevice(&dev) != hipSuccess || hipDeviceGetAttribute(&cus, hipDeviceAttributeMultiprocessorCount, dev) != hipSuccess) { grid = -1; return; }
        if (hipFuncSetAttribute((const void*)fwd_kernel, hipFuncAttributeMaxDynamicSharedMemorySize, LDS_BYTES) != hipSuccess) { fprintf(stderr, "kernel_launch: hipFuncSetAttribute failed\n"); grid = -1; return; }
        if (hipOccupancyMaxActiveBlocksPerMultiprocessor(&per_cu, (const void*)fwd_kernel, NWAVES * 64, LDS_BYTES) != hipSuccess || per_cu < 1) { fprintf(stderr, "kernel_launch: occupancy query says %d\n", per_cu); }
        (void)hipGetLastError();
        grid = cus;
    }
    if (grid < 0) return;
    (void)hipMemsetAsync((char*)d_ws + WS_CTL, 0, CTL_ZERO_BYTES, stream);
    Args a{};
    a.x_prompt = (const float*)d_in[0]; a.x_sample = (const float*)d_in[1]; a.state_gdn = (const float*)d_in[2]; a.c = (const float*)d_in[3]; a.c_ctx = (const float*)d_in[4];
    a.w_mod = (const float*)d_in[5]; a.b_mod = (const float*)d_in[6]; a.norm_g = (const float*)d_in[7]; a.ffn_w_in = (const float*)d_in[8]; a.ffn_w_out = (const float*)d_in[9];
    a.gdn_w_in = (const float*)d_in[10]; a.gdn_conv = (const float*)d_in[11]; a.gdn_a_log = (const float*)d_in[12]; a.gdn_dt_bias = (const float*)d_in[13]; a.gdn_norm_g = (const float*)d_in[14]; a.gdn_w_out = (const float*)d_in[15];
    a.pool_w = (const float*)d_in[16]; a.pool_scale = (const float*)d_in[17]; a.final_g = (const float*)d_in[18];
    a.out = (float*)d_out; a.ws = (unsigned char*)d_ws;
    hipLaunchKernelGGL(fwd_kernel, dim3(grid), dim3(NWAVES * 64), LDS_BYTES, stream, a);
}
```

```cpp
#include <hip/hip_runtime.h>
#include <cstdio>
#include <cstdint>

#define GAS __attribute__((address_space(1)))
#define LAS __attribute__((address_space(3)))
typedef unsigned short bf16_t;
typedef short bf16x8 __attribute__((ext_vector_type(8)));
typedef short bf16x4 __attribute__((ext_vector_type(4)));
typedef float f32x4 __attribute__((ext_vector_type(4)));
typedef float f32x2 __attribute__((ext_vector_type(2)));
typedef unsigned u32x4 __attribute__((ext_vector_type(4)));
typedef unsigned u32x2 __attribute__((ext_vector_type(2)));

constexpr int D = 2048, NCTX = 8192, NLAT = 2048, MTOK = 10240, DEPTH = 4, DFF = 5504, NGU = 11008;
constexpr int NPROJ = 8256, NPROJ_PAD = 8448, NMOD = 9, NQKV = 6144, NMODC = NMOD * D;
constexpr int SEQ = 256, DSEQ = 1024, NB = 32, NDB = 2, HEADS = 16, DKV = 128, CHUNK = 64;
constexpr float RMS_EPS = 1e-6f, L2_EPS = 1e-6f;

constexpr size_t MiB = 1u << 20;
constexpr size_t WS_CTL = 0, CTL_ZERO_BYTES = 1 * MiB;
constexpr size_t WS_MODP = 1 * MiB;
constexpr size_t WS_MODS = 8 * MiB;
constexpr size_t WS_RSTD = 9 * MiB;
constexpr size_t WS_GG = 10 * MiB;
constexpr size_t WS_GB = 12 * MiB;
constexpr size_t WS_AB = 14 * MiB;
constexpr size_t WS_BT1 = 32 * MiB;
constexpr size_t SZ_BT1 = (size_t)NGU * D * 2;
constexpr size_t WS_BT2 = WS_BT1 + 8 * SZ_BT1;
constexpr size_t SZ_BT2 = (size_t)D * DFF * 2;
constexpr size_t WS_BTG = WS_BT2 + 8 * SZ_BT2;
constexpr size_t SZ_BTG = (size_t)NPROJ_PAD * D * 2;
constexpr size_t WS_BTO = WS_BTG + 2 * SZ_BTG;
constexpr size_t SZ_BTO = (size_t)D * D * 2;
constexpr size_t WS_BTP = WS_BTO + 2 * SZ_BTO;
constexpr size_t SZ_BTP = (size_t)D * 512 * 2;
constexpr size_t WS_X = ((WS_BTP + 2 * SZ_BTP + MiB - 1) / MiB) * MiB;
constexpr size_t WS_H = WS_X + (size_t)MTOK * D * 4;
constexpr size_t WS_ACT = WS_H + (size_t)MTOK * D * 2;
constexpr size_t WS_P = WS_ACT + (size_t)MTOK * DFF * 2;
constexpr size_t WS_QKV = WS_P + (size_t)MTOK * 8192 * 2;
constexpr size_t WS_O = WS_QKV + (size_t)MTOK * NQKV * 2;
constexpr size_t WS_END = WS_O + (size_t)2 * MTOK * D * 4;

constexpr int LDS_BYTES = 163840;
constexpr int MISC_OFF = 163328;
constexpr int NWAVES = 8;

#define LDS_WAIT() asm volatile("s_waitcnt lgkmcnt(0)" ::: "memory")
#define VM_WAIT() asm volatile("s_waitcnt vmcnt(0)" ::: "memory")
typedef __bf16 bf16x2_t __attribute__((ext_vector_type(2)));
__device__ __forceinline__ unsigned cvt_pk_bf16(float lo, float hi) { const f32x2 v = {lo, hi}; const bf16x2_t b = __builtin_convertvector(v, bf16x2_t); return __builtin_bit_cast(unsigned, b); }
__device__ __forceinline__ float bf_lo(unsigned u) { return __uint_as_float(u << 16); }
__device__ __forceinline__ float bf_hi(unsigned u) { return __uint_as_float(u & 0xffff0000u); }
__device__ __forceinline__ float fast_exp(float x) { return __builtin_amdgcn_exp2f(x * 1.44269504089f); }
__device__ __forceinline__ float silu_f(float x) { return x * __builtin_amdgcn_rcpf(1.0f + fast_exp(-x)); }
__device__ __forceinline__ float wave_sum(float v) {
#pragma unroll
    for (int o = 1; o < 64; o <<= 1) v += __shfl_xor(v, o);
    return v;
}

#define XB_TMO      128
#define XB_XCNT(j)  (256  + 64 * (j))
#define XB_XSUB(j)  (1280 + 64 * (j))
#define XB_XGEN(j)  (2304 + 64 * (j))
#define XB_TOP      3328
#define XB_TOPGEN   3392
#define XCD_BAR_WORDS 3456
#define XB_SPIN_CAP (1u << 20)

__device__ __forceinline__ unsigned xb_ld(unsigned* p)              { return __hip_atomic_load(p, __ATOMIC_RELAXED, __HIP_MEMORY_SCOPE_AGENT); }
__device__ __forceinline__ unsigned xb_add(unsigned* p, unsigned v) { return __hip_atomic_fetch_add(p, v, __ATOMIC_RELAXED, __HIP_MEMORY_SCOPE_AGENT); }
__device__ __forceinline__ unsigned xb_xcc_id() { return (unsigned)__builtin_amdgcn_s_getreg((3 << 11) | 20) & 0xFu; }
#define XB_SPIN(cond, bar) do { unsigned _sp = 0; while (cond) { __builtin_amdgcn_s_sleep(1); \
    if ((++_sp & 255u) == 0u) { if (xb_ld(&(bar)[XB_TMO])) break; if (_sp > XB_SPIN_CAP) { atomicAdd(&(bar)[XB_TMO], 1u); break; } } } } while (0)

struct XcdBarrier { unsigned* bar; unsigned x; volatile LAS unsigned* st; };

__device__ __forceinline__ XcdBarrier xcd_barrier_post(unsigned* bar, volatile LAS unsigned* st) {
    XcdBarrier b; b.bar = bar; b.x = xb_xcc_id(); b.st = st;
    if (threadIdx.x == 0) (void)xb_add(&bar[XB_XCNT(b.x)], 1u);
    return b;
}
__device__ __forceinline__ void xcd_barrier_complete(unsigned* bar, unsigned x, unsigned& nloc, unsigned& nx) {
    const unsigned G = gridDim.x * gridDim.y * gridDim.z;
    unsigned sum, cnt, mine, sp = 0u;
    for (;;) {
        sum = 0u; cnt = 0u; mine = 0u;
#pragma unroll
        for (unsigned j = 0; j < 16; ++j) { const unsigned c = xb_ld(&bar[XB_XCNT(j)]); sum += c; cnt += (c > 0u) ? 1u : 0u; mine = (j == x) ? c : mine; }
        if (sum == G) break;
        __builtin_amdgcn_s_sleep(1);
        if ((++sp & 255u) == 0u) { if (xb_ld(&bar[XB_TMO])) break; if (sp > XB_SPIN_CAP) { atomicAdd(&bar[XB_TMO], 1u); break; } }
    }
    nloc = mine > 0u ? mine : 1u; nx = cnt > 0u ? cnt : 1u;
}
__device__ __forceinline__ void xcd_barrier(const XcdBarrier& b) {
    asm volatile("s_waitcnt vmcnt(0)" ::: "memory");
    __syncthreads();
    if (threadIdx.x == 0) {
        unsigned* bar = b.bar; unsigned bx = b.x;
        asm volatile("" : "+s"(bar), "+s"(bx));
        __builtin_amdgcn_s_waitcnt(0);
        unsigned nloc = b.st[0], nx = b.st[1];
        if (nloc == 0u) { xcd_barrier_complete(bar, bx, nloc, nx); b.st[0] = nloc; b.st[1] = nx; }
        const unsigned old = xb_add(&bar[XB_XSUB(bx)], 1u);
        const unsigned gen = old / nloc;
        if (old + 1u == (gen + 1u) * nloc) {
            __builtin_amdgcn_fence(__ATOMIC_RELEASE, "agent");
            asm volatile("s_waitcnt vmcnt(0)" ::: "memory");
            const unsigned og = xb_add(&bar[XB_TOP], 1u);
            const unsigned tg = og / nx;
            if (og + 1u == (tg + 1u) * nx) xb_add(&bar[XB_TOPGEN], 1u);
            else XB_SPIN(xb_ld(&bar[XB_TOPGEN]) == tg, bar);
            __builtin_amdgcn_fence(__ATOMIC_ACQUIRE, "agent");
            xb_add(&bar[XB_XGEN(bx)], 1u);
            asm volatile("s_waitcnt vmcnt(0)" ::: "memory");
        } else {
            XB_SPIN(xb_ld(&bar[XB_XGEN(bx)]) == gen, bar);
            __builtin_amdgcn_fence(__ATOMIC_ACQUIRE, "agent");
            asm volatile("s_waitcnt vmcnt(0)" ::: "memory");
        }
    }
    __syncthreads();
}

namespace pg8 {
constexpr int BM = 256, BK = 64, HALF = 128, HTB = HALF * BK * 2, STAGE_BYTES = 8 * HTB, NXCD = 8, WGM = 8;
__device__ __forceinline__ int lds_byte(int r, int c) { const int st = (r >> 4) * 2 + (c >> 5), rr = r & 15, cc = c & 31, ob = rr * 64 + cc * 2; return st * 1024 + (ob ^ (((ob >> 9) & 1) << 5)); }
__device__ __forceinline__ void stage_rc(int b, int& R, int& C) { const int st = b / 1024, sb = b % 1024, swz = sb ^ (((sb >> 9) & 1) << 5); R = (st >> 1) * 16 + swz / 64; C = (st & 1) * 32 + (swz % 64) / 2; }
__device__ __forceinline__ int perm32(int rho) { const int n = rho >> 4, i = rho & 15; return 8 * (i >> 2) + 4 * n + (i & 3); }

struct Unit { int pm, pn, ak; };
struct Gemm { const bf16_t* A; const bf16_t* Bt; int lda, ldb, K; };

struct StaticOrder {
    int nM, nN, nwg, G, c, pool;
    __device__ void init(int nM_, int nN_, int G_, int c_, int pool_) { nM = nM_; nN = nN_; nwg = nM * nN; G = G_; c = c_; pool = pool_; }
    __device__ bool next(int i, Unit& u) const {
        const long L = (long)i * G + c; if (L >= nwg) return false;
        int wgid = (int)L; { const int q = nwg / NXCD, r = nwg % NXCD, xcd = wgid % NXCD, off = wgid / NXCD; wgid = (xcd < r ? xcd * (q + 1) : r * (q + 1) + (xcd - r) * q) + off; }
        const int nig = WGM * nN, gid = wgid / nig, fm = gid * WGM, gsz = (nM - fm) < WGM ? (nM - fm) : WGM;
        u.pm = fm + ((wgid % nig) % gsz); u.pn = (wgid % nig) / gsz; u.ak = pool ? (u.pn >> 1) * 512 : 0; return true;
    }
};

template <class Epi, bool ALIGN_EPI = true>
__device__ __forceinline__ void gemm_phase(LAS unsigned char* lds, const Gemm g, const StaticOrder& S, const Epi& E) {
    int tid = threadIdx.x; asm volatile("" : "+v"(tid)); const int wid = __builtin_amdgcn_readfirstlane(tid >> 6), lane = tid & 63, wr = wid >> 2, wc = wid & 3, fr = lane & 15, fq = lane >> 4;
    const int K = g.K, nt = K / BK;
    unsigned voffA[2], voffB[2];
#pragma unroll
    for (int i = 0; i < 2; ++i) { int R, C; stage_rc(tid * 16 + i * 8192, R, C); const int Rb = Epi::PERM ? ((R & ~31) + perm32(R & 31)) : R;
        voffA[i] = (unsigned)(R * g.lda + C) * 2u; voffB[i] = (unsigned)(Rb * g.ldb + C) * 2u; }
    const size_t kstep = (size_t)(BK * 2);
    const size_t hstepA = (size_t)HALF * g.lda * 2, hstepB = (size_t)HALF * g.ldb * 2;
    const size_t tstepA = 2 * hstepA, tstepB = 2 * hstepB;
    const unsigned ldsw = (unsigned)wid * 1024u;
    const int aoff = lds_byte(wr * 64 + fr, fq * 8), boff = lds_byte(wc * 32 + fr, fq * 8);
#define PG8_SA(b, h) (((b) * 2 + (h)) * HTB)
#define PG8_SB(b, h) ((4 + (b) * 2 + (h)) * HTB)
#define PG8_STAGE(bufoff, gbase, voff) do { _Pragma("unroll") for (int _i = 0; _i < 2; ++_i) \
        __builtin_amdgcn_global_load_lds((const GAS unsigned*)((const char*)(gbase) + (voff)[_i]), (LAS unsigned*)(lds + (bufoff) + ldsw + _i * 8192), 16, 0, 0); } while (0)
#define PG8_LDA(dst, b, h) do { _Pragma("unroll") for (int m = 0; m < 4; ++m) _Pragma("unroll") for (int k = 0; k < 2; ++k) dst[m][k] = *(const LAS bf16x8*)(lds + PG8_SA(b, h) + aoff + m * 2048 + k * 1024); } while (0)
#define PG8_LDB(dst, b, h) do { _Pragma("unroll") for (int n = 0; n < 2; ++n) _Pragma("unroll") for (int k = 0; k < 2; ++k) dst[n][k] = *(const LAS bf16x8*)(lds + PG8_SB(b, h) + boff + n * 2048 + k * 1024); } while (0)
#define PG8_MMA(ai, bj, At, Bt) do { __builtin_amdgcn_s_setprio(1); _Pragma("unroll") for (int m = 0; m < 4; ++m) _Pragma("unroll") for (int n = 0; n < 2; ++n) _Pragma("unroll") for (int k = 0; k < 2; ++k) \
        acc[ai][bj][m][n] = __builtin_amdgcn_mfma_f32_16x16x32_bf16(Bt[n][k], At[m][k], acc[ai][bj][m][n], 0, 0, 0); __builtin_amdgcn_s_setprio(0); } while (0)
#define PG8_WAIT_V(n) asm volatile("s_waitcnt vmcnt(" #n ")" ::: "memory")
#define PG8_WAIT_L(n) asm volatile("s_waitcnt lgkmcnt(" #n ")" ::: "memory")
#define PG8_BAR __builtin_amdgcn_s_barrier()
#define PG8_SCHED __builtin_amdgcn_sched_barrier(0)
    Unit cur, nxt; int ui = 0;
    if (!S.next(0, cur)) return;
    f32x4 acc[2][2][4][2];
#pragma unroll
    for (int a = 0; a < 2; ++a)
#pragma unroll
        for (int b = 0; b < 2; ++b)
#pragma unroll
            for (int m = 0; m < 4; ++m)
#pragma unroll
                for (int n = 0; n < 2; ++n) acc[a][b][m][n] = (f32x4){0.f, 0.f, 0.f, 0.f};
    bf16x8 At[4][2], B0[2][2], B1[2][2];
    const char* cA = (const char*)g.A + (size_t)cur.pm * tstepA + (size_t)cur.ak * 2; const char* cB = (const char*)g.Bt + (size_t)cur.pn * tstepB;
    PG8_STAGE(PG8_SB(0, 0), cB, voffB); PG8_STAGE(PG8_SB(0, 1), cB + hstepB, voffB); PG8_STAGE(PG8_SA(0, 0), cA, voffA); PG8_STAGE(PG8_SA(0, 1), cA + hstepA, voffA);
    if (wr == 1) PG8_BAR;
    PG8_WAIT_V(2); PG8_BAR;
    PG8_STAGE(PG8_SB(1, 0), cB + kstep, voffB); PG8_STAGE(PG8_SA(1, 0), cA + kstep, voffA); PG8_STAGE(PG8_SB(1, 1), cB + hstepB + kstep, voffB);
    PG8_WAIT_V(6); PG8_BAR;
    for (;;) {
        const bool has_next = S.next(ui + 1, nxt);
        const char* nA = has_next ? (const char*)g.A + (size_t)nxt.pm * tstepA + (size_t)nxt.ak * 2 : cA; const char* nB = has_next ? (const char*)g.Bt + (size_t)nxt.pn * tstepB : cB;
        for (int t = 0; t < nt; t += 2) {
            const bool last = (t == nt - 2);
            const char* a1 = cA + (size_t)(t + 1) * kstep;
            const char* a2 = last ? nA : cA + (size_t)(t + 2) * kstep; const char* b2 = last ? nB : cB + (size_t)(t + 2) * kstep;
            const char* a3 = a2 + kstep; const char* b3 = b2 + kstep;
            PG8_LDB(B0, 0, 0); PG8_LDB(B1, 0, 1); PG8_SCHED; PG8_LDA(At, 0, 0); PG8_STAGE(PG8_SA(1, 1), a1 + hstepA, voffA);
            PG8_WAIT_V(8); PG8_WAIT_L(0); PG8_BAR; PG8_MMA(0, 0, At, B0); PG8_MMA(0, 1, At, B1); PG8_BAR; PG8_SCHED;
            PG8_LDA(At, 0, 1); PG8_STAGE(PG8_SB(0, 0), b2, voffB); PG8_STAGE(PG8_SB(0, 1), b2 + hstepB, voffB); PG8_STAGE(PG8_SA(0, 0), a2, voffA);
            PG8_WAIT_V(8); PG8_WAIT_L(0); PG8_BAR; PG8_MMA(1, 0, At, B0); PG8_MMA(1, 1, At, B1); PG8_BAR; PG8_SCHED;
            PG8_LDB(B0, 1, 0); PG8_LDB(B1, 1, 1); PG8_SCHED; PG8_LDA(At, 1, 0); PG8_STAGE(PG8_SA(0, 1), a2 + hstepA, voffA);
            PG8_WAIT_V(8); PG8_WAIT_L(0); PG8_BAR; PG8_MMA(0, 0, At, B0); PG8_MMA(0, 1, At, B1); PG8_BAR; PG8_SCHED;
            PG8_LDA(At, 1, 1); PG8_STAGE(PG8_SB(1, 0), b3, voffB); PG8_STAGE(PG8_SB(1, 1), b3 + hstepB, voffB); PG8_STAGE(PG8_SA(1, 0), a3, voffA);
            PG8_WAIT_V(8); PG8_WAIT_L(0); PG8_BAR; PG8_MMA(1, 0, At, B0); PG8_MMA(1, 1, At, B1); PG8_BAR; PG8_SCHED;
        }
        if constexpr (ALIGN_EPI) { if (wr == 0) PG8_BAR; }
        E(acc, cur, wr, wc, fr, fq);
        if (!has_next) break;
#pragma unroll
        for (int a = 0; a < 2; ++a)
#pragma unroll
            for (int b = 0; b < 2; ++b)
#pragma unroll
                for (int m = 0; m < 4; ++m)
#pragma unroll
                    for (int n = 0; n < 2; ++n) acc[a][b][m][n] = (f32x4){0.f, 0.f, 0.f, 0.f};
        cur = nxt; cA = nA; cB = nB; ++ui;
        if constexpr (ALIGN_EPI) { if (wr == 1) PG8_BAR; }
    }
    PG8_WAIT_V(0);
    if constexpr (!ALIGN_EPI) { if (wr == 0) PG8_BAR; }
    PG8_BAR;
#undef PG8_SA
#undef PG8_SB
#undef PG8_STAGE
#undef PG8_LDA
#undef PG8_LDB
#undef PG8_MMA
#undef PG8_WAIT_V
#undef PG8_WAIT_L
#undef PG8_BAR
#undef PG8_SCHED
}

struct EpiSwiGLU {
    static constexpr bool PERM = true;
    bf16_t* O;
    __device__ __forceinline__ void operator()(const f32x4 (&acc)[2][2][4][2], const Unit& u, int wr, int wc, int fr, int fq) const {
        const int row0 = u.pm * BM + wr * 64 + fr, col0 = u.pn * 128 + wc * 32 + 8 * fq;
#pragma unroll
        for (int ai = 0; ai < 2; ++ai)
#pragma unroll
            for (int m = 0; m < 4; ++m) {
                GAS bf16_t* rowp = (GAS bf16_t*)O + (size_t)(row0 + ai * HALF + m * 16) * DFF + col0;
                float v[8];
#pragma unroll
                for (int n = 0; n < 2; ++n)
#pragma unroll
                    for (int j = 0; j < 4; ++j) { const float gt = acc[ai][0][m][n][j], up = acc[ai][1][m][n][j]; v[n * 4 + j] = silu_f(gt) * up; }
                u32x4 w; w.x = cvt_pk_bf16(v[0], v[1]); w.y = cvt_pk_bf16(v[2], v[3]); w.z = cvt_pk_bf16(v[4], v[5]); w.w = cvt_pk_bf16(v[6], v[7]);
                *(GAS u32x4*)rowp = w;
            }
    }
};
struct EpiResid {
    static constexpr bool PERM = false;
    float* X; const float* gate; const float* ps; float coef;
    __device__ __forceinline__ void operator()(const f32x4 (&acc)[2][2][4][2], const Unit& u, int wr, int wc, int fr, int fq) const {
        const int row0 = u.pm * BM + wr * 64 + fr, col0 = u.pn * BM + wc * 32 + 4 * fq;
        const int grp = u.pm < 32 ? 0 : 1 + ((u.pm - 32) >> 2);
        const GAS float* gp = (const GAS float*)gate + (size_t)grp * NMODC + col0;
        f32x4 bv[2][2];
#pragma unroll
        for (int bj = 0; bj < 2; ++bj)
#pragma unroll
            for (int n = 0; n < 2; ++n) { f32x4 t = *(const GAS f32x4*)(gp + bj * HALF + n * 16) * coef; if (ps) t = t * *(const GAS f32x4*)((const GAS float*)ps + col0 + bj * HALF + n * 16); bv[bj][n] = t; }
#pragma unroll
        for (int ai = 0; ai < 2; ++ai)
#pragma unroll
            for (int m = 0; m < 4; ++m) { GAS float* rowp = (GAS float*)X + (size_t)(row0 + ai * HALF + m * 16) * D + col0;
#pragma unroll
                for (int bj = 0; bj < 2; ++bj)
#pragma unroll
                    for (int n = 0; n < 2; ++n) { const f32x4 x = *(const GAS f32x4*)(rowp + bj * HALF + n * 16); *(GAS f32x4*)(rowp + bj * HALF + n * 16) = x + bv[bj][n] * acc[ai][bj][m][n]; }
                asm volatile("" ::: "memory"); }
    }
};
struct EpiProj {
    static constexpr bool PERM = true;
    bf16_t* P; float* AB;
    __device__ __forceinline__ void operator()(const f32x4 (&acc)[2][2][4][2], const Unit& u, int wr, int wc, int fr, int fq) const {
        const int row0 = u.pm * BM + wr * 64 + fr;
        if (u.pn < 32) {
            const int col0 = u.pn * BM + wc * 32 + 8 * fq;
#pragma unroll
            for (int ai = 0; ai < 2; ++ai)
#pragma unroll
                for (int m = 0; m < 4; ++m) { GAS bf16_t* rowp = (GAS bf16_t*)P + (size_t)(row0 + ai * HALF + m * 16) * 8192 + col0;
#pragma unroll
                    for (int bj = 0; bj < 2; ++bj) { const f32x4 v0 = acc[ai][bj][m][0], v1 = acc[ai][bj][m][1];
                        u32x4 w; w.x = cvt_pk_bf16(v0[0], v0[1]); w.y = cvt_pk_bf16(v0[2], v0[3]); w.z = cvt_pk_bf16(v1[0], v1[1]); w.w = cvt_pk_bf16(v1[2], v1[3]);
                        *(GAS u32x4*)(rowp + bj * HALF) = w; } }
        } else if (wc < 2) {
            const int col0 = wc * 32 + 8 * fq;
#pragma unroll
            for (int ai = 0; ai < 2; ++ai)
#pragma unroll
                for (int m = 0; m < 4; ++m) { GAS float* rowp = (GAS float*)AB + (size_t)(row0 + ai * HALF + m * 16) * 64 + col0;
                    *(GAS f32x4*)rowp = acc[ai][0][m][0]; *(GAS f32x4*)(rowp + 4) = acc[ai][0][m][1]; }
        }
    }
};
}

struct Args {
    const float* x_prompt; const float* x_sample; const float* state_gdn; const float* c; const float* c_ctx;
    const float* w_mod; const float* b_mod; const float* norm_g; const float* ffn_w_in; const float* ffn_w_out;
    const float* gdn_w_in; const float* gdn_conv; const float* gdn_a_log; const float* gdn_dt_bias; const float* gdn_norm_g; const float* gdn_w_out;
    const float* pool_w; const float* pool_scale; const float* final_g;
    float* out; unsigned char* ws;
};

struct Frame {
    LAS unsigned char* lds;
    int tid, lane, wave, vcu, G;
};

#define OPAQUE_FRAME(F) Frame F = F##_in; asm volatile("" : "+v"(F.tid), "+v"(F.lane), "+s"(F.vcu), "+s"(F.wave))
__device__ __forceinline__ void transpose_item(const float* src, int ld_src, int k0, int n0s, bf16_t* dst, int ld_dst, int n0d, LAS float* scr, int lane) {
    const GAS float* sp = (const GAS float*)src + (size_t)k0 * ld_src + n0s + (lane & 31) + (size_t)(lane >> 5) * ld_src;
#pragma unroll 8
    for (int i = 0; i < 32; ++i) { const int kk = 2 * i + (lane >> 5); scr[kk * 33 + (lane & 31)] = sp[(size_t)(2 * i) * ld_src]; }
    LDS_WAIT(); asm volatile("" ::: "memory");
    const int c = lane & 7;
#pragma unroll
    for (int j = 0; j < 4; ++j) { const int n = (lane >> 3) + 8 * j; const LAS float* s = scr + (8 * c) * 33 + n;
        u32x4 o; o.x = cvt_pk_bf16(s[0 * 33], s[1 * 33]); o.y = cvt_pk_bf16(s[2 * 33], s[3 * 33]); o.z = cvt_pk_bf16(s[4 * 33], s[5 * 33]); o.w = cvt_pk_bf16(s[6 * 33], s[7 * 33]);
        *(GAS u32x4*)((GAS bf16_t*)dst + (size_t)(n0d + n) * ld_dst + k0 + 8 * c) = o; }
    LDS_WAIT(); asm volatile("" ::: "memory");
}

__device__ __forceinline__ void sincos_small(float x, float& s, float& c) {
    const float k = rintf(x * 0.636619772367581f);
    float y = fmaf(k, -1.57079637050628662109375f, x); y = fmaf(k, 4.37113882867379e-8f, y);
    const float y2 = y * y;
    float sp = fmaf(y2, 2.7557319e-6f, -1.9841270e-4f); sp = fmaf(sp, y2, 8.3333333e-3f); sp = fmaf(sp, y2, -1.6666667e-1f); sp = fmaf(sp * y2, y, y);
    float cp = fmaf(y2, -2.7557319e-7f, 2.4801587e-5f); cp = fmaf(cp, y2, -1.3888889e-3f); cp = fmaf(cp, y2, 4.1666667e-2f); cp = fmaf(cp, y2, -0.5f); cp = fmaf(cp, y2, 1.0f);
    const int q = ((int)k) & 3;
    s = (q == 0) ? sp : (q == 1) ? cp : (q == 2) ? -sp : -cp;
    c = (q == 0) ? cp : (q == 1) ? -sp : (q == 2) ? -cp : sp;
}

__device__ __forceinline__ void prologue_a(const Frame& F_in, const Args& a) {
    OPAQUE_FRAME(F);
    unsigned char* ws = a.ws;
    LAS float* scr = (LAS float*)(F.lds + F.wave * 8704);
    LAS float* sv = (LAS float*)(F.lds + 69632);
    for (int i = F.tid; i < 3 * D; i += NWAVES * 64) { const int g = i / D, k = i % D; const float v = (g == 0) ? a.c_ctx[k] : a.c[(g - 1) * D + k]; sv[i] = v / (1.0f + expf(-v)); }
    __syncthreads();
    const int gw = F.vcu * NWAVES + F.wave, NGW = F.G * NWAVES;
    for (int t = gw; t < 4 * 72 * 8; t += NGW) {
        const int l = t / 576, rem = t % 576, cb = rem >> 3, ks = rem & 7;
        const GAS float* wp = (const GAS float*)a.w_mod + ((size_t)l * D + ks * 256) * NMODC + cb * 256 + F.lane * 4;
        f32x4 acc0 = {0.f, 0.f, 0.f, 0.f}, acc1 = acc0, acc2 = acc0;
        const LAS float* s0 = sv + ks * 256, *s1 = sv + D + ks * 256, *s2 = sv + 2 * D + ks * 256;
#pragma unroll 8
        for (int k = 0; k < 256; ++k) { const f32x4 w = *(const GAS f32x4*)(wp + (size_t)k * NMODC); acc0 += w * s0[k]; acc1 += w * s1[k]; acc2 += w * s2[k]; }
        GAS float* pp = (GAS float*)(ws + WS_MODP) + ((size_t)(ks * 4 + l) * 3) * NMODC + cb * 256 + F.lane * 4;
        *(GAS f32x4*)pp = acc0; *(GAS f32x4*)(pp + NMODC) = acc1; *(GAS f32x4*)(pp + 2 * NMODC) = acc2;
    }
    for (int m = gw; m < MTOK; m += NGW) {
        GAS f32x4* xo = (GAS f32x4*)(ws + WS_X) + (size_t)m * (D / 4) + F.lane;
        if (m < NCTX) { const GAS f32x4* xi = (const GAS f32x4*)a.x_prompt + (size_t)m * (D / 4) + F.lane;
#pragma unroll
            for (int j = 0; j < 8; ++j) xo[64 * j] = xi[64 * j];
        } else {
            const int tok = (m - NCTX) & (DSEQ - 1); const float rr = (float)(tok >> 6), cc = (float)(tok & 63);
            const GAS f32x4* xi = (const GAS f32x4*)a.x_sample + (size_t)(m - NCTX) * (D / 4) + F.lane;
#pragma unroll
            for (int j = 0; j < 8; ++j) { f32x4 v = xi[64 * j]; const int e0 = 4 * (F.lane + 64 * j), qd = e0 >> 9, f0 = e0 & 511; const float pos = (qd < 2) ? rr : cc;
#pragma unroll
                for (int i = 0; i < 4; ++i) { const float fr = expf(-9.210340371976184f * (float)(f0 + i) * (1.0f / 512.0f)); float s, c; sincos_small(pos * fr, s, c); v[i] += (qd & 1) ? c : s; }
                xo[64 * j] = v; }
        }
    }
    constexpr int I1 = 32 * 344, I2 = 86 * 64, I3 = 32 * 258, I4 = 32 * 64, I5 = 8 * 16;
    constexpr int R1 = 8 * I1, R2 = R1 + 8 * I2, R3 = R2 + 2 * I3, R4 = R3 + 2 * I4, R5 = R4 + 8 * I5, R6 = R5 + 2 * 192;
    for (int it = gw; it < R6; it += NGW) {
        if (it < R1) { const int mt = it / I1, r = it % I1, kb = r / 344, nb = r % 344, n0s = 32 * nb;
            const int n0d = (n0s < DFF) ? 256 * (n0s >> 7) + (n0s & 127) : 256 * ((n0s - DFF) >> 7) + 128 + ((n0s - DFF) & 127);
            transpose_item(a.ffn_w_in + (size_t)mt * D * NGU, NGU, 64 * kb, n0s, (bf16_t*)(ws + WS_BT1 + mt * SZ_BT1), D, n0d, scr, F.lane); }
        else if (it < R2) { const int q = it - R1, mt = q / I2, r = q % I2, kb = r >> 6, nb = r & 63;
            transpose_item(a.ffn_w_out + (size_t)mt * DFF * D, D, 64 * kb, 32 * nb, (bf16_t*)(ws + WS_BT2 + mt * SZ_BT2), DFF, 32 * nb, scr, F.lane); }
        else if (it < R3) { const int q = it - R2, mt = q / I3, r = q % I3, kb = r / 258, nb = r % 258;
            transpose_item(a.gdn_w_in + (size_t)mt * D * NPROJ, NPROJ, 64 * kb, 32 * nb, (bf16_t*)(ws + WS_BTG + mt * SZ_BTG), D, 32 * nb, scr, F.lane); }
        else if (it < R4) { const int q = it - R3, mt = q / I4, r = q % I4, kb = r >> 6, nb = r & 63;
            transpose_item(a.gdn_w_out + (size_t)mt * D * D, D, 64 * kb, 32 * nb, (bf16_t*)(ws + WS_BTO + mt * SZ_BTO), D, 32 * nb, scr, F.lane); }
        else if (it < R5) { const int q = it - R4, mg = q / I5, r = q % I5, kb = r >> 4, nb = r & 15, mi = mg >> 2, gi = mg & 3;
            transpose_item(a.pool_w + (size_t)mg * 512 * 512, 512, 64 * kb, 32 * nb, (bf16_t*)(ws + WS_BTP + mi * SZ_BTP), 512, gi * 512 + 32 * nb, scr, F.lane); }
        else { const int q = it - R5, mi = q / 192, row = NPROJ + q % 192; GAS u32x4* p = (GAS u32x4*)((GAS bf16_t*)(ws + WS_BTG + mi * SZ_BTG) + (size_t)row * D) + F.lane;
#pragma unroll
            for (int j = 0; j < 4; ++j) p[64 * j] = (u32x4){0u, 0u, 0u, 0u}; }
    }
}
__device__ __forceinline__ void prologue_b(const Frame& F_in, const Args& a) {
    OPAQUE_FRAME(F);
    const GAS float* pp = (const GAS float*)(a.ws + WS_MODP); GAS float* mo = (GAS float*)(a.ws + WS_MODS);
    for (int i = F.vcu * 512 + F.tid; i < 4 * 3 * NMODC; i += F.G * 512) {
        const int l = i / (3 * NMODC), n = i % NMODC; float s = a.b_mod[l * NMODC + n];
#pragma unroll
        for (int ks = 0; ks < 8; ++ks) s += pp[(size_t)ks * (4 * 3 * NMODC) + i];
        mo[i] = s;
    }
}

__device__ __forceinline__ void norm_phase(const Frame& F_in, const Args& a, const float* ng, const float* modbase  , int s) {
    OPAQUE_FRAME(F);
    const int gw = F.vcu * NWAVES + F.wave, NGW = F.G * NWAVES;
    const GAS f32x4* g4 = (const GAS f32x4*)ng + F.lane;
    for (int m = gw; m < MTOK; m += NGW) {
        const int grp = m < NCTX ? 0 : 1 + ((m - NCTX) >> 10);
        const GAS f32x4* xr = (const GAS f32x4*)(a.ws + WS_X) + (size_t)m * (D / 4) + F.lane;
        const GAS f32x4* sh = (const GAS f32x4*)((const GAS float*)modbase + (size_t)grp * NMODC + (3 * s) * D) + F.lane;
        const GAS f32x4* sc = sh + D / 4;
        f32x4 v[8]; float ss = 0.f;
#pragma unroll
        for (int j = 0; j < 8; ++j) { v[j] = xr[64 * j]; ss += (v[j].x * v[j].x + v[j].y * v[j].y) + (v[j].z * v[j].z + v[j].w * v[j].w); }
        const float r = 1.0f / sqrtf(wave_sum(ss) * (1.0f / D) + RMS_EPS);
        GAS u32x2* o = (GAS u32x2*)((GAS bf16_t*)(a.ws + WS_H) + (size_t)m * D) + F.lane;
#pragma unroll
        for (int j = 0; j < 8; ++j) { const f32x4 gg = g4[64 * j], s1 = sc[64 * j], s0 = sh[64 * j]; const f32x4 h = (v[j] * r * gg) * (s1 + 1.0f) + s0;
            u32x2 w; w.x = cvt_pk_bf16(h.x, h.y); w.y = cvt_pk_bf16(h.z, h.w); o[64 * j] = w; }
    }
}
__device__ __forceinline__ void final_phase(const Frame& F_in, const Args& a) {
    OPAQUE_FRAME(F);
    const int gw = F.vcu * NWAVES + F.wave, NGW = F.G * NWAVES;
    const GAS f32x4* g4 = (const GAS f32x4*)a.final_g + F.lane;
    for (int m = gw; m < MTOK; m += NGW) {
        const GAS f32x4* xr = (const GAS f32x4*)(a.ws + WS_X) + (size_t)m * (D / 4) + F.lane;
        f32x4 v[8]; float ss = 0.f;
#pragma unroll
        for (int j = 0; j < 8; ++j) { v[j] = xr[64 * j]; ss += (v[j].x * v[j].x + v[j].y * v[j].y) + (v[j].z * v[j].z + v[j].w * v[j].w); }
        const float r = 1.0f / sqrtf(wave_sum(ss) * (1.0f / D) + RMS_EPS);
        GAS f32x4* o = (GAS f32x4*)a.out + (size_t)m * (D / 4) + F.lane;
#pragma unroll
        for (int j = 0; j < 8; ++j) o[64 * j] = v[j] * r * g4[64 * j];
    }
}
__device__ __forceinline__ void rstd_phase(const Frame& F_in, const Args& a) {
    OPAQUE_FRAME(F);
    const int gw = F.vcu * NWAVES + F.wave, NGW = F.G * NWAVES;
    for (int m = gw; m < MTOK; m += NGW) {
        const GAS f32x4* xr = (const GAS f32x4*)(a.ws + WS_X) + (size_t)m * (D / 4) + F.lane;
        float ss = 0.f;
#pragma unroll
        for (int j = 0; j < 8; ++j) { const f32x4 v = xr[64 * j]; ss += (v.x * v.x + v.y * v.y) + (v.z * v.z + v.w * v.w); }
        const float r = 1.0f / sqrtf(wave_sum(ss) * (1.0f / D) + RMS_EPS);
        if (F.lane == 0) __hip_atomic_store((GAS float*)(a.ws + WS_RSTD) + m, r, __ATOMIC_RELAXED, __HIP_MEMORY_SCOPE_AGENT);
    }
}
__device__ __forceinline__ void pool_pre_phase(const Frame& F_in, const Args& a, const float* ng, const float* modbase) {
    OPAQUE_FRAME(F);
    const GAS float* X = (const GAS float*)(a.ws + WS_X); const GAS float* RS = (const GAS float*)(a.ws + WS_RSTD);
    for (int task = F.vcu * 512 + F.tid; task < 640 * 512; task += F.G * 512) {
        const int seg = task >> 9, cq = task & 511, r0 = seg * 16, col = cq * 4, gi = cq >> 7, half = 1 << gi;
        const int s0 = r0 < NCTX ? (r0 & ~(SEQ - 1)) : NCTX + ((r0 - NCTX) & ~(DSEQ - 1));
        const int s1 = s0 + (r0 < NCTX ? SEQ : DSEQ);
        const int grp = r0 < NCTX ? 0 : 1 + ((r0 - NCTX) >> 10);
        const f32x4 gs = *(const GAS f32x4*)((const GAS float*)ng + col) * (*(const GAS f32x4*)((const GAS float*)modbase + (size_t)grp * NMODC + 4 * D + col) + 1.0f);
        int lo = r0 - half; if (lo < s0) lo = s0; int hi = r0 + half; if (hi > s1) hi = s1;
        f32x4 sum = {0.f, 0.f, 0.f, 0.f};
        for (int r = lo; r < hi; ++r) sum += *(const GAS f32x4*)(X + (size_t)r * D + col) * RS[r];
        for (int t = r0; t < r0 + 16; ++t) {
            const f32x4 own = *(const GAS f32x4*)(X + (size_t)t * D + col) * RS[t];
            const float inv = 1.0f / (float)(hi - lo);
            const f32x4 o = gs * (sum * inv - own);
            u32x2 w; w.x = cvt_pk_bf16(o.x, o.y); w.y = cvt_pk_bf16(o.z, o.w);
            *(GAS u32x2*)((GAS bf16_t*)(a.ws + WS_H) + (size_t)t * D + col) = w;
            if (t + half < s1) { sum += *(const GAS f32x4*)(X + (size_t)(t + half) * D + col) * RS[t + half]; ++hi; }
            if (t - half >= s0) { sum -= *(const GAS f32x4*)(X + (size_t)(t - half) * D + col) * RS[t - half]; ++lo; }
        }
    }
}

__device__ __forceinline__ void gdn_prep_phase(const Frame& F_in, const Args& a, int mi) {
    OPAQUE_FRAME(F);
    const GAS bf16_t* P = (const GAS bf16_t*)(a.ws + WS_P); GAS bf16_t* Q = (GAS bf16_t*)(a.ws + WS_QKV);
    const int ch8 = F.tid & 15, rr = F.tid >> 4;
    for (int unit = F.vcu; unit < 160 * 16; unit += F.G) {
        const int blk = unit >> 4, h = unit & 15, r0 = blk * 64;
        const int s0 = r0 < NCTX ? (r0 & ~(SEQ - 1)) : NCTX + ((r0 - NCTX) & ~(DSEQ - 1));
        const int s1 = s0 + (r0 < NCTX ? SEQ : DSEQ);
        if (F.tid < 128) {
            const int c = F.tid & 63, dir = F.tid >> 6, tok = r0 + c;
            const GAS float* ab = (const GAS float*)(a.ws + WS_AB) + (size_t)tok * 64 + dir * 32 + h;
            const float xa = ab[0] + a.gdn_dt_bias[(mi * 2 + dir) * 16 + h], xb = ab[16];
            const float sp = (xa > 20.f) ? xa : log1pf(expf(xa));
            const float g = -expf(a.gdn_a_log[(mi * 2 + dir) * 16 + h]) * sp;
            const float be = 1.0f / (1.0f + expf(-xb));
            __hip_atomic_store((GAS float*)(a.ws + WS_GG) + ((size_t)dir * MTOK + tok) * 16 + h, g, __ATOMIC_RELAXED, __HIP_MEMORY_SCOPE_AGENT);
            __hip_atomic_store((GAS float*)(a.ws + WS_GB) + ((size_t)dir * MTOK + tok) * 16 + h, be, __ATOMIC_RELAXED, __HIP_MEMORY_SCOPE_AGENT);
        }
#pragma unroll 1
        for (int ten = 0; ten < 3; ++ten) {
            const int chan = ten * D + h * DKV + ch8 * 8;
            float w[5][8];
#pragma unroll
            for (int j = 0; j < 5; ++j) { const GAS f32x4* wp = (const GAS f32x4*)((const GAS float*)a.gdn_conv + ((size_t)mi * 5 + j) * NQKV + chan); const f32x4 w0 = wp[0], w1 = wp[1];
                w[j][0] = w0.x; w[j][1] = w0.y; w[j][2] = w0.z; w[j][3] = w0.w; w[j][4] = w1.x; w[j][5] = w1.y; w[j][6] = w1.z; w[j][7] = w1.w; }
#pragma unroll
            for (int ps = 0; ps < 2; ++ps) {
                const int tok = r0 + rr + 32 * ps;
                float acc[8] = {0.f, 0.f, 0.f, 0.f, 0.f, 0.f, 0.f, 0.f};
#pragma unroll
                for (int j = 0; j < 5; ++j) { const int t = tok + j - 2;
                    u32x4 u = {0u, 0u, 0u, 0u}; if (t >= s0 && t < s1) u = *(const GAS u32x4*)(P + (size_t)t * 8192 + chan);
                    acc[0] = fmaf(bf_lo(u.x), w[j][0], acc[0]); acc[1] = fmaf(bf_hi(u.x), w[j][1], acc[1]); acc[2] = fmaf(bf_lo(u.y), w[j][2], acc[2]); acc[3] = fmaf(bf_hi(u.y), w[j][3], acc[3]);
                    acc[4] = fmaf(bf_lo(u.z), w[j][4], acc[4]); acc[5] = fmaf(bf_hi(u.z), w[j][5], acc[5]); acc[6] = fmaf(bf_lo(u.w), w[j][6], acc[6]); acc[7] = fmaf(bf_hi(u.w), w[j][7], acc[7]); }
                float ss = 0.f;
#pragma unroll
                for (int i = 0; i < 8; ++i) { acc[i] = silu_f(acc[i]); ss += acc[i] * acc[i]; }
                if (ten < 2) {
                    ss += __shfl_xor(ss, 1); ss += __shfl_xor(ss, 2); ss += __shfl_xor(ss, 4); ss += __shfl_xor(ss, 8);
                    float sc = 1.0f / sqrtf(ss + L2_EPS); if (ten == 0) sc *= 0.08838834764831845f;
#pragma unroll
                    for (int i = 0; i < 8; ++i) acc[i] *= sc;
                }
                u32x4 o; o.x = cvt_pk_bf16(acc[0], acc[1]); o.y = cvt_pk_bf16(acc[2], acc[3]); o.z = cvt_pk_bf16(acc[4], acc[5]); o.w = cvt_pk_bf16(acc[6], acc[7]);
                *(GAS u32x4*)(Q + (size_t)tok * NQKV + chan) = o;
            }
        }
    }
}
__device__ __forceinline__ void gdn_post_phase(const Frame& F_in, const Args& a, int mi) {
    OPAQUE_FRAME(F);
    const int gw = F.vcu * NWAVES + F.wave, NGW = F.G * NWAVES;
    const GAS float* O0 = (const GAS float*)(a.ws + WS_O); const GAS float* O1 = O0 + (size_t)MTOK * D;
    for (int m = gw; m < MTOK; m += NGW) {
#pragma unroll
        for (int j = 0; j < 8; ++j) {
            const int e0 = 4 * (F.lane + 64 * j);
            const f32x4 o = *(const GAS f32x4*)(O0 + (size_t)m * D + e0) + *(const GAS f32x4*)(O1 + (size_t)m * D + e0);
            float ss = (o.x * o.x + o.y * o.y) + (o.z * o.z + o.w * o.w);
            ss += __shfl_xor(ss, 1); ss += __shfl_xor(ss, 2); ss += __shfl_xor(ss, 4); ss += __shfl_xor(ss, 8); ss += __shfl_xor(ss, 16);
            const float r = 1.0f / sqrtf(ss * (1.0f / DKV) + RMS_EPS);
            const f32x4 ng = *(const GAS f32x4*)((const GAS float*)a.gdn_norm_g + mi * DKV + (e0 & 127));
            const u32x2 zz = *(const GAS u32x2*)((const GAS bf16_t*)(a.ws + WS_P) + (size_t)m * 8192 + NQKV + e0);
            f32x4 v = o * r * ng; v.x *= silu_f(bf_lo(zz.x)); v.y *= silu_f(bf_hi(zz.x)); v.z *= silu_f(bf_lo(zz.y)); v.w *= silu_f(bf_hi(zz.y));
            u32x2 w; w.x = cvt_pk_bf16(v.x, v.y); w.y = cvt_pk_bf16(v.z, v.w);
            *(GAS u32x2*)((GAS bf16_t*)(a.ws + WS_H) + (size_t)m * D + e0) = w;
        }
    }
}

constexpr int SC_Z = 0, SC_Q = 34816, SC_K = 52224, SC_V = 69632, SC_AKK = 88064, SC_TW = 106496, SC_TU = 115712, SC_AQK = 124928, SC_WN = 134144, SC_G = 151552, SC_XS = 153600;
__device__ __forceinline__ int off256(int row, int cb) { return row * 272 + cb; }
__device__ __forceinline__ int off128(int row, int cb) { return row * 144 + cb; }
__device__ __forceinline__ bf16x8 ldf256(LAS unsigned char* base, int row0, int ks, int fr, int fq) { return *(const LAS bf16x8*)(base + off256(row0 + fr, 64 * ks + 16 * fq)); }
__device__ __forceinline__ bf16x8 ldf128(LAS unsigned char* base, int row0, int ks, int fr, int fq) { return *(const LAS bf16x8*)(base + off128(row0 + fr, 64 * ks + 16 * fq)); }
__device__ __forceinline__ bf16x8 ldtr256(LAS unsigned char* base, int n0, int ks, int fr, int fq) {
    const int q = fr >> 2, p = fr & 3, r = 32 * ks + 8 * fq + q, cb = 2 * (n0 + 4 * p);
    const bf16x4 lo = __builtin_amdgcn_ds_read_tr16_b64_v4i16((LAS bf16x4*)(base + off256(r, cb)));
    const bf16x4 hi = __builtin_amdgcn_ds_read_tr16_b64_v4i16((LAS bf16x4*)(base + off256(r + 4, cb)));
    return __builtin_shufflevector(lo, hi, 0, 1, 2, 3, 4, 5, 6, 7);
}
#define MFMA16(a, b, c) __builtin_amdgcn_mfma_f32_16x16x32_bf16(a, b, c, 0, 0, 0)

__device__ __forceinline__ void scan_item(const Frame& F, const Args& a, int mi, int islat, int b, int h, int dir) {
    LAS unsigned char* L = F.lds;
    const int w = F.wave; int lane0 = F.lane; int tid0 = F.tid; asm volatile("" : "+v"(lane0), "+v"(tid0));
    const int T = islat ? DSEQ : SEQ, t0 = islat ? NCTX + b * DSEQ : b * SEQ, nchunk = T / CHUNK;
    const GAS bf16_t* Qc = (const GAS bf16_t*)(a.ws + WS_QKV);
    GAS float* Og = (GAS float*)(a.ws + WS_O) + (size_t)dir * MTOK * D;
    const GAS float* GGp = (const GAS float*)(a.ws + WS_GG) + (size_t)dir * MTOK * 16 + h;
    const GAS float* GBp = (const GAS float*)(a.ws + WS_GB) + (size_t)dir * MTOK * 16 + h;
    f32x4 accz[8];
    { const int fr = lane0 & 15, fq = lane0 >> 4;
    if (islat) {
        const GAS float* sp = (const GAS float*)a.state_gdn + ((((size_t)b * 2 + mi) * 2 + dir) * 16 + h) * (DKV * DKV);
#pragma unroll
        for (int dkt = 0; dkt < 8; ++dkt)
#pragma unroll
            for (int r = 0; r < 4; ++r) accz[dkt][r] = sp[(size_t)(16 * dkt + 4 * fq + r) * DKV + 16 * w + fr];
    } else {
#pragma unroll
        for (int dkt = 0; dkt < 8; ++dkt) accz[dkt] = (f32x4){0.f, 0.f, 0.f, 0.f};
    }
#pragma unroll
    for (int dkt = 0; dkt < 8; ++dkt) { u32x2 z; z.x = cvt_pk_bf16(accz[dkt][0], accz[dkt][1]); z.y = cvt_pk_bf16(accz[dkt][2], accz[dkt][3]);
        *(LAS u32x2*)(L + SC_Z + off256(16 * w + fr, 2 * (16 * dkt + 4 * fq))) = z; } }
    u32x4 pq[2], pk[2], pv[2]; float pg = 0.f, pb = 0.f;
#define SCAN_PREFETCH(nn) do { _Pragma("unroll") for (int ps = 0; ps < 2; ++ps) { const int c_ = rr + 32 * ps; const int tok_ = dir ? t0 + T - 1 - (64 * (nn) + c_) : t0 + 64 * (nn) + c_; \
            const GAS bf16_t* src_ = Qc + (size_t)tok_ * NQKV + h * DKV + ch8 * 8; pq[ps] = *(const GAS u32x4*)src_; pk[ps] = *(const GAS u32x4*)(src_ + D); pv[ps] = *(const GAS u32x4*)(src_ + 2 * D); } \
        if (w == 0) { const int tok_ = dir ? t0 + T - 1 - (64 * (nn) + lane) : t0 + 64 * (nn) + lane; pg = GGp[(size_t)tok_ * 16]; pb = GBp[(size_t)tok_ * 16]; } } while (0)
    { const int lane = lane0, ch8 = tid0 & 15, rr = tid0 >> 4; SCAN_PREFETCH(0); }

    for (int n = 0; n < nchunk; ++n) {
        LAS unsigned char *bZ = L + SC_Z, *bQ = L + SC_Q, *bK = L + SC_K, *bV = L + SC_V, *bAKK = L + SC_AKK, *bAQK = L + SC_AQK, *bWN = L + SC_WN, *bXS = L + SC_XS, *bG = L + SC_G;
        int lane = lane0, tid = tid0;
        asm volatile("" : "+v"(bZ), "+v"(bQ), "+v"(bK), "+v"(bV), "+v"(bAKK), "+v"(bAQK), "+v"(bWN), "+v"(bXS), "+v"(bG), "+v"(lane), "+v"(tid));
        const int fr = lane & 15, fq = lane >> 4, ch8 = tid & 15, rr = tid >> 4;
        LAS float* gam = (LAS float*)bG; LAS float* bet = gam + 64; LAS float* eg = gam + 128; LAS float* edl = gam + 192; LAS float* fwv = gam + 256; LAS float* fuv = gam + 320;
        if (w == 0) {
            float cs = pg;
#pragma unroll
            for (int o = 1; o < 64; o <<= 1) { const float t = __shfl_up(cs, o); if (lane >= o) cs += t; }
            const float last = __shfl(cs, 63);
            const float e = fast_exp(cs);
            gam[lane] = cs; bet[lane] = pb; eg[lane] = e; edl[lane] = fast_exp(last - cs); fwv[lane] = pb * e; fuv[lane] = pb;
        }
#pragma unroll
        for (int ps = 0; ps < 2; ++ps) { const int o = off256(rr + 32 * ps, ch8 * 16);
            *(LAS u32x4*)(bQ + o) = pq[ps]; *(LAS u32x4*)(bK + o) = pk[ps]; *(LAS u32x4*)(bV + o) = pv[ps]; }
        __syncthreads();
        if (n + 1 < nchunk) SCAN_PREFETCH(n + 1);
        {
            const int tsel = w >> 2, st = w & 3;
            bf16x8 af[4];
#pragma unroll
            for (int ks = 0; ks < 4; ++ks) af[ks] = ldf256(bK, 16 * st, ks, fr, fq);
            LAS unsigned char* Bsrc = tsel ? bQ : bK;
#pragma unroll
            for (int ct = 0; ct < 4; ++ct) {
                f32x4 acc = {0.f, 0.f, 0.f, 0.f};
                if (ct >= st) {
#pragma unroll
                    for (int ks = 0; ks < 4; ++ks) acc = MFMA16(af[ks], ldf256(Bsrc, 16 * ct, ks, fr, fq), acc);
                }
                const int c = 16 * ct + fr, s0 = 16 * st + 4 * fq;
                const float gc = gam[c], bc = bet[c];
                f32x4 o;
#pragma unroll
                for (int r = 0; r < 4; ++r) { const int s = s0 + r; const float e = fast_exp(gc - gam[s]);
                    o[r] = tsel ? ((c >= s) ? acc[r] * e : 0.f) : ((c > s) ? bc * acc[r] * e : 0.f); }
                if (tsel) { u32x2 wv; wv.x = cvt_pk_bf16(o[0], o[1]); wv.y = cvt_pk_bf16(o[2], o[3]); *(LAS u32x2*)(bAQK + off128(c, 2 * s0)) = wv; }
                else *(LAS f32x4*)(bAKK + c * 256 + s0 * 4) = o;
            }
        }
        __syncthreads();
        if (w == 0) {
            const int g = fq, j = fr;
            {
                LAS unsigned char* bb = bAKK + g * (16 * 256 + 64);
                float t[16]; t[0] = 0.f;
#define D1_BATCH(c_lo, c_hi) { f32x4 rv[16][4]; float aj[16]; \
                    _Pragma("unroll") for (int c = c_lo; c < c_hi; ++c) { aj[c] = *(const LAS float*)(bb + c * 256 + j * 4); \
                        _Pragma("unroll") for (int q = 0; q < 4; ++q) if (4 * q < c) rv[c][q] = *(const LAS f32x4*)(bb + c * 256 + q * 16); } \
                    _Pragma("unroll") for (int c = c_lo; c < c_hi; ++c) { float a0 = -aj[c], a1 = 0.f; \
                        _Pragma("unroll") for (int s = 0; s < c; ++s) { if (s & 1) a1 = fmaf(-rv[c][s >> 2][s & 3], t[s], a1); else a0 = fmaf(-rv[c][s >> 2][s & 3], t[s], a0); } \
                        t[c] = a0 + a1; } \
                    asm volatile("" : "+v"(t[c_hi - 1])); }
                D1_BATCH(1, 6) D1_BATCH(6, 11) D1_BATCH(11, 16)
#undef D1_BATCH
#pragma unroll
                for (int c = 0; c < 16; ++c) *(LAS float*)(bb + c * 256 + j * 4) = t[c];
                *(LAS float*)(bb + j * 256 + j * 4) = 1.0f;
            }
#define TA(r_, c_) (*(const LAS float*)(bAKK + (r_) * 256 + (c_) * 4))
#define XSA(r_, c_) (*(LAS float*)(bXS + (r_) * 128 + (c_) * 4))
#define MF32(a_, b_, c_) __builtin_amdgcn_mfma_f32_16x16x4f32(a_, b_, c_, 0, 0, 0)
            {
                f32x4 x0 = {0.f, 0.f, 0.f, 0.f}, x1 = x0;
#pragma unroll
                for (int kk = 0; kk < 4; ++kk) { x0 = MF32(TA(16 + j, 4 * kk + g), TA(4 * kk + g, j), x0); x1 = MF32(TA(48 + j, 32 + 4 * kk + g), TA(32 + 4 * kk + g, 32 + j), x1); }
#pragma unroll
                for (int r = 0; r < 4; ++r) { XSA(4 * g + r, j) = x0[r]; XSA(16 + 4 * g + r, j) = x1[r]; }
                f32x4 y0 = {0.f, 0.f, 0.f, 0.f}, y1 = y0;
#pragma unroll
                for (int kk = 0; kk < 4; ++kk) { y0 = MF32(TA(16 + j, 16 + 4 * kk + g), XSA(4 * kk + g, j), y0); y1 = MF32(TA(48 + j, 48 + 4 * kk + g), XSA(16 + 4 * kk + g, j), y1); }
#pragma unroll
                for (int r = 0; r < 4; ++r) { *(LAS float*)(bAKK + (16 + 4 * g + r) * 256 + j * 4) = -y0[r]; *(LAS float*)(bAKK + (48 + 4 * g + r) * 256 + (32 + j) * 4) = -y1[r]; }
            }
            {
                f32x4 y[2][2];
#pragma unroll
                for (int rt = 0; rt < 2; ++rt)
#pragma unroll
                    for (int ct = 0; ct < 2; ++ct) { y[rt][ct] = (f32x4){0.f, 0.f, 0.f, 0.f};
#pragma unroll
                        for (int kk = 4 * ct; kk < 8; ++kk) y[rt][ct] = MF32(TA(32 + 16 * rt + j, 4 * kk + g), TA(4 * kk + g, 16 * ct + j), y[rt][ct]); }
#pragma unroll
                for (int rt = 0; rt < 2; ++rt)
#pragma unroll
                    for (int ct = 0; ct < 2; ++ct)
#pragma unroll
                        for (int r = 0; r < 4; ++r) XSA(16 * rt + 4 * g + r, 16 * ct + j) = y[rt][ct][r];
                f32x4 z[2][2];
#pragma unroll
                for (int rt = 0; rt < 2; ++rt)
#pragma unroll
                    for (int ct = 0; ct < 2; ++ct) { z[rt][ct] = (f32x4){0.f, 0.f, 0.f, 0.f};
#pragma unroll
                        for (int kk = 0; kk < 4 * (rt + 1); ++kk) z[rt][ct] = MF32(TA(32 + 16 * rt + j, 32 + 4 * kk + g), XSA(4 * kk + g, 16 * ct + j), z[rt][ct]); }
#pragma unroll
                for (int rt = 0; rt < 2; ++rt)
#pragma unroll
                    for (int ct = 0; ct < 2; ++ct)
#pragma unroll
                        for (int r = 0; r < 4; ++r) *(LAS float*)(bAKK + (32 + 16 * rt + 4 * g + r) * 256 + (16 * ct + j) * 4) = -z[rt][ct][r];
            }
#undef TA
#undef XSA
#undef MF32
        }
        __syncthreads();
        f32x4 accu[4];
        {
            bf16x8 kt[2], vt[2];
#pragma unroll
            for (int ks = 0; ks < 2; ++ks) { kt[ks] = ldtr256(bK, 16 * w, ks, fr, fq); vt[ks] = ldtr256(bV, 16 * w, ks, fr, fq); }
#pragma unroll
            for (int ct = 0; ct < 4; ++ct) {
                f32x4 aw = {0.f, 0.f, 0.f, 0.f}; accu[ct] = (f32x4){0.f, 0.f, 0.f, 0.f};
#pragma unroll
                for (int ks = 0; ks < 2; ++ks) {
                    const LAS f32x4* tp = (const LAS f32x4*)(bAKK + (16 * ct + fr) * 256 + (32 * ks + 8 * fq) * 4);
                    const f32x4 t0v = tp[0], t1v = tp[1];
                    const LAS f32x4* fwp = (const LAS f32x4*)(fwv + 32 * ks + 8 * fq); const LAS f32x4* fup = (const LAS f32x4*)(fuv + 32 * ks + 8 * fq);
                    const f32x4 w0 = t0v * fwp[0], w1 = t1v * fwp[1], u0 = t0v * fup[0], u1 = t1v * fup[1];
                    u32x4 tw, tu; tw.x = cvt_pk_bf16(w0[0], w0[1]); tw.y = cvt_pk_bf16(w0[2], w0[3]); tw.z = cvt_pk_bf16(w1[0], w1[1]); tw.w = cvt_pk_bf16(w1[2], w1[3]);
                    tu.x = cvt_pk_bf16(u0[0], u0[1]); tu.y = cvt_pk_bf16(u0[2], u0[3]); tu.z = cvt_pk_bf16(u1[0], u1[1]); tu.w = cvt_pk_bf16(u1[2], u1[3]);
                    aw = MFMA16(kt[ks], __builtin_bit_cast(bf16x8, tw), aw); accu[ct] = MFMA16(__builtin_bit_cast(bf16x8, tu), vt[ks], accu[ct]);
                }
                u32x2 wv; wv.x = cvt_pk_bf16(-aw[0], -aw[1]); wv.y = cvt_pk_bf16(-aw[2], -aw[3]);
                *(LAS u32x2*)(bWN + off256(16 * ct + fr, 2 * (16 * w + 4 * fq))) = wv;
            }
        }
        __syncthreads();
        {
            bf16x8 zf[4];
#pragma unroll
            for (int ks = 0; ks < 4; ++ks) zf[ks] = ldf256(bZ, 16 * w, ks, fr, fq);
#pragma unroll
            for (int ct = 0; ct < 4; ++ct) {
#pragma unroll
                for (int ks = 0; ks < 4; ++ks) accu[ct] = MFMA16(ldf256(bWN, 16 * ct, ks, fr, fq), zf[ks], accu[ct]);
                const int c0 = 16 * ct + 4 * fq, dv = 16 * w + fr;
                const f32x4 ed = *(const LAS f32x4*)(edl + c0);
                u32x2 v1, v2; v1.x = cvt_pk_bf16(accu[ct][0], accu[ct][1]); v1.y = cvt_pk_bf16(accu[ct][2], accu[ct][3]);
                v2.x = cvt_pk_bf16(accu[ct][0] * ed[0], accu[ct][1] * ed[1]); v2.y = cvt_pk_bf16(accu[ct][2] * ed[2], accu[ct][3] * ed[3]);
                *(LAS u32x2*)(bV + off128(dv, 2 * c0)) = v1; *(LAS u32x2*)(bAKK + off128(dv, 2 * c0)) = v2;
            }
            bf16x8 vf[2], vd[2];
#pragma unroll
            for (int ks = 0; ks < 2; ++ks) { vf[ks] = ldf128(bV, 16 * w, ks, fr, fq); vd[ks] = ldf128(bAKK, 16 * w, ks, fr, fq); }
#pragma unroll
            for (int ct = 0; ct < 4; ++ct) {
                f32x4 ao = {0.f, 0.f, 0.f, 0.f};
#pragma unroll
                for (int ks = 0; ks < 4; ++ks) ao = MFMA16(zf[ks], ldf256(bQ, 16 * ct, ks, fr, fq), ao);
                const int c = 16 * ct + fr; ao = ao * eg[c];
#pragma unroll
                for (int ks = 0; ks < 2; ++ks) ao = MFMA16(vf[ks], ldf128(bAQK, 16 * ct, ks, fr, fq), ao);
                const int tok = dir ? t0 + T - 1 - (64 * n + c) : t0 + 64 * n + c;
                *(GAS f32x4*)(Og + (size_t)tok * D + h * DKV + 16 * w + 4 * fq) = ao;
            }
            const float cdec = eg[63];
#pragma unroll
            for (int dkt = 0; dkt < 8; ++dkt) {
                accz[dkt] = accz[dkt] * cdec;
#pragma unroll
                for (int ks = 0; ks < 2; ++ks) accz[dkt] = MFMA16(ldtr256(bK, 16 * dkt, ks, fr, fq), vd[ks], accz[dkt]);
                u32x2 z; z.x = cvt_pk_bf16(accz[dkt][0], accz[dkt][1]); z.y = cvt_pk_bf16(accz[dkt][2], accz[dkt][3]);
                *(LAS u32x2*)(bZ + off256(16 * w + fr, 2 * (16 * dkt + 4 * fq))) = z;
            }
        }
        __syncthreads();
    }
#undef SCAN_PREFETCH
    if (!islat) {
        const int fr = lane0 & 15, fq = lane0 >> 4;
        GAS float* sp = (GAS float*)a.out + (size_t)MTOK * D + ((((size_t)b * 2 + mi) * 2 + dir) * 16 + h) * (DKV * DKV);
#pragma unroll
        for (int dkt = 0; dkt < 8; ++dkt)
#pragma unroll
            for (int r = 0; r < 4; ++r) sp[(size_t)(16 * dkt + 4 * fq + r) * DKV + 16 * w + fr] = accz[dkt][r];
    }
}
__device__ __forceinline__ void gdn_scan_phase(const Frame& F, const Args& a, int mi) {
    const int c = F.vcu;
    const int nit = (F.G == 256) ? (c < 64 ? 2 : 5) : (64 + 1024 - c + F.G - 1) / F.G;
    for (int j = 0; j < nit; ++j) {
        int i;
        if (F.G == 256) i = (c < 64) ? (j == 0 ? c : 64 + c) : 64 + 64 + (c - 64) * 5 + j; else i = c + j * F.G;
        const int islat = i < 64; const int q = islat ? i : i - 64;
        scan_item(F, a, mi, islat, q >> 5, (q >> 1) & 15, q & 1);
    }
}

__global__ void __launch_bounds__(NWAVES * 64, 2) fwd_kernel(Args a) {
    extern __shared__ __attribute__((aligned(16))) unsigned char lds_raw[];
    Frame F;
    F.lds = (LAS unsigned char*)lds_raw;
    F.tid = threadIdx.x; F.lane = F.tid & 63; F.wave = __builtin_amdgcn_readfirstlane(F.tid >> 6);
    F.G = gridDim.x; { const int bx = blockIdx.x; F.vcu = (F.G % 8 == 0) ? (bx % 8) * (F.G / 8) + bx / 8 : bx; }
    volatile LAS unsigned* MISC = (volatile LAS unsigned*)(F.lds + MISC_OFF);
    for (int u = F.tid; u < (LDS_BYTES - MISC_OFF) / 4; u += NWAVES * 64) MISC[u] = 0u;
    __syncthreads();
    unsigned char* ws = a.ws;
    XcdBarrier bar = xcd_barrier_post((unsigned*)(ws + WS_CTL) + 4096, MISC + 8);
#define GRID_BAR() xcd_barrier(bar)
    const float* mods = (const float*)(ws + WS_MODS);

    prologue_a(F, a);
    GRID_BAR();
    prologue_b(F, a);
    GRID_BAR();

    for (int l = 0; l < DEPTH; ++l) {
        const float* modl = mods + (size_t)l * 3 * NMODC;
        const int mi = l >> 1;
        norm_phase(F, a, a.norm_g + (size_t)(l * 3 + 0) * D, modl, 0);
        GRID_BAR();
        { pg8::Gemm g{(const bf16_t*)(ws + WS_H), (const bf16_t*)(ws + WS_BT1 + (size_t)(l * 2 + 0) * SZ_BT1), D, D, D};
          pg8::StaticOrder S; S.init(MTOK / 256, NGU / 256, F.G, (int)blockIdx.x, 0);
          pg8::EpiSwiGLU E{(bf16_t*)(ws + WS_ACT)};
          pg8::gemm_phase<pg8::EpiSwiGLU>(F.lds, g, S, E); }
        GRID_BAR();
        { pg8::Gemm g{(const bf16_t*)(ws + WS_ACT), (const bf16_t*)(ws + WS_BT2 + (size_t)(l * 2 + 0) * SZ_BT2), DFF, DFF, DFF};
          pg8::StaticOrder S; S.init(MTOK / 256, D / 256, F.G, (int)blockIdx.x, 0);
          pg8::EpiResid E{(float*)(ws + WS_X), modl + 2 * D, nullptr, 0.5f};
          pg8::gemm_phase<pg8::EpiResid>(F.lds, g, S, E); }
        GRID_BAR();
        if ((l & 1) == 0) {
            norm_phase(F, a, a.norm_g + (size_t)(l * 3 + 1) * D, modl, 1);
            GRID_BAR();
            { pg8::Gemm g{(const bf16_t*)(ws + WS_H), (const bf16_t*)(ws + WS_BTG + (size_t)mi * SZ_BTG), D, D, D};
              pg8::StaticOrder S; S.init(MTOK / 256, NPROJ_PAD / 256, F.G, (int)blockIdx.x, 0);
              pg8::EpiProj E{(bf16_t*)(ws + WS_P), (float*)(ws + WS_AB)};
              pg8::gemm_phase<pg8::EpiProj>(F.lds, g, S, E); }
            GRID_BAR();
            gdn_prep_phase(F, a, mi);
            GRID_BAR();
            gdn_scan_phase(F, a, mi);
            GRID_BAR();
            gdn_post_phase(F, a, mi);
            GRID_BAR();
            { pg8::Gemm g{(const bf16_t*)(ws + WS_H), (const bf16_t*)(ws + WS_BTO + (size_t)mi * SZ_BTO), D, D, D};
              pg8::StaticOrder S; S.init(MTOK / 256, D / 256, F.G, (int)blockIdx.x, 0);
              pg8::EpiResid E{(float*)(ws + WS_X), modl + 5 * D, nullptr, 1.0f};
              pg8::gemm_phase<pg8::EpiResid>(F.lds, g, S, E); }
            GRID_BAR();
        } else {
            rstd_phase(F, a);
            GRID_BAR();
            pool_pre_phase(F, a, a.norm_g + (size_t)(l * 3 + 1) * D, modl);
            GRID_BAR();
            { pg8::Gemm g{(const bf16_t*)(ws + WS_H), (const bf16_t*)(ws + WS_BTP + (size_t)mi * SZ_BTP), D, 512, 512};
              pg8::StaticOrder S; S.init(MTOK / 256, D / 256, F.G, (int)blockIdx.x, 1);
              pg8::EpiResid E{(float*)(ws + WS_X), modl + 5 * D, a.pool_scale + (size_t)mi * D, 1.0f};
              pg8::gemm_phase<pg8::EpiResid>(F.lds, g, S, E); }
            GRID_BAR();
        }
        norm_phase(F, a, a.norm_g + (size_t)(l * 3 + 2) * D, modl, 2);
        GRID_BAR();
        { pg8::Gemm g{(const bf16_t*)(ws + WS_H), (const bf16_t*)(ws + WS_BT1 + (size_t)(l * 2 + 1) * SZ_BT1), D, D, D};
          pg8::StaticOrder S; S.init(MTOK / 256, NGU / 256, F.G, (int)blockIdx.x, 0);
          pg8::EpiSwiGLU E{(bf16_t*)(ws + WS_ACT)};
          pg8::gemm_phase<pg8::EpiSwiGLU>(F.lds, g, S, E); }
        GRID_BAR();
        { pg8::Gemm g{(const bf16_t*)(ws + WS_ACT), (const bf16_t*)(ws + WS_BT2 + (size_t)(l * 2 + 1) * SZ_BT2), DFF, DFF, DFF};
          pg8::StaticOrder S; S.init(MTOK / 256, D / 256, F.G, (int)blockIdx.x, 0);
          pg8::EpiResid E{(float*)(ws + WS_X), modl + 8 * D, nullptr, 0.5f};
          pg8::gemm_phase<pg8::EpiResid>(F.lds, g, S, E); }
        GRID_BAR();
    }
    final_phase(F, a);
}

extern "C" void kernel_launch(void* const* d_in, const int* in_sizes, int n_in, void* d_out, int out_size, void* d_ws, size_t ws_size, hipStream_t stream) {
    static int grid = 0;
    if (grid == 0) {
        if (n_in != 19 || ws_size < WS_END) { fprintf(stderr, "kernel_launch: unexpected n_in %d or ws_size %zu (need %zu)\n", n_in, ws_size, (size_t)WS_END); grid = -1; return; }
        int dev = 0, cus = 0, per_cu = 0;
        if (hipGetDevice(&dev) != hipSuccess || hipDeviceGetAttribute(&cus, hipDeviceAttributeMultiprocessorCount, dev) != hipSuccess) { grid = -1; return; }
        if (hipFuncSetAttribute((const void*)fwd_kernel, hipFuncAttributeMaxDynamicSharedMemorySize, LDS_BYTES) != hipSuccess) { fprintf(stderr, "kernel_launch: hipFuncSetAttribute failed\n"); grid = -1; return; }
        if (hipOccupancyMaxActiveBlocksPerMultiprocessor(&per_cu, (const void*)fwd_kernel, NWAVES * 64, LDS_BYTES) != hipSuccess || per_cu < 1) { fprintf(stderr, "kernel_launch: occupancy query says %d\n", per_cu); }
        (void)hipGetLastError();
        grid = cus;
    }
    if (grid < 0) return;
    (void)hipMemsetAsync((char*)d_ws + WS_CTL, 0, CTL_ZERO_BYTES, stream);
    Args a{};
    a.x_prompt = (const float*)d_in[0]; a.x_sample = (const float*)d_in[1]; a.state_gdn = (const float*)d_in[2]; a.c = (const float*)d_in[3]; a.c_ctx = (const float*)d_in[4];
    a.w_mod = (const float*)d_in[5]; a.b_mod = (const float*)d_in[6]; a.norm_g = (const float*)d_in[7]; a.ffn_w_in = (const float*)d_in[8]; a.ffn_w_out = (const float*)d_in[9];
    a.gdn_w_in = (const float*)d_in[10]; a.gdn_conv = (const float*)d_in[11]; a.gdn_a_log = (const float*)d_in[12]; a.gdn_dt_bias = (const float*)d_in[13]; a.gdn_norm_g = (const float*)d_in[14]; a.gdn_w_out = (const float*)d_in[15];
    a.pool_w = (const float*)d_in[16]; a.pool_scale = (const float*)d_in[17]; a.final_g = (const float*)d_in[18];
    a.out = (float*)d_out; a.ws = (unsigned char*)d_ws;
    hipLaunchKernelGGL(fwd_kernel, dim3(grid), dim3(NWAVES * 64), LDS_BYTES, stream, a);
}
```

```cpp
#include <hip/hip_runtime.h>
#include <cstdio>
#include <cstdint>

#define GAS __attribute__((address_space(1)))
#define LAS __attribute__((address_space(3)))
typedef unsigned short bf16_t;
typedef short bf16x8 __attribute__((ext_vector_type(8)));
typedef short bf16x4 __attribute__((ext_vector_type(4)));
typedef float f32x4 __attribute__((ext_vector_type(4)));
typedef float f32x2 __attribute__((ext_vector_type(2)));
typedef unsigned u32x4 __attribute__((ext_vector_type(4)));
typedef unsigned u32x2 __attribute__((ext_vector_type(2)));

constexpr int D = 2048, NCTX = 8192, NLAT = 2048, MTOK = 10240, DEPTH = 4, DFF = 5504, NGU = 11008;
constexpr int NPROJ = 8256, NPROJ_PAD = 8448, NMOD = 9, NQKV = 6144, NMODC = NMOD * D;
constexpr int SEQ = 256, DSEQ = 1024, NB = 32, NDB = 2, HEADS = 16, DKV = 128, CHUNK = 64;
constexpr float RMS_EPS = 1e-6f, L2_EPS = 1e-6f;

constexpr size_t MiB = 1u << 20;
constexpr size_t WS_CTL = 0, CTL_ZERO_BYTES = 1 * MiB;
constexpr size_t WS_MODP = 1 * MiB;
constexpr size_t WS_MODS = 8 * MiB;
constexpr size_t WS_RSTD = 9 * MiB;
constexpr size_t WS_GG = 10 * MiB;
constexpr size_t WS_GB = 12 * MiB;
constexpr size_t WS_AB = 14 * MiB;
constexpr size_t WS_BT1 = 32 * MiB;
constexpr size_t SZ_BT1 = (size_t)NGU * D * 2;
constexpr size_t WS_BT2 = WS_BT1 + 8 * SZ_BT1;
constexpr size_t SZ_BT2 = (size_t)D * DFF * 2;
constexpr size_t WS_BTG = WS_BT2 + 8 * SZ_BT2;
constexpr size_t SZ_BTG = (size_t)NPROJ_PAD * D * 2;
constexpr size_t WS_BTO = WS_BTG + 2 * SZ_BTG;
constexpr size_t SZ_BTO = (size_t)D * D * 2;
constexpr size_t WS_BTP = WS_BTO + 2 * SZ_BTO;
constexpr size_t SZ_BTP = (size_t)D * 512 * 2;
constexpr size_t WS_X = ((WS_BTP + 2 * SZ_BTP + MiB - 1) / MiB) * MiB;
constexpr size_t WS_H = WS_X + (size_t)MTOK * D * 4;
constexpr size_t WS_ACT = WS_H + (size_t)MTOK * D * 2;
constexpr size_t WS_P = WS_ACT + (size_t)MTOK * DFF * 2;
constexpr size_t WS_QKV = WS_P + (size_t)MTOK * 8192 * 2;
constexpr size_t WS_O = WS_QKV + (size_t)MTOK * NQKV * 2;
constexpr size_t WS_END = WS_O + (size_t)2 * MTOK * D * 4;

constexpr int LDS_BYTES = 163840;
constexpr int MISC_OFF = 163328;
constexpr int NWAVES = 8;

#define LDS_WAIT() asm volatile("s_waitcnt lgkmcnt(0)" ::: "memory")
#define VM_WAIT() asm volatile("s_waitcnt vmcnt(0)" ::: "memory")
typedef __bf16 bf16x2_t __attribute__((ext_vector_type(2)));
__device__ __forceinline__ unsigned cvt_pk_bf16(float lo, float hi) { const f32x2 v = {lo, hi}; const bf16x2_t b = __builtin_convertvector(v, bf16x2_t); return __builtin_bit_cast(unsigned, b); }
__device__ __forceinline__ float bf_lo(unsigned u) { return __uint_as_float(u << 16); }
__device__ __forceinline__ float bf_hi(unsigned u) { return __uint_as_float(u & 0xffff0000u); }
__device__ __forceinline__ float fast_exp(float x) { return __builtin_amdgcn_exp2f(x * 1.44269504089f); }
__device__ __forceinline__ float silu_f(float x) { return x * __builtin_amdgcn_rcpf(1.0f + fast_exp(-x)); }
__device__ __forceinline__ float wave_sum(float v) {
#pragma unroll
    for (int o = 1; o < 64; o <<= 1) v += __shfl_xor(v, o);
    return v;
}

#define XB_TMO      128
#define XB_XCNT(j)  (256  + 64 * (j))
#define XB_XSUB(j)  (1280 + 64 * (j))
#define XB_XGEN(j)  (2304 + 64 * (j))
#define XB_TOP      3328
#define XB_TOPGEN   3392
#define XCD_BAR_WORDS 3456
#define XB_SPIN_CAP (1u << 20)

__device__ __forceinline__ unsigned xb_ld(unsigned* p)              { return __hip_atomic_load(p, __ATOMIC_RELAXED, __HIP_MEMORY_SCOPE_AGENT); }
__device__ __forceinline__ unsigned xb_add(unsigned* p, unsigned v) { return __hip_atomic_fetch_add(p, v, __ATOMIC_RELAXED, __HIP_MEMORY_SCOPE_AGENT); }
__device__ __forceinline__ unsigned xb_xcc_id() { return (unsigned)__builtin_amdgcn_s_getreg((3 << 11) | 20) & 0xFu; }
#define XB_SPIN(cond, bar) do { unsigned _sp = 0; while (cond) { __builtin_amdgcn_s_sleep(1); \
    if ((++_sp & 255u) == 0u) { if (xb_ld(&(bar)[XB_TMO])) break; if (_sp > XB_SPIN_CAP) { atomicAdd(&(bar)[XB_TMO], 1u); break; } } } } while (0)

struct XcdBarrier { unsigned* bar; unsigned x; volatile LAS unsigned* st; };

__device__ __forceinline__ XcdBarrier xcd_barrier_post(unsigned* bar, volatile LAS unsigned* st) {
    XcdBarrier b; b.bar = bar; b.x = xb_xcc_id(); b.st = st;
    if (threadIdx.x == 0) (void)xb_add(&bar[XB_XCNT(b.x)], 1u);
    return b;
}
__device__ __forceinline__ void xcd_barrier_complete(unsigned* bar, unsigned x, unsigned& nloc, unsigned& nx) {
    const unsigned G = gridDim.x * gridDim.y * gridDim.z;
    unsigned sum, cnt, mine, sp = 0u;
    for (;;) {
        sum = 0u; cnt = 0u; mine = 0u;
#pragma unroll
        for (unsigned j = 0; j < 16; ++j) { const unsigned c = xb_ld(&bar[XB_XCNT(j)]); sum += c; cnt += (c > 0u) ? 1u : 0u; mine = (j == x) ? c : mine; }
        if (sum == G) break;
        __builtin_amdgcn_s_sleep(1);
        if ((++sp & 255u) == 0u) { if (xb_ld(&bar[XB_TMO])) break; if (sp > XB_SPIN_CAP) { atomicAdd(&bar[XB_TMO], 1u); break; } }
    }
    nloc = mine > 0u ? mine : 1u; nx = cnt > 0u ? cnt : 1u;
}
__device__ __forceinline__ void xcd_barrier(const XcdBarrier& b) {
    asm volatile("s_waitcnt vmcnt(0)" ::: "memory");
    __syncthreads();
    if (threadIdx.x == 0) {
        unsigned* bar = b.bar; unsigned bx = b.x;
        asm volatile("" : "+s"(bar), "+s"(bx));
        __builtin_amdgcn_s_waitcnt(0);
        unsigned nloc = b.st[0], nx = b.st[1];
        if (nloc == 0u) { xcd_barrier_complete(bar, bx, nloc, nx); b.st[0] = nloc; b.st[1] = nx; }
        const unsigned old = xb_add(&bar[XB_XSUB(bx)], 1u);
        const unsigned gen = old / nloc;
        if (old + 1u == (gen + 1u) * nloc) {
            __builtin_amdgcn_fence(__ATOMIC_RELEASE, "agent");
            asm volatile("s_waitcnt vmcnt(0)" ::: "memory");
            const unsigned og = xb_add(&bar[XB_TOP], 1u);
            const unsigned tg = og / nx;
            if (og + 1u == (tg + 1u) * nx) xb_add(&bar[XB_TOPGEN], 1u);
            else XB_SPIN(xb_ld(&bar[XB_TOPGEN]) == tg, bar);
            __builtin_amdgcn_fence(__ATOMIC_ACQUIRE, "agent");
            xb_add(&bar[XB_XGEN(bx)], 1u);
            asm volatile("s_waitcnt vmcnt(0)" ::: "memory");
        } else {
            XB_SPIN(xb_ld(&bar[XB_XGEN(bx)]) == gen, bar);
            __builtin_amdgcn_fence(__ATOMIC_ACQUIRE, "agent");
            asm volatile("s_waitcnt vmcnt(0)" ::: "memory");
        }
    }
    __syncthreads();
}

namespace pg8 {
constexpr int BM = 256, BK = 64, HALF = 128, HTB = HALF * BK * 2, STAGE_BYTES = 8 * HTB, NXCD = 8, WGM = 8;
__device__ __forceinline__ int lds_byte(int r, int c) { const int st = (r >> 4) * 2 + (c >> 5), rr = r & 15, cc = c & 31, ob = rr * 64 + cc * 2; return st * 1024 + (ob ^ (((ob >> 9) & 1) << 5)); }
__device__ __forceinline__ void stage_rc(int b, int& R, int& C) { const int st = b / 1024, sb = b % 1024, swz = sb ^ (((sb >> 9) & 1) << 5); R = (st >> 1) * 16 + swz / 64; C = (st & 1) * 32 + (swz % 64) / 2; }
__device__ __forceinline__ int perm32(int rho) { const int n = rho >> 4, i = rho & 15; return 8 * (i >> 2) + 4 * n + (i & 3); }

struct Unit { int pm, pn, ak; };
struct Gemm { const bf16_t* A; const bf16_t* Bt; int lda, ldb, K; };

struct StaticOrder {
    int nM, nN, nwg, G, c, pool;
    __device__ void init(int nM_, int nN_, int G_, int c_, int pool_) { nM = nM_; nN = nN_; nwg = nM * nN; G = G_; c = c_; pool = pool_; }
    __device__ bool next(int i, Unit& u) const {
        const long L = (long)i * G + c; if (L >= nwg) return false;
        int wgid = (int)L; { const int q = nwg / NXCD, r = nwg % NXCD, xcd = wgid % NXCD, off = wgid / NXCD; wgid = (xcd < r ? xcd * (q + 1) : r * (q + 1) + (xcd - r) * q) + off; }
        const int nig = WGM * nN, gid = wgid / nig, fm = gid * WGM, gsz = (nM - fm) < WGM ? (nM - fm) : WGM;
        u.pm = fm + ((wgid % nig) % gsz); u.pn = (wgid % nig) / gsz; u.ak = pool ? (u.pn >> 1) * 512 : 0; return true;
    }
};

template <class Epi, bool ALIGN_EPI = true>
__device__ __forceinline__ void gemm_phase(LAS unsigned char* lds, const Gemm g, const StaticOrder& S, const Epi& E) {
    int tid = threadIdx.x; asm volatile("" : "+v"(tid)); const int wid = __builtin_amdgcn_readfirstlane(tid >> 6), lane = tid & 63, wr = wid >> 2, wc = wid & 3, fr = lane & 15, fq = lane >> 4;
    const int K = g.K, nt = K / BK;
    unsigned voffA[2], voffB[2];
#pragma unroll
    for (int i = 0; i < 2; ++i) { int R, C; stage_rc(tid * 16 + i * 8192, R, C); const int Rb = Epi::PERM ? ((R & ~31) + perm32(R & 31)) : R;
        voffA[i] = (unsigned)(R * g.lda + C) * 2u; voffB[i] = (unsigned)(Rb * g.ldb + C) * 2u; }
    const size_t kstep = (size_t)(BK * 2);
    const size_t hstepA = (size_t)HALF * g.lda * 2, hstepB = (size_t)HALF * g.ldb * 2;
    const size_t tstepA = 2 * hstepA, tstepB = 2 * hstepB;
    const unsigned ldsw = (unsigned)wid * 1024u;
    const int aoff = lds_byte(wr * 64 + fr, fq * 8), boff = lds_byte(wc * 32 + fr, fq * 8);
#define PG8_SA(b, h) (((b) * 2 + (h)) * HTB)
#define PG8_SB(b, h) ((4 + (b) * 2 + (h)) * HTB)
#define PG8_STAGE(bufoff, gbase, voff) do { _Pragma("unroll") for (int _i = 0; _i < 2; ++_i) \
        __builtin_amdgcn_global_load_lds((const GAS unsigned*)((const char*)(gbase) + (voff)[_i]), (LAS unsigned*)(lds + (bufoff) + ldsw + _i * 8192), 16, 0, 0); } while (0)
#define PG8_LDA(dst, b, h) do { _Pragma("unroll") for (int m = 0; m < 4; ++m) _Pragma("unroll") for (int k = 0; k < 2; ++k) dst[m][k] = *(const LAS bf16x8*)(lds + PG8_SA(b, h) + aoff + m * 2048 + k * 1024); } while (0)
#define PG8_LDB(dst, b, h) do { _Pragma("unroll") for (int n = 0; n < 2; ++n) _Pragma("unroll") for (int k = 0; k < 2; ++k) dst[n][k] = *(const LAS bf16x8*)(lds + PG8_SB(b, h) + boff + n * 2048 + k * 1024); } while (0)
#define PG8_MMA(ai, bj, At, Bt) do { __builtin_amdgcn_s_setprio(1); _Pragma("unroll") for (int m = 0; m < 4; ++m) _Pragma("unroll") for (int n = 0; n < 2; ++n) _Pragma("unroll") for (int k = 0; k < 2; ++k) \
        acc[ai][bj][m][n] = __builtin_amdgcn_mfma_f32_16x16x32_bf16(Bt[n][k], At[m][k], acc[ai][bj][m][n], 0, 0, 0); __builtin_amdgcn_s_setprio(0); } while (0)
#define PG8_WAIT_V(n) asm volatile("s_waitcnt vmcnt(" #n ")" ::: "memory")
#define PG8_WAIT_L(n) asm volatile("s_waitcnt lgkmcnt(" #n ")" ::: "memory")
#define PG8_BAR __builtin_amdgcn_s_barrier()
#define PG8_SCHED __builtin_amdgcn_sched_barrier(0)
    Unit cur, nxt; int ui = 0;
    if (!S.next(0, cur)) return;
    f32x4 acc[2][2][4][2];
#pragma unroll
    for (int a = 0; a < 2; ++a)
#pragma unroll
        for (int b = 0; b < 2; ++b)
#pragma unroll
            for (int m = 0; m < 4; ++m)
#pragma unroll
                for (int n = 0; n < 2; ++n) acc[a][b][m][n] = (f32x4){0.f, 0.f, 0.f, 0.f};
    bf16x8 At[4][2], B0[2][2], B1[2][2];
    const char* cA = (const char*)g.A + (size_t)cur.pm * tstepA + (size_t)cur.ak * 2; const char* cB = (const char*)g.Bt + (size_t)cur.pn * tstepB;
    PG8_STAGE(PG8_SB(0, 0), cB, voffB); PG8_STAGE(PG8_SB(0, 1), cB + hstepB, voffB); PG8_STAGE(PG8_SA(0, 0), cA, voffA); PG8_STAGE(PG8_SA(0, 1), cA + hstepA, voffA);
    if (wr == 1) PG8_BAR;
    PG8_WAIT_V(2); PG8_BAR;
    PG8_STAGE(PG8_SB(1, 0), cB + kstep, voffB); PG8_STAGE(PG8_SA(1, 0), cA + kstep, voffA); PG8_STAGE(PG8_SB(1, 1), cB + hstepB + kstep, voffB);
    PG8_WAIT_V(6); PG8_BAR;
    for (;;) {
        const bool has_next = S.next(ui + 1, nxt);
        const char* nA = has_next ? (const char*)g.A + (size_t)nxt.pm * tstepA + (size_t)nxt.ak * 2 : cA; const char* nB = has_next ? (const char*)g.Bt + (size_t)nxt.pn * tstepB : cB;
        for (int t = 0; t < nt; t += 2) {
            const bool last = (t == nt - 2);
            const char* a1 = cA + (size_t)(t + 1) * kstep;
            const char* a2 = last ? nA : cA + (size_t)(t + 2) * kstep; const char* b2 = last ? nB : cB + (size_t)(t + 2) * kstep;
            const char* a3 = a2 + kstep; const char* b3 = b2 + kstep;
            PG8_LDB(B0, 0, 0); PG8_LDB(B1, 0, 1); PG8_SCHED; PG8_LDA(At, 0, 0); PG8_STAGE(PG8_SA(1, 1), a1 + hstepA, voffA);
            PG8_WAIT_V(8); PG8_WAIT_L(0); PG8_BAR; PG8_MMA(0, 0, At, B0); PG8_MMA(0, 1, At, B1); PG8_BAR; PG8_SCHED;
            PG8_LDA(At, 0, 1); PG8_STAGE(PG8_SB(0, 0), b2, voffB); PG8_STAGE(PG8_SB(0, 1), b2 + hstepB, voffB); PG8_STAGE(PG8_SA(0, 0), a2, voffA);
            PG8_WAIT_V(8); PG8_WAIT_L(0); PG8_BAR; PG8_MMA(1, 0, At, B0); PG8_MMA(1, 1, At, B1); PG8_BAR; PG8_SCHED;
            PG8_LDB(B0, 1, 0); PG8_LDB(B1, 1, 1); PG8_SCHED; PG8_LDA(At, 1, 0); PG8_STAGE(PG8_SA(0, 1), a2 + hstepA, voffA);
            PG8_WAIT_V(8); PG8_WAIT_L(0); PG8_BAR; PG8_MMA(0, 0, At, B0); PG8_MMA(0, 1, At, B1); PG8_BAR; PG8_SCHED;
            PG8_LDA(At, 1, 1); PG8_STAGE(PG8_SB(1, 0), b3, voffB); PG8_STAGE(PG8_SB(1, 1), b3 + hstepB, voffB); PG8_STAGE(PG8_SA(1, 0), a3, voffA);
            PG8_WAIT_V(8); PG8_WAIT_L(0); PG8_BAR; PG8_MMA(1, 0, At, B0); PG8_MMA(1, 1, At, B1); PG8_BAR; PG8_SCHED;
        }
        if constexpr (ALIGN_EPI) { if (wr == 0) PG8_BAR; }
        E(acc, cur, wr, wc, fr, fq);
        if (!has_next) break;
#pragma unroll
        for (int a = 0; a < 2; ++a)
#pragma unroll
            for (int b = 0; b < 2; ++b)
#pragma unroll
                for (int m = 0; m < 4; ++m)
#pragma unroll
                    for (int n = 0; n < 2; ++n) acc[a][b][m][n] = (f32x4){0.f, 0.f, 0.f, 0.f};
        cur = nxt; cA = nA; cB = nB; ++ui;
        if constexpr (ALIGN_EPI) { if (wr == 1) PG8_BAR; }
    }
    PG8_WAIT_V(0);
    if constexpr (!ALIGN_EPI) { if (wr == 0) PG8_BAR; }
    PG8_BAR;
#undef PG8_SA
#undef PG8_SB
#undef PG8_STAGE
#undef PG8_LDA
#undef PG8_LDB
#undef PG8_MMA
#undef PG8_WAIT_V
#undef PG8_WAIT_L
#undef PG8_BAR
#undef PG8_SCHED
}

struct EpiSwiGLU {
    static constexpr bool PERM = true;
    bf16_t* O;
    __device__ __forceinline__ void operator()(const f32x4 (&acc)[2][2][4][2], const Unit& u, int wr, int wc, int fr, int fq) const {
        const int row0 = u.pm * BM + wr * 64 + fr, col0 = u.pn * 128 + wc * 32 + 8 * fq;
#pragma unroll
        for (int ai = 0; ai < 2; ++ai)
#pragma unroll
            for (int m = 0; m < 4; ++m) {
                GAS bf16_t* rowp = (GAS bf16_t*)O + (size_t)(row0 + ai * HALF + m * 16) * DFF + col0;
                float v[8];
#pragma unroll
                for (int n = 0; n < 2; ++n)
#pragma unroll
                    for (int j = 0; j < 4; ++j) { const float gt = acc[ai][0][m][n][j], up = acc[ai][1][m][n][j]; v[n * 4 + j] = silu_f(gt) * up; }
                u32x4 w; w.x = cvt_pk_bf16(v[0], v[1]); w.y = cvt_pk_bf16(v[2], v[3]); w.z = cvt_pk_bf16(v[4], v[5]); w.w = cvt_pk_bf16(v[6], v[7]);
                *(GAS u32x4*)rowp = w;
            }
    }
};
struct EpiResid {
    static constexpr bool PERM = false;
    float* X; const float* gate; const float* ps; float coef;
    __device__ __forceinline__ void operator()(const f32x4 (&acc)[2][2][4][2], const Unit& u, int wr, int wc, int fr, int fq) const {
        const int row0 = u.pm * BM + wr * 64 + fr, col0 = u.pn * BM + wc * 32 + 4 * fq;
        const int grp = u.pm < 32 ? 0 : 1 + ((u.pm - 32) >> 2);
        const GAS float* gp = (const GAS float*)gate + (size_t)grp * NMODC + col0;
        f32x4 bv[2][2];
#pragma unroll
        for (int bj = 0; bj < 2; ++bj)
#pragma unroll
            for (int n = 0; n < 2; ++n) { f32x4 t = *(const GAS f32x4*)(gp + bj * HALF + n * 16) * coef; if (ps) t = t * *(const GAS f32x4*)((const GAS float*)ps + col0 + bj * HALF + n * 16); bv[bj][n] = t; }
#pragma unroll
        for (int ai = 0; ai < 2; ++ai)
#pragma unroll
            for (int m = 0; m < 4; ++m) { GAS float* rowp = (GAS float*)X + (size_t)(row0 + ai * HALF + m * 16) * D + col0;
#pragma unroll
                for (int bj = 0; bj < 2; ++bj)
#pragma unroll
                    for (int n = 0; n < 2; ++n) { const f32x4 x = *(const GAS f32x4*)(rowp + bj * HALF + n * 16); *(GAS f32x4*)(rowp + bj * HALF + n * 16) = x + bv[bj][n] * acc[ai][bj][m][n]; }
                asm volatile("" ::: "memory"); }
    }
};
struct EpiProj {
    static constexpr bool PERM = true;
    bf16_t* P; float* AB;
    __device__ __forceinline__ void operator()(const f32x4 (&acc)[2][2][4][2], const Unit& u, int wr, int wc, int fr, int fq) const {
        const int row0 = u.pm * BM + wr * 64 + fr;
        if (u.pn < 32) {
            const int col0 = u.pn * BM + wc * 32 + 8 * fq;
#pragma unroll
            for (int ai = 0; ai < 2; ++ai)
#pragma unroll
                for (int m = 0; m < 4; ++m) { GAS bf16_t* rowp = (GAS bf16_t*)P + (size_t)(row0 + ai * HALF + m * 16) * 8192 + col0;
#pragma unroll
                    for (int bj = 0; bj < 2; ++bj) { const f32x4 v0 = acc[ai][bj][m][0], v1 = acc[ai][bj][m][1];
                        u32x4 w; w.x = cvt_pk_bf16(v0[0], v0[1]); w.y = cvt_pk_bf16(v0[2], v0[3]); w.z = cvt_pk_bf16(v1[0], v1[1]); w.w = cvt_pk_bf16(v1[2], v1[3]);
                        *(GAS u32x4*)(rowp + bj * HALF) = w; } }
        } else if (wc < 2) {
            const int col0 = wc * 32 + 8 * fq;
#pragma unroll
            for (int ai = 0; ai < 2; ++ai)
#pragma unroll
                for (int m = 0; m < 4; ++m) { GAS float* rowp = (GAS float*)AB + (size_t)(row0 + ai * HALF + m * 16) * 64 + col0;
                    *(GAS f32x4*)rowp = acc[ai][0][m][0]; *(GAS f32x4*)(rowp + 4) = acc[ai][0][m][1]; }
        }
    }
};
}

struct Args {
    const float* x_prompt; const float* x_sample; const float* state_gdn; const float* c; const float* c_ctx;
    const float* w_mod; const float* b_mod; const float* norm_g; const float* ffn_w_in; const float* ffn_w_out;
    const float* gdn_w_in; const float* gdn_conv; const float* gdn_a_log; const float* gdn_dt_bias; const float* gdn_norm_g; const float* gdn_w_out;
    const float* pool_w; const float* pool_scale; const float* final_g;
    float* out; unsigned char* ws;
};

struct Frame {
    LAS unsigned char* lds;
    int tid, lane, wave, vcu, G;
};

#define OPAQUE_FRAME(F) Frame F = F##_in; asm volatile("" : "+v"(F.tid), "+v"(F.lane), "+s"(F.vcu), "+s"(F.wave))
__device__ __forceinline__ void transpose_item(const float* src, int ld_src, int k0, int n0s, bf16_t* dst, int ld_dst, int n0d, LAS float* scr, int lane) {
    const GAS float* sp = (const GAS float*)src + (size_t)k0 * ld_src + n0s + (lane & 31) + (size_t)(lane >> 5) * ld_src;
#pragma unroll 8
    for (int i = 0; i < 32; ++i) { const int kk = 2 * i + (lane >> 5); scr[kk * 33 + (lane & 31)] = sp[(size_t)(2 * i) * ld_src]; }
    LDS_WAIT(); asm volatile("" ::: "memory");
    const int c = lane & 7;
#pragma unroll
    for (int j = 0; j < 4; ++j) { const int n = (lane >> 3) + 8 * j; const LAS float* s = scr + (8 * c) * 33 + n;
        u32x4 o; o.x = cvt_pk_bf16(s[0 * 33], s[1 * 33]); o.y = cvt_pk_bf16(s[2 * 33], s[3 * 33]); o.z = cvt_pk_bf16(s[4 * 33], s[5 * 33]); o.w = cvt_pk_bf16(s[6 * 33], s[7 * 33]);
        *(GAS u32x4*)((GAS bf16_t*)dst + (size_t)(n0d + n) * ld_dst + k0 + 8 * c) = o; }
    LDS_WAIT(); asm volatile("" ::: "memory");
}

__device__ __forceinline__ void sincos_small(float x, float& s, float& c) {
    const float k = rintf(x * 0.636619772367581f);
    float y = fmaf(k, -1.57079637050628662109375f, x); y = fmaf(k, 4.37113882867379e-8f, y);
    const float y2 = y * y;
    float sp = fmaf(y2, 2.7557319e-6f, -1.9841270e-4f); sp = fmaf(sp, y2, 8.3333333e-3f); sp = fmaf(sp, y2, -1.6666667e-1f); sp = fmaf(sp * y2, y, y);
    float cp = fmaf(y2, -2.7557319e-7f, 2.4801587e-5f); cp = fmaf(cp, y2, -1.3888889e-3f); cp = fmaf(cp, y2, 4.1666667e-2f); cp = fmaf(cp, y2, -0.5f); cp = fmaf(cp, y2, 1.0f);
    const int q = ((int)k) & 3;
    s = (q == 0) ? sp : (q == 1) ? cp : (q == 2) ? -sp : -cp;
    c = (q == 0) ? cp : (q == 1) ? -sp : (q == 2) ? -cp : sp;
}

__device__ __forceinline__ void prologue_a(const Frame& F_in, const Args& a) {
    OPAQUE_FRAME(F);
    unsigned char* ws = a.ws;
    LAS float* scr = (LAS float*)(F.lds + F.wave * 8704);
    LAS float* sv = (LAS float*)(F.lds + 69632);
    for (int i = F.tid; i < 3 * D; i += NWAVES * 64) { const int g = i / D, k = i % D; const float v = (g == 0) ? a.c_ctx[k] : a.c[(g - 1) * D + k]; sv[i] = v / (1.0f + expf(-v)); }
    __syncthreads();
    const int gw = F.vcu * NWAVES + F.wave, NGW = F.G * NWAVES;
    for (int t = gw; t < 4 * 72 * 8; t += NGW) {
        const int l = t / 576, rem = t % 576, cb = rem >> 3, ks = rem & 7;
        const GAS float* wp = (const GAS float*)a.w_mod + ((size_t)l * D + ks * 256) * NMODC + cb * 256 + F.lane * 4;
        f32x4 acc0 = {0.f, 0.f, 0.f, 0.f}, acc1 = acc0, acc2 = acc0;
        const LAS float* s0 = sv + ks * 256, *s1 = sv + D + ks * 256, *s2 = sv + 2 * D + ks * 256;
#pragma unroll 8
        for (int k = 0; k < 256; ++k) { const f32x4 w = *(const GAS f32x4*)(wp + (size_t)k * NMODC); acc0 += w * s0[k]; acc1 += w * s1[k]; acc2 += w * s2[k]; }
        GAS float* pp = (GAS float*)(ws + WS_MODP) + ((size_t)(ks * 4 + l) * 3) * NMODC + cb * 256 + F.lane * 4;
        *(GAS f32x4*)pp = acc0; *(GAS f32x4*)(pp + NMODC) = acc1; *(GAS f32x4*)(pp + 2 * NMODC) = acc2;
    }
    for (int m = gw; m < MTOK; m += NGW) {
        GAS f32x4* xo = (GAS f32x4*)(ws + WS_X) + (size_t)m * (D / 4) + F.lane;
        if (m < NCTX) { const GAS f32x4* xi = (const GAS f32x4*)a.x_prompt + (size_t)m * (D / 4) + F.lane;
#pragma unroll
            for (int j = 0; j < 8; ++j) xo[64 * j] = xi[64 * j];
        } else {
            const int tok = (m - NCTX) & (DSEQ - 1); const float rr = (float)(tok >> 6), cc = (float)(tok & 63);
            const GAS f32x4* xi = (const GAS f32x4*)a.x_sample + (size_t)(m - NCTX) * (D / 4) + F.lane;
#pragma unroll
            for (int j = 0; j < 8; ++j) { f32x4 v = xi[64 * j]; const int e0 = 4 * (F.lane + 64 * j), qd = e0 >> 9, f0 = e0 & 511; const float pos = (qd < 2) ? rr : cc;
#pragma unroll
                for (int i = 0; i < 4; ++i) { const float fr = expf(-9.210340371976184f * (float)(f0 + i) * (1.0f / 512.0f)); float s, c; sincos_small(pos * fr, s, c); v[i] += (qd & 1) ? c : s; }
                xo[64 * j] = v; }
        }
    }
    constexpr int I1 = 32 * 344, I2 = 86 * 64, I3 = 32 * 258, I4 = 32 * 64, I5 = 8 * 16;
    constexpr int R1 = 8 * I1, R2 = R1 + 8 * I2, R3 = R2 + 2 * I3, R4 = R3 + 2 * I4, R5 = R4 + 8 * I5, R6 = R5 + 2 * 192;
    for (int it = gw; it < R6; it += NGW) {
        if (it < R1) { const int mt = it / I1, r = it % I1, kb = r / 344, nb = r % 344, n0s = 32 * nb;
            const int n0d = (n0s < DFF) ? 256 * (n0s >> 7) + (n0s & 127) : 256 * ((n0s - DFF) >> 7) + 128 + ((n0s - DFF) & 127);
            transpose_item(a.ffn_w_in + (size_t)mt * D * NGU, NGU, 64 * kb, n0s, (bf16_t*)(ws + WS_BT1 + mt * SZ_BT1), D, n0d, scr, F.lane); }
        else if (it < R2) { const int q = it - R1, mt = q / I2, r = q % I2, kb = r >> 6, nb = r & 63;
            transpose_item(a.ffn_w_out + (size_t)mt * DFF * D, D, 64 * kb, 32 * nb, (bf16_t*)(ws + WS_BT2 + mt * SZ_BT2), DFF, 32 * nb, scr, F.lane); }
        else if (it < R3) { const int q = it - R2, mt = q / I3, r = q % I3, kb = r / 258, nb = r % 258;
            transpose_item(a.gdn_w_in + (size_t)mt * D * NPROJ, NPROJ, 64 * kb, 32 * nb, (bf16_t*)(ws + WS_BTG + mt * SZ_BTG), D, 32 * nb, scr, F.lane); }
        else if (it < R4) { const int q = it - R3, mt = q / I4, r = q % I4, kb = r >> 6, nb = r & 63;
            transpose_item(a.gdn_w_out + (size_t)mt * D * D, D, 64 * kb, 32 * nb, (bf16_t*)(ws + WS_BTO + mt * SZ_BTO), D, 32 * nb, scr, F.lane); }
        else if (it < R5) { const int q = it - R4, mg = q / I5, r = q % I5, kb = r >> 4, nb = r & 15, mi = mg >> 2, gi = mg & 3;
            transpose_item(a.pool_w + (size_t)mg * 512 * 512, 512, 64 * kb, 32 * nb, (bf16_t*)(ws + WS_BTP + mi * SZ_BTP), 512, gi * 512 + 32 * nb, scr, F.lane); }
        else { const int q = it - R5, mi = q / 192, row = NPROJ + q % 192; GAS u32x4* p = (GAS u32x4*)((GAS bf16_t*)(ws + WS_BTG + mi * SZ_BTG) + (size_t)row * D) + F.lane;
#pragma unroll
            for (int j = 0; j < 4; ++j) p[64 * j] = (u32x4){0u, 0u, 0u, 0u}; }
    }
}
__device__ __forceinline__ void prologue_b(const Frame& F_in, const Args& a) {
    OPAQUE_FRAME(F);
    const GAS float* pp = (const GAS float*)(a.ws + WS_MODP); GAS float* mo = (GAS float*)(a.ws + WS_MODS);
    for (int i = F.vcu * 512 + F.tid; i < 4 * 3 * NMODC; i += F.G * 512) {
        const int l = i / (3 * NMODC), n = i % NMODC; float s = a.b_mod[l * NMODC + n];
#pragma unroll
        for (int ks = 0; ks < 8; ++ks) s += pp[(size_t)ks * (4 * 3 * NMODC) + i];
        mo[i] = s;
    }
}

__device__ __forceinline__ void norm_phase(const Frame& F_in, const Args& a, const float* ng, const float* modbase  , int s) {
    OPAQUE_FRAME(F);
    const int gw = F.vcu * NWAVES + F.wave, NGW = F.G * NWAVES;
    const GAS f32x4* g4 = (const GAS f32x4*)ng + F.lane;
    for (int m = gw; m < MTOK; m += NGW) {
        const int grp = m < NCTX ? 0 : 1 + ((m - NCTX) >> 10);
        const GAS f32x4* xr = (const GAS f32x4*)(a.ws + WS_X) + (size_t)m * (D / 4) + F.lane;
        const GAS f32x4* sh = (const GAS f32x4*)((const GAS float*)modbase + (size_t)grp * NMODC + (3 * s) * D) + F.lane;
        const GAS f32x4* sc = sh + D / 4;
        f32x4 v[8]; float ss = 0.f;
#pragma unroll
        for (int j = 0; j < 8; ++j) { v[j] = xr[64 * j]; ss += (v[j].x * v[j].x + v[j].y * v[j].y) + (v[j].z * v[j].z + v[j].w * v[j].w); }
        const float r = 1.0f / sqrtf(wave_sum(ss) * (1.0f / D) + RMS_EPS);
        GAS u32x2* o = (GAS u32x2*)((GAS bf16_t*)(a.ws + WS_H) + (size_t)m * D) + F.lane;
#pragma unroll
        for (int j = 0; j < 8; ++j) { const f32x4 gg = g4[64 * j], s1 = sc[64 * j], s0 = sh[64 * j]; const f32x4 h = (v[j] * r * gg) * (s1 + 1.0f) + s0;
            u32x2 w; w.x = cvt_pk_bf16(h.x, h.y); w.y = cvt_pk_bf16(h.z, h.w); o[64 * j] = w; }
    }
}
__device__ __forceinline__ void final_phase(const Frame& F_in, const Args& a) {
    OPAQUE_FRAME(F);
    const int gw = F.vcu * NWAVES + F.wave, NGW = F.G * NWAVES;
    const GAS f32x4* g4 = (const GAS f32x4*)a.final_g + F.lane;
    for (int m = gw; m < MTOK; m += NGW) {
        const GAS f32x4* xr = (const GAS f32x4*)(a.ws + WS_X) + (size_t)m * (D / 4) + F.lane;
        f32x4 v[8]; float ss = 0.f;
#pragma unroll
        for (int j = 0; j < 8; ++j) { v[j] = xr[64 * j]; ss += (v[j].x * v[j].x + v[j].y * v[j].y) + (v[j].z * v[j].z + v[j].w * v[j].w); }
        const float r = 1.0f / sqrtf(wave_sum(ss) * (1.0f / D) + RMS_EPS);
        GAS f32x4* o = (GAS f32x4*)a.out + (size_t)m * (D / 4) + F.lane;
#pragma unroll
        for (int j = 0; j < 8; ++j) o[64 * j] = v[j] * r * g4[64 * j];
    }
}
__device__ __forceinline__ void rstd_phase(const Frame& F_in, const Args& a) {
    OPAQUE_FRAME(F);
    const int gw = F.vcu * NWAVES + F.wave, NGW = F.G * NWAVES;
    for (int m = gw; m < MTOK; m += NGW) {
        const GAS f32x4* xr = (const GAS f32x4*)(a.ws + WS_X) + (size_t)m * (D / 4) + F.lane;
        float ss = 0.f;
#pragma unroll
        for (int j = 0; j < 8; ++j) { const f32x4 v = xr[64 * j]; ss += (v.x * v.x + v.y * v.y) + (v.z * v.z + v.w * v.w); }
        const float r = 1.0f / sqrtf(wave_sum(ss) * (1.0f / D) + RMS_EPS);
        if (F.lane == 0) __hip_atomic_store((GAS float*)(a.ws + WS_RSTD) + m, r, __ATOMIC_RELAXED, __HIP_MEMORY_SCOPE_AGENT);
    }
}
__device__ __forceinline__ void pool_pre_phase(const Frame& F_in, const Args& a, const float* ng, const float* modbase) {
    OPAQUE_FRAME(F);
    const GAS float* X = (const GAS float*)(a.ws + WS_X); const GAS float* RS = (const GAS float*)(a.ws + WS_RSTD);
    for (int task = F.vcu * 512 + F.tid; task < 640 * 512; task += F.G * 512) {
        const int seg = task >> 9, cq = task & 511, r0 = seg * 16, col = cq * 4, gi = cq >> 7, half = 1 << gi;
        const int s0 = r0 < NCTX ? (r0 & ~(SEQ - 1)) : NCTX + ((r0 - NCTX) & ~(DSEQ - 1));
        const int s1 = s0 + (r0 < NCTX ? SEQ : DSEQ);
        const int grp = r0 < NCTX ? 0 : 1 + ((r0 - NCTX) >> 10);
        const f32x4 gs = *(const GAS f32x4*)((const GAS float*)ng + col) * (*(const GAS f32x4*)((const GAS float*)modbase + (size_t)grp * NMODC + 4 * D + col) + 1.0f);
        int lo = r0 - half; if (lo < s0) lo = s0; int hi = r0 + half; if (hi > s1) hi = s1;
        f32x4 sum = {0.f, 0.f, 0.f, 0.f};
        for (int r = lo; r < hi; ++r) sum += *(const GAS f32x4*)(X + (size_t)r * D + col) * RS[r];
        for (int t = r0; t < r0 + 16; ++t) {
            const f32x4 own = *(const GAS f32x4*)(X + (size_t)t * D + col) * RS[t];
            const float inv = 1.0f / (float)(hi - lo);
            const f32x4 o = gs * (sum * inv - own);
            u32x2 w; w.x = cvt_pk_bf16(o.x, o.y); w.y = cvt_pk_bf16(o.z, o.w);
            *(GAS u32x2*)((GAS bf16_t*)(a.ws + WS_H) + (size_t)t * D + col) = w;
            if (t + half < s1) { sum += *(const GAS f32x4*)(X + (size_t)(t + half) * D + col) * RS[t + half]; ++hi; }
            if (t - half >= s0) { sum -= *(const GAS f32x4*)(X + (size_t)(t - half) * D + col) * RS[t - half]; ++lo; }
        }
    }
}

__device__ __forceinline__ void gdn_prep_phase(const Frame& F_in, const Args& a, int mi) {
    OPAQUE_FRAME(F);
    const GAS bf16_t* P = (const GAS bf16_t*)(a.ws + WS_P); GAS bf16_t* Q = (GAS bf16_t*)(a.ws + WS_QKV);
    const int ch8 = F.tid & 15, rr = F.tid >> 4;
    for (int unit = F.vcu; unit < 160 * 16; unit += F.G) {
        const int blk = unit >> 4, h = unit & 15, r0 = blk * 64;
        const int s0 = r0 < NCTX ? (r0 & ~(SEQ - 1)) : NCTX + ((r0 - NCTX) & ~(DSEQ - 1));
        const int s1 = s0 + (r0 < NCTX ? SEQ : DSEQ);
        if (F.tid < 128) {
            const int c = F.tid & 63, dir = F.tid >> 6, tok = r0 + c;
            const GAS float* ab = (const GAS float*)(a.ws + WS_AB) + (size_t)tok * 64 + dir * 32 + h;
            const float xa = ab[0] + a.gdn_dt_bias[(mi * 2 + dir) * 16 + h], xb = ab[16];
            const float sp = (xa > 20.f) ? xa : log1pf(expf(xa));
            const float g = -expf(a.gdn_a_log[(mi * 2 + dir) * 16 + h]) * sp;
            const float be = 1.0f / (1.0f + expf(-xb));
            __hip_atomic_store((GAS float*)(a.ws + WS_GG) + ((size_t)dir * MTOK + tok) * 16 + h, g, __ATOMIC_RELAXED, __HIP_MEMORY_SCOPE_AGENT);
            __hip_atomic_store((GAS float*)(a.ws + WS_GB) + ((size_t)dir * MTOK + tok) * 16 + h, be, __ATOMIC_RELAXED, __HIP_MEMORY_SCOPE_AGENT);
        }
#pragma unroll 1
        for (int ten = 0; ten < 3; ++ten) {
            const int chan = ten * D + h * DKV + ch8 * 8;
            float w[5][8];
#pragma unroll
            for (int j = 0; j < 5; ++j) { const GAS f32x4* wp = (const GAS f32x4*)((const GAS float*)a.gdn_conv + ((size_t)mi * 5 + j) * NQKV + chan); const f32x4 w0 = wp[0], w1 = wp[1];
                w[j][0] = w0.x; w[j][1] = w0.y; w[j][2] = w0.z; w[j][3] = w0.w; w[j][4] = w1.x; w[j][5] = w1.y; w[j][6] = w1.z; w[j][7] = w1.w; }
#pragma unroll
            for (int ps = 0; ps < 2; ++ps) {
                const int tok = r0 + rr + 32 * ps;
                float acc[8] = {0.f, 0.f, 0.f, 0.f, 0.f, 0.f, 0.f, 0.f};
#pragma unroll
                for (int j = 0; j < 5; ++j) { const int t = tok + j - 2;
                    u32x4 u = {0u, 0u, 0u, 0u}; if (t >= s0 && t < s1) u = *(const GAS u32x4*)(P + (size_t)t * 8192 + chan);
                    acc[0] = fmaf(bf_lo(u.x), w[j][0], acc[0]); acc[1] = fmaf(bf_hi(u.x), w[j][1], acc[1]); acc[2] = fmaf(bf_lo(u.y), w[j][2], acc[2]); acc[3] = fmaf(bf_hi(u.y), w[j][3], acc[3]);
                    acc[4] = fmaf(bf_lo(u.z), w[j][4], acc[4]); acc[5] = fmaf(bf_hi(u.z), w[j][5], acc[5]); acc[6] = fmaf(bf_lo(u.w), w[j][6], acc[6]); acc[7] = fmaf(bf_hi(u.w), w[j][7], acc[7]); }
                float ss = 0.f;
#pragma unroll
                for (int i = 0; i < 8; ++i) { acc[i] = silu_f(acc[i]); ss += acc[i] * acc[i]; }
                if (ten < 2) {
                    ss += __shfl_xor(ss, 1); ss += __shfl_xor(ss, 2); ss += __shfl_xor(ss, 4); ss += __shfl_xor(ss, 8);
                    float sc = 1.0f / sqrtf(ss + L2_EPS); if (ten == 0) sc *= 0.08838834764831845f;
#pragma unroll
                    for (int i = 0; i < 8; ++i) acc[i] *= sc;
                }
                u32x4 o; o.x = cvt_pk_bf16(acc[0], acc[1]); o.y = cvt_pk_bf16(acc[2], acc[3]); o.z = cvt_pk_bf16(acc[4], acc[5]); o.w = cvt_pk_bf16(acc[6], acc[7]);
                *(GAS u32x4*)(Q + (size_t)tok * NQKV + chan) = o;
            }
        }
    }
}
__device__ __forceinline__ void gdn_post_phase(const Frame& F_in, const Args& a, int mi) {
    OPAQUE_FRAME(F);
    const int gw = F.vcu * NWAVES + F.wave, NGW = F.G * NWAVES;
    const GAS float* O0 = (const GAS float*)(a.ws + WS_O); const GAS float* O1 = O0 + (size_t)MTOK * D;
    for (int m = gw; m < MTOK; m += NGW) {
#pragma unroll
        for (int j = 0; j < 8; ++j) {
            const int e0 = 4 * (F.lane + 64 * j);
            const f32x4 o = *(const GAS f32x4*)(O0 + (size_t)m * D + e0) + *(const GAS f32x4*)(O1 + (size_t)m * D + e0);
            float ss = (o.x * o.x + o.y * o.y) + (o.z * o.z + o.w * o.w);
            ss += __shfl_xor(ss, 1); ss += __shfl_xor(ss, 2); ss += __shfl_xor(ss, 4); ss += __shfl_xor(ss, 8); ss += __shfl_xor(ss, 16);
            const float r = 1.0f / sqrtf(ss * (1.0f / DKV) + RMS_EPS);
            const f32x4 ng = *(const GAS f32x4*)((const GAS float*)a.gdn_norm_g + mi * DKV + (e0 & 127));
            const u32x2 zz = *(const GAS u32x2*)((const GAS bf16_t*)(a.ws + WS_P) + (size_t)m * 8192 + NQKV + e0);
            f32x4 v = o * r * ng; v.x *= silu_f(bf_lo(zz.x)); v.y *= silu_f(bf_hi(zz.x)); v.z *= silu_f(bf_lo(zz.y)); v.w *= silu_f(bf_hi(zz.y));
            u32x2 w; w.x = cvt_pk_bf16(v.x, v.y); w.y = cvt_pk_bf16(v.z, v.w);
            *(GAS u32x2*)((GAS bf16_t*)(a.ws + WS_H) + (size_t)m * D + e0) = w;
        }
    }
}

constexpr int SC_Z = 0, SC_Q = 34816, SC_K = 52224, SC_V = 69632, SC_AKK = 88064, SC_TW = 106496, SC_TU = 115712, SC_AQK = 124928, SC_WN = 134144, SC_G = 151552, SC_XS = 153600, TKS = 272;
__device__ __forceinline__ int off256(int row, int cb) { return row * 272 + cb; }
__device__ __forceinline__ int off128(int row, int cb) { return row * 144 + cb; }
__device__ __forceinline__ bf16x8 ldf256(LAS unsigned char* base, int row0, int ks, int fr, int fq) { return *(const LAS bf16x8*)(base + off256(row0 + fr, 64 * ks + 16 * fq)); }
__device__ __forceinline__ bf16x8 ldf128(LAS unsigned char* base, int row0, int ks, int fr, int fq) { return *(const LAS bf16x8*)(base + off128(row0 + fr, 64 * ks + 16 * fq)); }
__device__ __forceinline__ bf16x8 ldtr256(LAS unsigned char* base, int n0, int ks, int fr, int fq) {
    const int q = fr >> 2, p = fr & 3, r = 32 * ks + 8 * fq + q, cb = 2 * (n0 + 4 * p);
    const bf16x4 lo = __builtin_amdgcn_ds_read_tr16_b64_v4i16((LAS bf16x4*)(base + off256(r, cb)));
    const bf16x4 hi = __builtin_amdgcn_ds_read_tr16_b64_v4i16((LAS bf16x4*)(base + off256(r + 4, cb)));
    return __builtin_shufflevector(lo, hi, 0, 1, 2, 3, 4, 5, 6, 7);
}
#define MFMA16(a, b, c) __builtin_amdgcn_mfma_f32_16x16x32_bf16(a, b, c, 0, 0, 0)

__device__ __forceinline__ void scan_item(const Frame& F, const Args& a, int mi, int islat, int b, int h, int dir) {
    LAS unsigned char* L = F.lds;
#define SCAN_BAR() do { asm volatile("s_waitcnt lgkmcnt(0)" ::: "memory"); __builtin_amdgcn_s_barrier(); asm volatile("" ::: "memory"); } while (0)
    const int w = F.wave; int lane0 = F.lane; int tid0 = F.tid; asm volatile("" : "+v"(lane0), "+v"(tid0));
    const int T = islat ? DSEQ : SEQ, t0 = islat ? NCTX + b * DSEQ : b * SEQ, nchunk = T / CHUNK;
    const GAS bf16_t* Qc = (const GAS bf16_t*)(a.ws + WS_QKV);
    GAS float* Og = (GAS float*)(a.ws + WS_O) + (size_t)dir * MTOK * D;
    const GAS float* GGp = (const GAS float*)(a.ws + WS_GG) + (size_t)dir * MTOK * 16 + h;
    const GAS float* GBp = (const GAS float*)(a.ws + WS_GB) + (size_t)dir * MTOK * 16 + h;
    f32x4 accz[8];
    { const int fr = lane0 & 15, fq = lane0 >> 4;
    if (islat) {
        const GAS float* sp = (const GAS float*)a.state_gdn + ((((size_t)b * 2 + mi) * 2 + dir) * 16 + h) * (DKV * DKV);
#pragma unroll
        for (int dkt = 0; dkt < 8; ++dkt)
#pragma unroll
            for (int r = 0; r < 4; ++r) accz[dkt][r] = sp[(size_t)(16 * dkt + 4 * fq + r) * DKV + 16 * w + fr];
    } else {
#pragma unroll
        for (int dkt = 0; dkt < 8; ++dkt) accz[dkt] = (f32x4){0.f, 0.f, 0.f, 0.f};
    }
#pragma unroll
    for (int dkt = 0; dkt < 8; ++dkt) { u32x2 z; z.x = cvt_pk_bf16(accz[dkt][0], accz[dkt][1]); z.y = cvt_pk_bf16(accz[dkt][2], accz[dkt][3]);
        *(LAS u32x2*)(L + SC_Z + off256(16 * w + fr, 2 * (16 * dkt + 4 * fq))) = z; } }
    u32x4 pq[2], pk[2], pv[2]; float pg = 0.f, pb = 0.f;
#define SCAN_PREFETCH(nn) do { _Pragma("unroll") for (int ps = 0; ps < 2; ++ps) { const int c_ = rr + 32 * ps; const int tok_ = dir ? t0 + T - 1 - (64 * (nn) + c_) : t0 + 64 * (nn) + c_; \
            const GAS bf16_t* src_ = Qc + (size_t)tok_ * NQKV + h * DKV + ch8 * 8; pq[ps] = *(const GAS u32x4*)src_; pk[ps] = *(const GAS u32x4*)(src_ + D); pv[ps] = *(const GAS u32x4*)(src_ + 2 * D); } \
        if (w == 0) { const int tok_ = dir ? t0 + T - 1 - (64 * (nn) + lane) : t0 + 64 * (nn) + lane; pg = GGp[(size_t)tok_ * 16]; pb = GBp[(size_t)tok_ * 16]; } } while (0)
    { const int lane = lane0, ch8 = tid0 & 15, rr = tid0 >> 4; SCAN_PREFETCH(0); }

    for (int n = 0; n < nchunk; ++n) {
        LAS unsigned char *bZ = L + SC_Z, *bQ = L + SC_Q, *bK = L + SC_K, *bV = L + SC_V, *bAKK = L + SC_AKK, *bAQK = L + SC_AQK, *bWN = L + SC_WN, *bXS = L + SC_XS, *bG = L + SC_G;
        int lane = lane0, tid = tid0;
        asm volatile("" : "+v"(bZ), "+v"(bQ), "+v"(bK), "+v"(bV), "+v"(bAKK), "+v"(bAQK), "+v"(bWN), "+v"(bXS), "+v"(bG), "+v"(lane), "+v"(tid));
        const int fr = lane & 15, fq = lane >> 4, ch8 = tid & 15, rr = tid >> 4;
        LAS float* gam = (LAS float*)bG; LAS float* bet = gam + 64; LAS float* eg = gam + 128; LAS float* edl = gam + 192; LAS float* fwv = gam + 256; LAS float* fuv = gam + 320;
        if (w == 0) {
            float cs = pg;
#pragma unroll
            for (int o = 1; o < 64; o <<= 1) { const float t = __shfl_up(cs, o); if (lane >= o) cs += t; }
            const float last = __shfl(cs, 63);
            const float e = fast_exp(cs);
            gam[lane] = cs; bet[lane] = pb; eg[lane] = e; edl[lane] = fast_exp(last - cs); fwv[lane] = pb * e; fuv[lane] = pb;
        }
#pragma unroll
        for (int ps = 0; ps < 2; ++ps) { const int o = off256(rr + 32 * ps, ch8 * 16);
            *(LAS u32x4*)(bQ + o) = pq[ps]; *(LAS u32x4*)(bK + o) = pk[ps]; *(LAS u32x4*)(bV + o) = pv[ps]; }
        SCAN_BAR();
        if (n + 1 < nchunk) SCAN_PREFETCH(n + 1);
        {
            const int tsel = w >> 2, st = w & 3;
            LAS unsigned char* Bsrc = tsel ? bQ : bK;
            bf16x8 af[4], bfr[4][4];
#pragma unroll
            for (int ks = 0; ks < 4; ++ks) af[ks] = ldf256(bK, 16 * st, ks, fr, fq);
#pragma unroll
            for (int ct = 0; ct < 4; ++ct)
#pragma unroll
                for (int ks = 0; ks < 4; ++ks) bfr[ct][ks] = ldf256(Bsrc, 16 * ct, ks, fr, fq);
            const int s0 = 16 * st + 4 * fq;
            const f32x4 gs4 = *(const LAS f32x4*)(gam + s0);
            float gc[4], bc[4];
#pragma unroll
            for (int ct = 0; ct < 4; ++ct) { gc[ct] = gam[16 * ct + fr]; bc[ct] = bet[16 * ct + fr]; }
            f32x4 acc[4];
#pragma unroll
            for (int ct = 0; ct < 4; ++ct) { acc[ct] = (f32x4){0.f, 0.f, 0.f, 0.f};
#pragma unroll
                for (int ks = 0; ks < 4; ++ks) acc[ct] = MFMA16(af[ks], bfr[ct][ks], acc[ct]); }
#pragma unroll
            for (int ct = 0; ct < 4; ++ct) {
                const int c = 16 * ct + fr;
                f32x4 o;
#pragma unroll
                for (int r = 0; r < 4; ++r) { const int s = s0 + r; const float e = fast_exp(gc[ct] - gs4[r]);
                    const float vq = (c >= s) ? acc[ct][r] * e : 0.f, vk = (c > s) ? bc[ct] * acc[ct][r] * e : 0.f; o[r] = tsel ? vq : vk; }
                if (tsel) { u32x2 wv; wv.x = cvt_pk_bf16(o[0], o[1]); wv.y = cvt_pk_bf16(o[2], o[3]); *(LAS u32x2*)(bAQK + off128(c, 2 * s0)) = wv; }
                else *(LAS f32x4*)(bAKK + c * TKS + s0 * 4) = o;
            }
        }
        SCAN_BAR();
        if (w == 0) {
            const int g = fq, j = fr;
            {
                LAS unsigned char* bb = bAKK + g * (16 * TKS + 64);
                float t[16]; t[0] = 0.f;
#define D1_BATCH(c_lo, c_hi) { f32x4 rv[16][4]; float aj[16]; \
                    _Pragma("unroll") for (int c = c_lo; c < c_hi; ++c) { aj[c] = *(const LAS float*)(bb + c * TKS + j * 4); \
                        _Pragma("unroll") for (int q = 0; q < 4; ++q) if (4 * q < c) rv[c][q] = *(const LAS f32x4*)(bb + c * TKS + q * 16); } \
                    _Pragma("unroll") for (int c = c_lo; c < c_hi; ++c) { float a0 = -aj[c], a1 = 0.f; \
                        _Pragma("unroll") for (int s = 0; s < c; ++s) { if (s & 1) a1 = fmaf(-rv[c][s >> 2][s & 3], t[s], a1); else a0 = fmaf(-rv[c][s >> 2][s & 3], t[s], a0); } \
                        t[c] = a0 + a1; } \
                    asm volatile("" : "+v"(t[c_hi - 1])); }
                D1_BATCH(1, 6) D1_BATCH(6, 11) D1_BATCH(11, 16)
#undef D1_BATCH
#pragma unroll
                for (int c = 0; c < 16; ++c) *(LAS float*)(bb + c * TKS + j * 4) = t[c];
                *(LAS float*)(bb + j * TKS + j * 4) = 1.0f;
            }
#define TA(r_, c_) (*(const LAS float*)(bAKK + (r_) * TKS + (c_) * 4))
#define XSA(r_, c_) (*(LAS float*)(bXS + (r_) * 128 + (c_) * 4))
#define MF32(a_, b_, c_) __builtin_amdgcn_mfma_f32_16x16x4f32(a_, b_, c_, 0, 0, 0)
            {
                f32x4 x0 = {0.f, 0.f, 0.f, 0.f}, x1 = x0;
#pragma unroll
                for (int kk = 0; kk < 4; ++kk) { x0 = MF32(TA(16 + j, 4 * kk + g), TA(4 * kk + g, j), x0); x1 = MF32(TA(48 + j, 32 + 4 * kk + g), TA(32 + 4 * kk + g, 32 + j), x1); }
#pragma unroll
                for (int r = 0; r < 4; ++r) { XSA(4 * g + r, j) = x0[r]; XSA(16 + 4 * g + r, j) = x1[r]; }
                f32x4 y0 = {0.f, 0.f, 0.f, 0.f}, y1 = y0;
#pragma unroll
                for (int kk = 0; kk < 4; ++kk) { y0 = MF32(TA(16 + j, 16 + 4 * kk + g), XSA(4 * kk + g, j), y0); y1 = MF32(TA(48 + j, 48 + 4 * kk + g), XSA(16 + 4 * kk + g, j), y1); }
#pragma unroll
                for (int r = 0; r < 4; ++r) { *(LAS float*)(bAKK + (16 + 4 * g + r) * TKS + j * 4) = -y0[r]; *(LAS float*)(bAKK + (48 + 4 * g + r) * TKS + (32 + j) * 4) = -y1[r]; }
            }
            {
                f32x4 y[2][2];
#pragma unroll
                for (int rt = 0; rt < 2; ++rt)
#pragma unroll
                    for (int ct = 0; ct < 2; ++ct) { y[rt][ct] = (f32x4){0.f, 0.f, 0.f, 0.f};
#pragma unroll
                        for (int kk = 4 * ct; kk < 8; ++kk) y[rt][ct] = MF32(TA(32 + 16 * rt + j, 4 * kk + g), TA(4 * kk + g, 16 * ct + j), y[rt][ct]); }
#pragma unroll
                for (int rt = 0; rt < 2; ++rt)
#pragma unroll
                    for (int ct = 0; ct < 2; ++ct)
#pragma unroll
                        for (int r = 0; r < 4; ++r) XSA(16 * rt + 4 * g + r, 16 * ct + j) = y[rt][ct][r];
                f32x4 z[2][2];
#pragma unroll
                for (int rt = 0; rt < 2; ++rt)
#pragma unroll
                    for (int ct = 0; ct < 2; ++ct) { z[rt][ct] = (f32x4){0.f, 0.f, 0.f, 0.f};
#pragma unroll
                        for (int kk = 0; kk < 4 * (rt + 1); ++kk) z[rt][ct] = MF32(TA(32 + 16 * rt + j, 32 + 4 * kk + g), XSA(4 * kk + g, 16 * ct + j), z[rt][ct]); }
#pragma unroll
                for (int rt = 0; rt < 2; ++rt)
#pragma unroll
                    for (int ct = 0; ct < 2; ++ct)
#pragma unroll
                        for (int r = 0; r < 4; ++r) *(LAS float*)(bAKK + (32 + 16 * rt + 4 * g + r) * TKS + (16 * ct + j) * 4) = -z[rt][ct][r];
            }
#undef TA
#undef XSA
#undef MF32
        }
        SCAN_BAR();
        f32x4 accu[4];
        {
            bf16x8 kt[2], vt[2]; f32x4 tv[4][2][2], fw4[2][2], fu4[2][2];
#pragma unroll
            for (int ks = 0; ks < 2; ++ks) { kt[ks] = ldtr256(bK, 16 * w, ks, fr, fq); vt[ks] = ldtr256(bV, 16 * w, ks, fr, fq);
#pragma unroll
                for (int hh = 0; hh < 2; ++hh) { fw4[ks][hh] = *(const LAS f32x4*)(fwv + 32 * ks + 8 * fq + 4 * hh); fu4[ks][hh] = *(const LAS f32x4*)(fuv + 32 * ks + 8 * fq + 4 * hh); } }
#pragma unroll
            for (int ct = 0; ct < 4; ++ct)
#pragma unroll
                for (int ks = 0; ks < 2; ++ks) { const LAS f32x4* tp = (const LAS f32x4*)(bAKK + (16 * ct + fr) * TKS + (32 * ks + 8 * fq) * 4); tv[ct][ks][0] = tp[0]; tv[ct][ks][1] = tp[1]; }
            f32x4 aw[4];
#pragma unroll
            for (int ct = 0; ct < 4; ++ct) {
                aw[ct] = (f32x4){0.f, 0.f, 0.f, 0.f}; accu[ct] = (f32x4){0.f, 0.f, 0.f, 0.f};
#pragma unroll
                for (int ks = 0; ks < 2; ++ks) {
                    const f32x4 w0 = tv[ct][ks][0] * fw4[ks][0], w1 = tv[ct][ks][1] * fw4[ks][1], u0 = tv[ct][ks][0] * fu4[ks][0], u1 = tv[ct][ks][1] * fu4[ks][1];
                    u32x4 tw, tu; tw.x = cvt_pk_bf16(w0[0], w0[1]); tw.y = cvt_pk_bf16(w0[2], w0[3]); tw.z = cvt_pk_bf16(w1[0], w1[1]); tw.w = cvt_pk_bf16(w1[2], w1[3]);
                    tu.x = cvt_pk_bf16(u0[0], u0[1]); tu.y = cvt_pk_bf16(u0[2], u0[3]); tu.z = cvt_pk_bf16(u1[0], u1[1]); tu.w = cvt_pk_bf16(u1[2], u1[3]);
                    aw[ct] = MFMA16(kt[ks], __builtin_bit_cast(bf16x8, tw), aw[ct]); accu[ct] = MFMA16(__builtin_bit_cast(bf16x8, tu), vt[ks], accu[ct]);
                }
            }
#pragma unroll
            for (int ct = 0; ct < 4; ++ct) { u32x2 wv; wv.x = cvt_pk_bf16(-aw[ct][0], -aw[ct][1]); wv.y = cvt_pk_bf16(-aw[ct][2], -aw[ct][3]);
                *(LAS u32x2*)(bWN + off256(16 * ct + fr, 2 * (16 * w + 4 * fq))) = wv; }
        }
        SCAN_BAR();
        {
            bf16x8 zf[4];
            {
                bf16x8 wf[4][4]; f32x4 ed[4];
#pragma unroll
                for (int ks = 0; ks < 4; ++ks) zf[ks] = ldf256(bZ, 16 * w, ks, fr, fq);
#pragma unroll
                for (int ct = 0; ct < 4; ++ct) { ed[ct] = *(const LAS f32x4*)(edl + 16 * ct + 4 * fq);
#pragma unroll
                    for (int ks = 0; ks < 4; ++ks) wf[ct][ks] = ldf256(bWN, 16 * ct, ks, fr, fq); }
#pragma unroll
                for (int ct = 0; ct < 4; ++ct)
#pragma unroll
                    for (int ks = 0; ks < 4; ++ks) accu[ct] = MFMA16(wf[ct][ks], zf[ks], accu[ct]);
#pragma unroll
                for (int ct = 0; ct < 4; ++ct) {
                    const int c0 = 16 * ct + 4 * fq, dv = 16 * w + fr;
                    u32x2 v1, v2; v1.x = cvt_pk_bf16(accu[ct][0], accu[ct][1]); v1.y = cvt_pk_bf16(accu[ct][2], accu[ct][3]);
                    v2.x = cvt_pk_bf16(accu[ct][0] * ed[ct][0], accu[ct][1] * ed[ct][1]); v2.y = cvt_pk_bf16(accu[ct][2] * ed[ct][2], accu[ct][3] * ed[ct][3]);
                    *(LAS u32x2*)(bV + off128(dv, 2 * c0)) = v1; *(LAS u32x2*)(bAKK + off128(dv, 2 * c0)) = v2;
                }
            }
            f32x4 ao[4];
            {
                bf16x8 qf[4][4]; float egc[4];
#pragma unroll
                for (int ct = 0; ct < 4; ++ct) { egc[ct] = eg[16 * ct + fr];
#pragma unroll
                    for (int ks = 0; ks < 4; ++ks) qf[ct][ks] = ldf256(bQ, 16 * ct, ks, fr, fq); }
#pragma unroll
                for (int ct = 0; ct < 4; ++ct) { ao[ct] = (f32x4){0.f, 0.f, 0.f, 0.f};
#pragma unroll
                    for (int ks = 0; ks < 4; ++ks) ao[ct] = MFMA16(zf[ks], qf[ct][ks], ao[ct]);
                    ao[ct] = ao[ct] * egc[ct]; }
            }
            bf16x8 vd[2];
            {
                bf16x8 vf[2], aq[4][2];
#pragma unroll
                for (int ks = 0; ks < 2; ++ks) { vf[ks] = ldf128(bV, 16 * w, ks, fr, fq); vd[ks] = ldf128(bAKK, 16 * w, ks, fr, fq);
#pragma unroll
                    for (int ct = 0; ct < 4; ++ct) aq[ct][ks] = ldf128(bAQK, 16 * ct, ks, fr, fq); }
#pragma unroll
                for (int ct = 0; ct < 4; ++ct) {
#pragma unroll
                    for (int ks = 0; ks < 2; ++ks) ao[ct] = MFMA16(vf[ks], aq[ct][ks], ao[ct]);
                    const int c = 16 * ct + fr; const int tok = dir ? t0 + T - 1 - (64 * n + c) : t0 + 64 * n + c;
                    *(GAS f32x4*)(Og + (size_t)tok * D + h * DKV + 16 * w + 4 * fq) = ao[ct];
                }
            }
            {
                const float cdec = eg[63];
                bf16x8 ktr[8][2];
#pragma unroll
                for (int dkt = 0; dkt < 8; ++dkt)
#pragma unroll
                    for (int ks = 0; ks < 2; ++ks) ktr[dkt][ks] = ldtr256(bK, 16 * dkt, ks, fr, fq);
#pragma unroll
                for (int dkt = 0; dkt < 8; ++dkt) {
                    accz[dkt] = accz[dkt] * cdec;
#pragma unroll
                    for (int ks = 0; ks < 2; ++ks) accz[dkt] = MFMA16(ktr[dkt][ks], vd[ks], accz[dkt]);
                }
#pragma unroll
                for (int dkt = 0; dkt < 8; ++dkt) { u32x2 z; z.x = cvt_pk_bf16(accz[dkt][0], accz[dkt][1]); z.y = cvt_pk_bf16(accz[dkt][2], accz[dkt][3]);
                    *(LAS u32x2*)(bZ + off256(16 * w + fr, 2 * (16 * dkt + 4 * fq))) = z; }
            }
        }
        SCAN_BAR();
    }
#undef SCAN_PREFETCH
#undef SCAN_BAR
    if (!islat) {
        const int fr = lane0 & 15, fq = lane0 >> 4;
        GAS float* sp = (GAS float*)a.out + (size_t)MTOK * D + ((((size_t)b * 2 + mi) * 2 + dir) * 16 + h) * (DKV * DKV);
#pragma unroll
        for (int dkt = 0; dkt < 8; ++dkt)
#pragma unroll
            for (int r = 0; r < 4; ++r) sp[(size_t)(16 * dkt + 4 * fq + r) * DKV + 16 * w + fr] = accz[dkt][r];
    }
}
__device__ __forceinline__ void gdn_scan_phase(const Frame& F, const Args& a, int mi) {
    const int c = F.vcu;
    const int nit = (F.G == 256) ? (c < 64 ? 2 : 5) : (64 + 1024 - c + F.G - 1) / F.G;
    for (int j = 0; j < nit; ++j) {
        int i;
        if (F.G == 256) i = (c < 64) ? (j == 0 ? c : 64 + c) : 64 + 64 + (c - 64) * 5 + j; else i = c + j * F.G;
        const int islat = i < 64; const int q = islat ? i : i - 64;
        scan_item(F, a, mi, islat, q >> 5, (q >> 1) & 15, q & 1);
    }
}

__global__ void __launch_bounds__(NWAVES * 64, 2) fwd_kernel(Args a) {
    extern __shared__ __attribute__((aligned(16))) unsigned char lds_raw[];
    Frame F;
    F.lds = (LAS unsigned char*)lds_raw;
    F.tid = threadIdx.x; F.lane = F.tid & 63; F.wave = __builtin_amdgcn_readfirstlane(F.tid >> 6);
    F.G = gridDim.x; { const int bx = blockIdx.x; F.vcu = (F.G % 8 == 0) ? (bx % 8) * (F.G / 8) + bx / 8 : bx; }
    volatile LAS unsigned* MISC = (volatile LAS unsigned*)(F.lds + MISC_OFF);
    for (int u = F.tid; u < (LDS_BYTES - MISC_OFF) / 4; u += NWAVES * 64) MISC[u] = 0u;
    __syncthreads();
    unsigned char* ws = a.ws;
    XcdBarrier bar = xcd_barrier_post((unsigned*)(ws + WS_CTL) + 4096, MISC + 8);
#define GRID_BAR() xcd_barrier(bar)
    const float* mods = (const float*)(ws + WS_MODS);

    prologue_a(F, a);
    GRID_BAR();
    prologue_b(F, a);
    GRID_BAR();

    for (int l = 0; l < DEPTH; ++l) {
        const float* modl = mods + (size_t)l * 3 * NMODC;
        const int mi = l >> 1;
        norm_phase(F, a, a.norm_g + (size_t)(l * 3 + 0) * D, modl, 0);
        GRID_BAR();
        { pg8::Gemm g{(const bf16_t*)(ws + WS_H), (const bf16_t*)(ws + WS_BT1 + (size_t)(l * 2 + 0) * SZ_BT1), D, D, D};
          pg8::StaticOrder S; S.init(MTOK / 256, NGU / 256, F.G, (int)blockIdx.x, 0);
          pg8::EpiSwiGLU E{(bf16_t*)(ws + WS_ACT)};
          pg8::gemm_phase<pg8::EpiSwiGLU>(F.lds, g, S, E); }
        GRID_BAR();
        { pg8::Gemm g{(const bf16_t*)(ws + WS_ACT), (const bf16_t*)(ws + WS_BT2 + (size_t)(l * 2 + 0) * SZ_BT2), DFF, DFF, DFF};
          pg8::StaticOrder S; S.init(MTOK / 256, D / 256, F.G, (int)blockIdx.x, 0);
          pg8::EpiResid E{(float*)(ws + WS_X), modl + 2 * D, nullptr, 0.5f};
          pg8::gemm_phase<pg8::EpiResid>(F.lds, g, S, E); }
        GRID_BAR();
        if ((l & 1) == 0) {
            norm_phase(F, a, a.norm_g + (size_t)(l * 3 + 1) * D, modl, 1);
            GRID_BAR();
            { pg8::Gemm g{(const bf16_t*)(ws + WS_H), (const bf16_t*)(ws + WS_BTG + (size_t)mi * SZ_BTG), D, D, D};
              pg8::StaticOrder S; S.init(MTOK / 256, NPROJ_PAD / 256, F.G, (int)blockIdx.x, 0);
              pg8::EpiProj E{(bf16_t*)(ws + WS_P), (float*)(ws + WS_AB)};
              pg8::gemm_phase<pg8::EpiProj>(F.lds, g, S, E); }
            GRID_BAR();
            gdn_prep_phase(F, a, mi);
            GRID_BAR();
            gdn_scan_phase(F, a, mi);
            GRID_BAR();
            gdn_post_phase(F, a, mi);
            GRID_BAR();
            { pg8::Gemm g{(const bf16_t*)(ws + WS_H), (const bf16_t*)(ws + WS_BTO + (size_t)mi * SZ_BTO), D, D, D};
              pg8::StaticOrder S; S.init(MTOK / 256, D / 256, F.G, (int)blockIdx.x, 0);
              pg8::EpiResid E{(float*)(ws + WS_X), modl + 5 * D, nullptr, 1.0f};
              pg8::gemm_phase<pg8::EpiResid>(F.lds, g, S, E); }
            GRID_BAR();
        } else {
            rstd_phase(F, a);
            GRID_BAR();
            pool_pre_phase(F, a, a.norm_g + (size_t)(l * 3 + 1) * D, modl);
            GRID_BAR();
            { pg8::Gemm g{(const bf16_t*)(ws + WS_H), (const bf16_t*)(ws + WS_BTP + (size_t)mi * SZ_BTP), D, 512, 512};
              pg8::StaticOrder S; S.init(MTOK / 256, D / 256, F.G, (int)blockIdx.x, 1);
              pg8::EpiResid E{(float*)(ws + WS_X), modl + 5 * D, a.pool_scale + (size_t)mi * D, 1.0f};
              pg8::gemm_phase<pg8::EpiResid>(F.lds, g, S, E); }
            GRID_BAR();
        }
        norm_phase(F, a, a.norm_g + (size_t)(l * 3 + 2) * D, modl, 2);
        GRID_BAR();
        { pg8::Gemm g{(const bf16_t*)(ws + WS_H), (const bf16_t*)(ws + WS_BT1 + (size_t)(l * 2 + 1) * SZ_BT1), D, D, D};
          pg8::StaticOrder S; S.init(MTOK / 256, NGU / 256, F.G, (int)blockIdx.x, 0);
          pg8::EpiSwiGLU E{(bf16_t*)(ws + WS_ACT)};
          pg8::gemm_phase<pg8::EpiSwiGLU>(F.lds, g, S, E); }
        GRID_BAR();
        { pg8::Gemm g{(const bf16_t*)(ws + WS_ACT), (const bf16_t*)(ws + WS_BT2 + (size_t)(l * 2 + 1) * SZ_BT2), DFF, DFF, DFF};
          pg8::StaticOrder S; S.init(MTOK / 256, D / 256, F.G, (int)blockIdx.x, 0);
          pg8::EpiResid E{(float*)(ws + WS_X), modl + 8 * D, nullptr, 0.5f};
          pg8::gemm_phase<pg8::EpiResid>(F.lds, g, S, E); }
        GRID_BAR();
    }
    final_phase(F, a);
}

extern "C" void kernel_launch(void* const* d_in, const int* in_sizes, int n_in, void* d_out, int out_size, void* d_ws, size_t ws_size, hipStream_t stream) {
    static int grid = 0;
    if (grid == 0) {
        if (n_in != 19 || ws_size < WS_END) { fprintf(stderr, "kernel_launch: unexpected n_in %d or ws_size %zu (need %zu)\n", n_in, ws_size, (size_t)WS_END); grid = -1; return; }
        int dev = 0, cus = 0, per_cu = 0;
        if (hipGetDevice(&dev) != hipSuccess || hipDeviceGetAttribute(&cus, hipDeviceAttributeMultiprocessorCount, dev) != hipSuccess) { grid = -1; return; }
        if (hipFuncSetAttribute((const void*)fwd_kernel, hipFuncAttributeMaxDynamicSharedMemorySize, LDS_BYTES) != hipSuccess) { fprintf(stderr, "kernel_launch: hipFuncSetAttribute failed\n"); grid = -1; return; }
        if (hipOccupancyMaxActiveBlocksPerMultiprocessor(&per_cu, (const void*)fwd_kernel, NWAVES * 64, LDS_BYTES) != hipSuccess || per_cu < 1) { fprintf(stderr, "kernel_launch: occupancy query says %d\n", per_cu); }
        (void)hipGetLastError();
        grid = cus;
    }
    if (grid < 0) return;
    (void)hipMemsetAsync((char*)d_ws + WS_CTL, 0, CTL_ZERO_BYTES, stream);
    Args a{};
    a.x_prompt = (const float*)d_in[0]; a.x_sample = (const float*)d_in[1]; a.state_gdn = (const float*)d_in[2]; a.c = (const float*)d_in[3]; a.c_ctx = (const float*)d_in[4];
    a.w_mod = (const float*)d_in[5]; a.b_mod = (const float*)d_in[6]; a.norm_g = (const float*)d_in[7]; a.ffn_w_in = (const float*)d_in[8]; a.ffn_w_out = (const float*)d_in[9];
    a.gdn_w_in = (const float*)d_in[10]; a.gdn_conv = (const float*)d_in[11]; a.gdn_a_log = (const float*)d_in[12]; a.gdn_dt_bias = (const float*)d_in[13]; a.gdn_norm_g = (const float*)d_in[14]; a.gdn_w_out = (const float*)d_in[15];
    a.pool_w = (const float*)d_in[16]; a.pool_scale = (const float*)d_in[17]; a.final_g = (const float*)d_in[18];
    a.out = (float*)d_out; a.ws = (unsigned char*)d_ws;
    hipLaunchKernelGGL(fwd_kernel, dim3(grid), dim3(NWAVES * 64), LDS_BYTES, stream, a);
}
```

```cpp
#include <hip/hip_runtime.h>
#include <cstdio>
#include <cstdint>

#define GAS __attribute__((address_space(1)))
#define LAS __attribute__((address_space(3)))
typedef unsigned short bf16_t;
typedef short bf16x8 __attribute__((ext_vector_type(8)));
typedef short bf16x4 __attribute__((ext_vector_type(4)));
typedef float f32x4 __attribute__((ext_vector_type(4)));
typedef float f32x2 __attribute__((ext_vector_type(2)));
typedef unsigned u32x4 __attribute__((ext_vector_type(4)));
typedef unsigned u32x2 __attribute__((ext_vector_type(2)));

constexpr int D = 2048, NCTX = 8192, NLAT = 2048, MTOK = 10240, DEPTH = 4, DFF = 5504, NGU = 11008;
constexpr int NPROJ = 8256, NPROJ_PAD = 8448, NMOD = 9, NQKV = 6144, NMODC = NMOD * D;
constexpr int SEQ = 256, DSEQ = 1024, NB = 32, NDB = 2, HEADS = 16, DKV = 128, CHUNK = 64;
constexpr float RMS_EPS = 1e-6f, L2_EPS = 1e-6f;

constexpr size_t MiB = 1u << 20;
constexpr size_t WS_CTL = 0, CTL_ZERO_BYTES = 1 * MiB;
constexpr size_t WS_MODP = 1 * MiB;
constexpr size_t WS_MODS = 8 * MiB;
constexpr size_t WS_RSTD = 9 * MiB;
constexpr size_t WS_GG = 10 * MiB;
constexpr size_t WS_GB = 12 * MiB;
constexpr size_t WS_AB = 14 * MiB;
constexpr size_t WS_BT1 = 32 * MiB;
constexpr size_t SZ_BT1 = (size_t)NGU * D * 2;
constexpr size_t WS_BT2 = WS_BT1 + 8 * SZ_BT1;
constexpr size_t SZ_BT2 = (size_t)D * DFF * 2;
constexpr size_t WS_BTG = WS_BT2 + 8 * SZ_BT2;
constexpr size_t SZ_BTG = (size_t)NPROJ_PAD * D * 2;
constexpr size_t WS_BTO = WS_BTG + 2 * SZ_BTG;
constexpr size_t SZ_BTO = (size_t)D * D * 2;
constexpr size_t WS_BTP = WS_BTO + 2 * SZ_BTO;
constexpr size_t SZ_BTP = (size_t)D * 512 * 2;
constexpr size_t WS_X = ((WS_BTP + 2 * SZ_BTP + MiB - 1) / MiB) * MiB;
constexpr size_t WS_H = WS_X + (size_t)MTOK * D * 4;
constexpr size_t WS_ACT = WS_H + (size_t)MTOK * D * 2;
constexpr size_t WS_P = WS_ACT + (size_t)MTOK * DFF * 2;
constexpr size_t WS_QKV = WS_P + (size_t)MTOK * 8192 * 2;
constexpr size_t WS_O = WS_QKV + (size_t)MTOK * NQKV * 2;
constexpr size_t WS_SLAB = WS_O + (size_t)2 * MTOK * D * 4;
constexpr size_t WS_END = WS_SLAB + (size_t)256 * 65536 * 4;
constexpr int CW_SS = 65536;
constexpr int CW_CNT = 16384;

constexpr int LDS_BYTES = 163840;
constexpr int MISC_OFF = 163328;
constexpr int NWAVES = 8;

#define LDS_WAIT() asm volatile("s_waitcnt lgkmcnt(0)" ::: "memory")
#define VM_WAIT() asm volatile("s_waitcnt vmcnt(0)" ::: "memory")
typedef __bf16 bf16x2_t __attribute__((ext_vector_type(2)));
__device__ __forceinline__ unsigned cvt_pk_bf16(float lo, float hi) { const f32x2 v = {lo, hi}; const bf16x2_t b = __builtin_convertvector(v, bf16x2_t); return __builtin_bit_cast(unsigned, b); }
__device__ __forceinline__ float bf_lo(unsigned u) { return __uint_as_float(u << 16); }
__device__ __forceinline__ float bf_hi(unsigned u) { return __uint_as_float(u & 0xffff0000u); }
__device__ __forceinline__ f32x4 ld_bf4(const GAS bf16_t* p) { const u32x2 u = *(const GAS u32x2*)p; return (f32x4){bf_lo(u.x), bf_hi(u.x), bf_lo(u.y), bf_hi(u.y)}; }
__device__ __forceinline__ void st_bf4(GAS bf16_t* p, const f32x4 v) { u32x2 w; w.x = cvt_pk_bf16(v.x, v.y); w.y = cvt_pk_bf16(v.z, v.w); *(GAS u32x2*)p = w; }
#ifndef X_BF16
#define X_BF16 1
#endif
#if X_BF16
typedef bf16_t xres_t;
__device__ __forceinline__ f32x4 ld_x4(const GAS xres_t* p) { return ld_bf4(p); }
__device__ __forceinline__ void st_x4(GAS xres_t* p, const f32x4 v) { st_bf4(p, v); }
#else
typedef float xres_t;
__device__ __forceinline__ f32x4 ld_x4(const GAS xres_t* p) { return *(const GAS f32x4*)p; }
__device__ __forceinline__ void st_x4(GAS xres_t* p, const f32x4 v) { *(GAS f32x4*)p = v; }
#endif
__device__ __forceinline__ void ld_x8(const GAS xres_t* p, f32x4& a, f32x4& b) {
#if X_BF16
    const u32x4 u = *(const GAS u32x4*)p; a = (f32x4){bf_lo(u.x), bf_hi(u.x), bf_lo(u.y), bf_hi(u.y)}; b = (f32x4){bf_lo(u.z), bf_hi(u.z), bf_lo(u.w), bf_hi(u.w)};
#else
    a = *(const GAS f32x4*)p; b = *(const GAS f32x4*)(p + 4);
#endif
}
#if X_BF16
typedef u32x4 xraw8;
__device__ __forceinline__ xraw8 ld_x8raw(const GAS xres_t* p) { return *(const GAS u32x4*)p; }
__device__ __forceinline__ void unpack_x8(const xraw8 u, f32x4& a, f32x4& b) { a = (f32x4){bf_lo(u.x), bf_hi(u.x), bf_lo(u.y), bf_hi(u.y)}; b = (f32x4){bf_lo(u.z), bf_hi(u.z), bf_lo(u.w), bf_hi(u.w)}; }
#else
struct xraw8 { f32x4 a, b; };
__device__ __forceinline__ xraw8 ld_x8raw(const GAS xres_t* p) { xraw8 r; r.a = *(const GAS f32x4*)p; r.b = *(const GAS f32x4*)(p + 4); return r; }
__device__ __forceinline__ void unpack_x8(const xraw8 u, f32x4& a, f32x4& b) { a = u.a; b = u.b; }
#endif
__device__ __forceinline__ void st_x8(GAS xres_t* p, const f32x4 a, const f32x4 b) {
#if X_BF16
    u32x4 w; w.x = cvt_pk_bf16(a.x, a.y); w.y = cvt_pk_bf16(a.z, a.w); w.z = cvt_pk_bf16(b.x, b.y); w.w = cvt_pk_bf16(b.z, b.w); *(GAS u32x4*)p = w;
#else
    *(GAS f32x4*)p = a; *(GAS f32x4*)(p + 4) = b;
#endif
}
__device__ __forceinline__ int hw_lane() { int l; asm volatile("v_mbcnt_lo_u32_b32 %0, -1, 0\n\tv_mbcnt_hi_u32_b32 %0, -1, %0" : "=v"(l)); return l; }
__device__ __forceinline__ float fast_exp(float x) { return __builtin_amdgcn_exp2f(x * 1.44269504089f); }
__device__ __forceinline__ float rsqrt_f(float x) { return __builtin_amdgcn_rsqf(x); }
__device__ __forceinline__ float silu_f(float x) { return x * __builtin_amdgcn_rcpf(1.0f + fast_exp(-x)); }
__device__ __forceinline__ float softplus_f(float x) { const float t = fast_exp(-fabsf(x)); return fmaxf(x, 0.f) + 0.6931471805599453f * __builtin_amdgcn_logf(1.0f + t); }
__device__ __forceinline__ float wave_sum(float v) {
#pragma unroll
    for (int o = 1; o < 64; o <<= 1) v += __shfl_xor(v, o);
    return v;
}

#define XB_TMO      128
#define XB_XCNT(j)  (256  + 64 * (j))
#define XB_XSUB(j)  (1280 + 64 * (j))
#define XB_XGEN(j)  (2304 + 64 * (j))
#define XB_TOP      3328
#define XB_TOPGEN   3392
#define XCD_BAR_WORDS 3456
#define XB_SPIN_CAP (1u << 20)

__device__ __forceinline__ unsigned xb_ld(unsigned* p)              { return __hip_atomic_load(p, __ATOMIC_RELAXED, __HIP_MEMORY_SCOPE_AGENT); }
__device__ __forceinline__ unsigned xb_add(unsigned* p, unsigned v) { return __hip_atomic_fetch_add(p, v, __ATOMIC_RELAXED, __HIP_MEMORY_SCOPE_AGENT); }
__device__ __forceinline__ unsigned xb_xcc_id() { return (unsigned)__builtin_amdgcn_s_getreg((3 << 11) | 20) & 0xFu; }
#define XB_SPIN(cond, bar) do { unsigned _sp = 0; while (cond) { __builtin_amdgcn_s_sleep(1); \
    if ((++_sp & 255u) == 0u) { if (xb_ld(&(bar)[XB_TMO])) break; if (_sp > XB_SPIN_CAP) { atomicAdd(&(bar)[XB_TMO], 1u); break; } } } } while (0)

struct XcdBarrier { unsigned* bar; unsigned x; volatile LAS unsigned* st; };

__device__ __forceinline__ XcdBarrier xcd_barrier_post(unsigned* bar, volatile LAS unsigned* st) {
    XcdBarrier b; b.bar = bar; b.x = xb_xcc_id(); b.st = st;
    if (threadIdx.x == 0) (void)xb_add(&bar[XB_XCNT(b.x)], 1u);
    return b;
}
__device__ __forceinline__ void xcd_barrier_complete(unsigned* bar, unsigned x, unsigned& nloc, unsigned& nx) {
    const unsigned G = gridDim.x * gridDim.y * gridDim.z;
    unsigned sum, cnt, mine, sp = 0u;
    for (;;) {
        sum = 0u; cnt = 0u; mine = 0u;
#pragma unroll
        for (unsigned j = 0; j < 16; ++j) { const unsigned c = xb_ld(&bar[XB_XCNT(j)]); sum += c; cnt += (c > 0u) ? 1u : 0u; mine = (j == x) ? c : mine; }
        if (sum == G) break;
        __builtin_amdgcn_s_sleep(1);
        if ((++sp & 255u) == 0u) { if (xb_ld(&bar[XB_TMO])) break; if (sp > XB_SPIN_CAP) { atomicAdd(&bar[XB_TMO], 1u); break; } }
    }
    nloc = mine > 0u ? mine : 1u; nx = cnt > 0u ? cnt : 1u;
}
__device__ __forceinline__ void xcd_barrier(const XcdBarrier& b, int wave) {
    asm volatile("s_waitcnt vmcnt(0)" ::: "memory");
    __syncthreads();
    int t0_ = wave * 64 + hw_lane();
    if (t0_ == 0) {
        unsigned* bar = b.bar; unsigned bx = b.x;
        asm volatile("" : "+s"(bar), "+s"(bx));
        __builtin_amdgcn_s_waitcnt(0);
        unsigned nloc = b.st[0], nx = b.st[1];
        if (nloc == 0u) { xcd_barrier_complete(bar, bx, nloc, nx); b.st[0] = nloc; b.st[1] = nx; }
        const unsigned old = xb_add(&bar[XB_XSUB(bx)], 1u);
        const unsigned gen = old / nloc;
        if (old + 1u == (gen + 1u) * nloc) {
            __builtin_amdgcn_fence(__ATOMIC_RELEASE, "agent");
            asm volatile("s_waitcnt vmcnt(0)" ::: "memory");
            const unsigned og = xb_add(&bar[XB_TOP], 1u);
            const unsigned tg = og / nx;
            if (og + 1u == (tg + 1u) * nx) xb_add(&bar[XB_TOPGEN], 1u);
            else XB_SPIN(xb_ld(&bar[XB_TOPGEN]) == tg, bar);
            __builtin_amdgcn_fence(__ATOMIC_ACQUIRE, "agent");
            xb_add(&bar[XB_XGEN(bx)], 1u);
            asm volatile("s_waitcnt vmcnt(0)" ::: "memory");
        } else {
            XB_SPIN(xb_ld(&bar[XB_XGEN(bx)]) == gen, bar);
            __builtin_amdgcn_fence(__ATOMIC_ACQUIRE, "agent");
            asm volatile("s_waitcnt vmcnt(0)" ::: "memory");
        }
    }
    __syncthreads();
}

namespace pg8 {
constexpr int BM = 256, BK = 64, HALF = 128, HTB = HALF * BK * 2, STAGE_BYTES = 8 * HTB, NXCD = 8, WGM = 4;
__device__ __forceinline__ int lds_byte(int r, int c) { const int st = (r >> 4) * 2 + (c >> 5), rr = r & 15, cc = c & 31, ob = rr * 64 + cc * 2; return st * 1024 + (ob ^ (((ob >> 9) & 1) << 5)); }
__device__ __forceinline__ void stage_rc(int b, int& R, int& C) { const int st = b / 1024, sb = b % 1024, swz = sb ^ (((sb >> 9) & 1) << 5); R = (st >> 1) * 16 + swz / 64; C = (st & 1) * 32 + (swz % 64) / 2; }
__device__ __forceinline__ int perm32(int rho) { const int n = rho >> 4, i = rho & 15; return 8 * (i >> 2) + 4 * n + (i & 3); }

struct Unit { int pm, pn, ak, bk, nt, slab; };
struct Gemm { const bf16_t* A; const bf16_t* Bt; int lda, ldb, K; };

struct StaticOrder {
    int nM, nN, nwg, G, c, pool, split, ntFull;
    __device__ __forceinline__ void init(int nM_, int nN_, int G_, int c_, int pool_, int split_, int K_) { nM = nM_; nN = nN_; nwg = nM * nN; G = G_; c = c_; pool = pool_; split = split_; ntFull = K_ / BK; }
    __device__ __forceinline__ void tile2(int L, int& pm, int& pn) const {
        int wgid = L; { const int q = nwg / NXCD, r = nwg % NXCD, xcd = wgid % NXCD, off = wgid / NXCD; wgid = (xcd < r ? xcd * (q + 1) : r * (q + 1) + (xcd - r) * q) + off; }
        const int nig = WGM * nN, gid = wgid / nig, fm = gid * WGM, gsz = (nM - fm) < WGM ? (nM - fm) : WGM;
        pm = fm + ((wgid % nig) % gsz); pn = (wgid % nig) / gsz;
    }
    __device__ __forceinline__ void tile(int L, Unit& u) const { int pm, pn; tile2(L, pm, pn); u.pm = pm; u.pn = pn; }
    __device__ __forceinline__ bool next(int i, Unit& u) const {
        if (split) {
            if (i > 1) return false;
            if (i == 0) { const int e = c >> 2, q = c & 3, nq = ((ntFull + 7) >> 3) << 1;
                tile(256 + e, u); u.ak = u.bk = q * nq * BK; u.nt = (q < 3) ? nq : ntFull - 3 * nq; u.slab = c; return true; }
            tile(c, u); u.ak = u.bk = 0; u.nt = ntFull; u.slab = -1; return true;
        }
        const long L = (long)i * G + c; if (L >= nwg) return false;
        tile((int)L, u); u.ak = pool ? (u.pn >> 1) * 512 : 0; u.bk = 0; u.nt = ntFull; u.slab = -1; return true;
    }
};

template <class Epi, bool ALIGN_EPI, int MT, bool W3>
__device__ __forceinline__ void gemm_phase_impl(LAS unsigned char* lds, const Gemm g, const StaticOrder& S, const Epi& E, int wave_) {
    int wid = wave_; asm volatile("" : "+s"(wid)); const int lane = hw_lane(), tid = wid * 64 + lane, wr = wid >> 2, wc = wid & 3, fr = lane & 15, fq = lane >> 4;
    unsigned voffA_, voffB_;
    { int R, C; stage_rc(tid * 16, R, C); const int Rb = Epi::PERM ? ((R & ~31) + perm32(R & 31)) : R;
      voffA_ = (unsigned)(R * g.lda + C) * 2u; voffB_ = (unsigned)(Rb * g.ldb + C) * 2u; }
    const size_t r64voffA = (size_t)64 * g.lda * 2, r64voffB = (size_t)64 * g.ldb * 2; const unsigned vvoffA = voffA_, vvoffB = voffB_;
    const size_t r3voffA = (size_t)128 * g.lda * 2; const unsigned lds3 = 16384u + (unsigned)(wid & 3) * 1024u;
    constexpr int HALF_A = MT * 32, HTA = HALF_A * BK * 2;
    const size_t kstep = (size_t)(BK * 2);
    const size_t hstepA = (size_t)HALF_A * g.lda * 2, hstepB = (size_t)HALF * g.ldb * 2;
    const size_t tstepA = 2 * hstepA, tstepB = 2 * hstepB;
    const unsigned ldsw = (unsigned)wid * 1024u;
    const int aoff = lds_byte(wr * (MT * 16) + fr, fq * 8), boff = lds_byte(wc * 32 + fr, fq * 8);
#define PG8_SA(b, h) (((b) * 2 + (h)) * HTA)
#define PG8_SB(b, h) (4 * HTA + ((b) * 2 + (h)) * HTB)
#define PG8_LD1(gb_, vo_, ldsoff) do { const char* _gb = (gb_); unsigned _vo = (vo_); asm volatile("" : "+s"(_gb), "+v"(_vo)); \
        __builtin_amdgcn_global_load_lds((const GAS unsigned*)(_gb + _vo), (LAS unsigned*)(lds + (ldsoff)), 16, 0, 0); } while (0)
#define PG8_STAGE(bufoff, gbase, voff) do { PG8_LD1((const char*)(gbase), v##voff, (bufoff) + ldsw); PG8_LD1((const char*)(gbase) + r64##voff, v##voff, (bufoff) + ldsw + 8192); } while (0)
#define PG8_STAGE_A(bufoff, gbase) do { PG8_STAGE(bufoff, gbase, voffA); if constexpr (MT == 5 && W3) PG8_LD1((const char*)(gbase) + r3voffA, vvoffA, (bufoff) + lds3); } while (0)
#define PG8_LDA(dst, b, h) do { _Pragma("unroll") for (int m = 0; m < MT; ++m) _Pragma("unroll") for (int k = 0; k < 2; ++k) dst[m][k] = *(const LAS bf16x8*)(lds + PG8_SA(b, h) + aoff + m * 2048 + k * 1024); } while (0)
#define PG8_LDB(dst, b, h) do { _Pragma("unroll") for (int n = 0; n < 2; ++n) _Pragma("unroll") for (int k = 0; k < 2; ++k) dst[n][k] = *(const LAS bf16x8*)(lds + PG8_SB(b, h) + boff + n * 2048 + k * 1024); } while (0)
#define PG8_MMA(ai, bj, At, Bt) do { __builtin_amdgcn_s_setprio(1); _Pragma("unroll") for (int m = 0; m < MT; ++m) _Pragma("unroll") for (int n = 0; n < 2; ++n) _Pragma("unroll") for (int k = 0; k < 2; ++k) \
        acc[ai][bj][m][n] = __builtin_amdgcn_mfma_f32_16x16x32_bf16(Bt[n][k], At[m][k], acc[ai][bj][m][n], 0, 0, 0); __builtin_amdgcn_s_setprio(0); } while (0)
#define PG8_WAIT_V(n) asm volatile("s_waitcnt vmcnt(" #n ")" ::: "memory")
#define PG8_WAIT_V2(n4, n5) do { if constexpr (MT == 5 && W3) PG8_WAIT_V(n5); else PG8_WAIT_V(n4); } while (0)
#define PG8_WAIT_L(n) asm volatile("s_waitcnt lgkmcnt(" #n ")" ::: "memory")
#define PG8_BAR __builtin_amdgcn_s_barrier()
#define PG8_SCHED __builtin_amdgcn_sched_barrier(0)
    Unit cur, nxt; int ui = 0;
    if (!S.next(0, cur)) return;
    f32x4 acc[2][2][MT][2];
    bf16x8 At[MT][2], B0[2][2], B1[2][2];
    const char* cA = (const char*)g.A + (size_t)cur.pm * tstepA + (size_t)cur.ak * 2; const char* cB = (const char*)g.Bt + (size_t)cur.pn * tstepB + (size_t)cur.bk * 2;
    PG8_STAGE(PG8_SB(0, 0), cB, voffB); PG8_STAGE(PG8_SB(0, 1), cB + hstepB, voffB); PG8_STAGE_A(PG8_SA(0, 0), cA); PG8_STAGE_A(PG8_SA(0, 1), cA + hstepA);
    if (wr == 1) PG8_BAR;
    PG8_WAIT_V2(2, 3); PG8_BAR;
    PG8_STAGE(PG8_SB(1, 0), cB + kstep, voffB); PG8_STAGE_A(PG8_SA(1, 0), cA + kstep); PG8_STAGE(PG8_SB(1, 1), cB + hstepB + kstep, voffB);
    PG8_WAIT_V2(6, 7); PG8_BAR;
#pragma unroll
    for (int a = 0; a < 2; ++a)
#pragma unroll
        for (int b = 0; b < 2; ++b)
#pragma unroll
            for (int m = 0; m < MT; ++m)
#pragma unroll
                for (int n = 0; n < 2; ++n) acc[a][b][m][n] = (f32x4){0.f, 0.f, 0.f, 0.f};
    for (;;) {
        const bool has_next = S.next(ui + 1, nxt);
        const char* nA = has_next ? (const char*)g.A + (size_t)nxt.pm * tstepA + (size_t)nxt.ak * 2 : cA; const char* nB = has_next ? (const char*)g.Bt + (size_t)nxt.pn * tstepB + (size_t)nxt.bk * 2 : cB;
        const int nt = cur.nt;
        for (int t = 0; t < nt; t += 2) {
            const bool last = (t == nt - 2);
            const char* a1 = cA + (size_t)(t + 1) * kstep;
            const char* a2 = last ? nA : cA + (size_t)(t + 2) * kstep; const char* b2 = last ? nB : cB + (size_t)(t + 2) * kstep;
            const char* a3 = a2 + kstep; const char* b3 = b2 + kstep;
            PG8_LDB(B0, 0, 0); PG8_LDB(B1, 0, 1); PG8_SCHED; PG8_LDA(At, 0, 0); PG8_STAGE_A(PG8_SA(1, 1), a1 + hstepA);
            PG8_WAIT_V2(8, 10); PG8_WAIT_L(0); PG8_BAR; PG8_MMA(0, 0, At, B0); PG8_MMA(0, 1, At, B1); PG8_BAR; PG8_SCHED;
            PG8_LDA(At, 0, 1); PG8_STAGE(PG8_SB(0, 0), b2, voffB); PG8_STAGE(PG8_SB(0, 1), b2 + hstepB, voffB); PG8_STAGE_A(PG8_SA(0, 0), a2);
            PG8_WAIT_V2(8, 10); PG8_WAIT_L(0); PG8_BAR; PG8_MMA(1, 0, At, B0); PG8_MMA(1, 1, At, B1); PG8_BAR; PG8_SCHED;
            PG8_LDB(B0, 1, 0); PG8_LDB(B1, 1, 1); PG8_SCHED; PG8_LDA(At, 1, 0); PG8_STAGE_A(PG8_SA(0, 1), a2 + hstepA);
            PG8_WAIT_V2(8, 10); PG8_WAIT_L(0); PG8_BAR; PG8_MMA(0, 0, At, B0); PG8_MMA(0, 1, At, B1); PG8_BAR; PG8_SCHED;
            PG8_LDA(At, 1, 1); PG8_STAGE(PG8_SB(1, 0), b3, voffB); PG8_STAGE(PG8_SB(1, 1), b3 + hstepB, voffB); PG8_STAGE_A(PG8_SA(1, 0), a3);
            PG8_WAIT_V2(8, 10); PG8_WAIT_L(0); PG8_BAR; PG8_MMA(1, 0, At, B0); PG8_MMA(1, 1, At, B1); PG8_BAR; PG8_SCHED;
        }
        if constexpr (ALIGN_EPI) { if (wr == 0) PG8_BAR; }
        { const int te = hw_lane(); E(acc, cur, wr, wc, te & 15, (te >> 4) & 3); }
        if (!has_next) break;
#pragma unroll
        for (int a = 0; a < 2; ++a)
#pragma unroll
            for (int b = 0; b < 2; ++b)
#pragma unroll
                for (int m = 0; m < MT; ++m)
#pragma unroll
                    for (int n = 0; n < 2; ++n) acc[a][b][m][n] = (f32x4){0.f, 0.f, 0.f, 0.f};
        cur = nxt; cA = nA; cB = nB; ++ui;
        if constexpr (ALIGN_EPI) { if (wr == 1) PG8_BAR; }
    }
    PG8_WAIT_V(0);
    if constexpr (!ALIGN_EPI) { if (wr == 0) PG8_BAR; }
    PG8_BAR;
#undef PG8_SA
#undef PG8_SB
#undef PG8_STAGE
#undef PG8_LD1
#undef PG8_STAGE_A
#undef PG8_WAIT_V2
#undef PG8_LDA
#undef PG8_LDB
#undef PG8_MMA
#undef PG8_WAIT_V
#undef PG8_WAIT_L
#undef PG8_BAR
#undef PG8_SCHED
}
template <class Epi, bool ALIGN_EPI = true, int MT = 4>
__device__ __forceinline__ void gemm_phase(LAS unsigned char* lds, const Gemm g, const StaticOrder& S, const Epi& E, int wave_) {
    if constexpr (MT == 5) { if (wave_ < 4) gemm_phase_impl<Epi, ALIGN_EPI, 5, true>(lds, g, S, E, wave_); else gemm_phase_impl<Epi, ALIGN_EPI, 5, false>(lds, g, S, E, wave_); }
    else gemm_phase_impl<Epi, ALIGN_EPI, MT, true>(lds, g, S, E, wave_);
}

struct EpiSwiGLU {
    static constexpr bool PERM = true;
    bf16_t* O;
    __device__ __forceinline__ void operator()(const f32x4 (&acc)[2][2][4][2], const Unit& u, int wr, int wc, int fr, int fq) const {
        const int row0 = u.pm * BM + wr * 64 + fr, col0 = u.pn * 128 + wc * 32 + 8 * fq;
#pragma unroll
        for (int ai = 0; ai < 2; ++ai)
#pragma unroll
            for (int m = 0; m < 4; ++m) {
                GAS bf16_t* rowp = (GAS bf16_t*)O + (size_t)(row0 + ai * HALF + m * 16) * DFF + col0;
                float v[8];
#pragma unroll
                for (int n = 0; n < 2; ++n)
#pragma unroll
                    for (int j = 0; j < 4; ++j) { const float gt = acc[ai][0][m][n][j], up = acc[ai][1][m][n][j]; v[n * 4 + j] = silu_f(gt) * up; }
                u32x4 w; w.x = cvt_pk_bf16(v[0], v[1]); w.y = cvt_pk_bf16(v[2], v[3]); w.z = cvt_pk_bf16(v[4], v[5]); w.w = cvt_pk_bf16(v[6], v[7]);
                *(GAS u32x4*)rowp = w;
            }
    }
};
struct EpiResid {
    static constexpr bool PERM = false;
    float* X; const float* gate; const float* ps; float* slab; unsigned* cnt; float* ssn; float coef; int pad_;
    __device__ __forceinline__ void operator()(const f32x4 (&acc)[2][2][4][2], const Unit& u, int wr, int wc, int fr, int fq) const {
        if (u.slab >= 0) {
            GAS float* sp = (GAS float*)slab + (size_t)u.slab * 65536 + (size_t)(wr * 64 + fr) * 256 + wc * 32 + 4 * fq;
#pragma unroll
            for (int ai = 0; ai < 2; ++ai)
#pragma unroll
                for (int m = 0; m < 4; ++m)
#pragma unroll
                    for (int bj = 0; bj < 2; ++bj)
#pragma unroll
                        for (int n = 0; n < 2; ++n) { GAS float* p = sp + (size_t)(ai * HALF + m * 16) * 256 + bj * HALF + n * 16; const f32x4 v = acc[ai][bj][m][n];
                            asm volatile("global_store_dwordx4 %0, %1, off sc1\n\ts_nop 1" :: "v"(p), "v"(v) : "memory"); }
            asm volatile("s_waitcnt vmcnt(0)" ::: "memory");
            if ((fr | fq) == 0) __hip_atomic_fetch_add(cnt + 64 * (u.slab >> 2), 1u, __ATOMIC_RELAXED, __HIP_MEMORY_SCOPE_AGENT);
            return;
        }
        const int row0 = u.pm * BM + wr * 64 + fr, col0 = u.pn * BM + wc * 32 + 4 * fq;
        const int grp = u.pm < 32 ? 0 : 1 + ((u.pm - 32) >> 2);
        const GAS float* gp = (const GAS float*)gate + (size_t)grp * NMODC + col0;
        f32x4 bv[2][2];
#pragma unroll
        for (int bj = 0; bj < 2; ++bj)
#pragma unroll
            for (int n = 0; n < 2; ++n) { f32x4 t = *(const GAS f32x4*)(gp + bj * HALF + n * 16) * coef; if (ps) t = t * *(const GAS f32x4*)((const GAS float*)ps + col0 + bj * HALF + n * 16); bv[bj][n] = t; }
#pragma unroll
        for (int ai = 0; ai < 2; ++ai)
#pragma unroll
            for (int mp = 0; mp < 2; ++mp) {
                f32x4 xr[2][2][2];
#pragma unroll
                for (int mm = 0; mm < 2; ++mm) { const GAS float* rowp = (const GAS float*)X + (size_t)(row0 + ai * HALF + (2 * mp + mm) * 16) * D + col0;
#pragma unroll
                    for (int bj = 0; bj < 2; ++bj)
#pragma unroll
                        for (int n = 0; n < 2; ++n) xr[mm][bj][n] = *(const GAS f32x4*)(rowp + bj * HALF + n * 16); }
#pragma unroll
                for (int mm = 0; mm < 2; ++mm) { const int m = 2 * mp + mm; const int row = row0 + ai * HALF + m * 16; GAS float* rowp = (GAS float*)X + (size_t)row * D + col0; float sq = 0.f;
#pragma unroll
                    for (int bj = 0; bj < 2; ++bj)
#pragma unroll
                        for (int n = 0; n < 2; ++n) { const f32x4 xn = xr[mm][bj][n] + bv[bj][n] * acc[ai][bj][m][n]; *(GAS f32x4*)(rowp + bj * HALF + n * 16) = xn;
                            sq += (xn.x * xn.x + xn.y * xn.y) + (xn.z * xn.z + xn.w * xn.w); }
                    if (ssn) { sq += __shfl_xor(sq, 16); sq += __shfl_xor(sq, 32); if (fq == 0) atomicAdd((float*)ssn + row, sq); } }
                asm volatile("" ::: "memory");
            }
    }
};
struct EpiResid5 {
    static constexpr bool PERM = true;
    xres_t* X; const float* gate; const float* ps; unsigned long long* ssn; float coef; int pad_;
    __device__ __forceinline__ void operator()(const f32x4 (&acc)[2][2][5][2], const Unit& u, int wr, int wc, int fr, int fq) const {
        asm volatile("" ::: "memory");
        const int rowt = u.pm * 320 + wr * 80, row0 = rowt + fr, col0 = u.pn * BM + wc * 32 + 8 * fq;
        const int rlo = u.pm * 320, rhi = rlo + 319;
        const int g0 = rlo < NCTX ? 0 : 1 + ((rlo - NCTX) >> 10), g1 = rhi < NCTX ? 0 : 1 + ((rhi - NCTX) >> 10);
        const int rb = (g1 == 0) ? (1 << 30) : NCTX + (g1 - 1) * 1024;
        f32x4 bvA[2][2], bvB[2][2];
#pragma unroll
        for (int bj = 0; bj < 2; ++bj)
#pragma unroll
            for (int n = 0; n < 2; ++n) { f32x4 sc = (f32x4){coef, coef, coef, coef}; if (ps) sc = sc * *(const GAS f32x4*)((const GAS float*)ps + col0 + bj * HALF + n * 4);
                bvA[bj][n] = *(const GAS f32x4*)((const GAS float*)gate + (size_t)g0 * NMODC + col0 + bj * HALF + n * 4) * sc;
                bvB[bj][n] = *(const GAS f32x4*)((const GAS float*)gate + (size_t)g1 * NMODC + col0 + bj * HALF + n * 4) * sc; }
#pragma unroll
        for (int pr = 0; pr < 5; ++pr) {
            xraw8 xq[2][2];
#pragma unroll
            for (int mm = 0; mm < 2; ++mm) { const int ai = (2 * pr + mm) / 5, m = (2 * pr + mm) % 5; const GAS xres_t* rowp = (const GAS xres_t*)X + (size_t)(row0 + ai * 160 + m * 16) * D + col0;
#pragma unroll
                for (int bj = 0; bj < 2; ++bj) xq[mm][bj] = ld_x8raw(rowp + bj * HALF); }
#pragma unroll
            for (int mm = 0; mm < 2; ++mm) { const int ai = (2 * pr + mm) / 5, m = (2 * pr + mm) % 5; const int row = row0 + ai * 160 + m * 16; const bool hi = (rowt + ai * 160 + m * 16) >= rb;
                GAS xres_t* rowp = (GAS xres_t*)X + (size_t)row * D + col0; float sq = 0.f;
#pragma unroll
                for (int bj = 0; bj < 2; ++bj) { f32x4 xn[2], xo[2]; unpack_x8(xq[mm][bj], xo[0], xo[1]);
#pragma unroll
                    for (int n = 0; n < 2; ++n) { const f32x4 bv = hi ? bvB[bj][n] : bvA[bj][n]; xn[n] = xo[n] + bv * acc[ai][bj][m][n];
                        sq += (xn[n].x * xn[n].x + xn[n].y * xn[n].y) + (xn[n].z * xn[n].z + xn[n].w * xn[n].w); }
                    st_x8(rowp + bj * HALF, xn[0], xn[1]); }
                if (ssn) { sq += __shfl_xor(sq, 16); sq += __shfl_xor(sq, 32); if (fq == 0) __hip_atomic_fetch_add(ssn + row, (unsigned long long)(sq * 1048576.0f + 0.5f), __ATOMIC_RELAXED, __HIP_MEMORY_SCOPE_AGENT); } }
            asm volatile("" ::: "memory");
        }
    }
};
__device__ __forceinline__ void combine_split(float* X, const float* gate, const float* ps, float coef, const float* slab, unsigned* cnt, const StaticOrder& S, float* ssn) {
    const int c = S.c, e = c >> 2, qr = c & 3; int tid = threadIdx.x;
    int pm, pn; S.tile2(256 + e, pm, pn);
    if (tid < 64) {
        const unsigned long long t0 = __builtin_amdgcn_s_memrealtime();
        while ((unsigned)__builtin_amdgcn_readfirstlane(__hip_atomic_load(cnt + 64 * e, __ATOMIC_RELAXED, __HIP_MEMORY_SCOPE_AGENT)) < 32u) {
            if (__builtin_amdgcn_s_memrealtime() - t0 > 20000000ull) break;
            __builtin_amdgcn_s_sleep(2); }
        __builtin_amdgcn_fence(__ATOMIC_ACQUIRE, "agent");
        asm volatile("s_waitcnt vmcnt(0)" ::: "memory");
    }
    __syncthreads();
    const int grp = pm < 32 ? 0 : 1 + ((pm - 32) >> 2);
    const int cq = (tid & 63) * 4, r0 = tid >> 6;
    f32x4 gv = *(const GAS f32x4*)((const GAS float*)gate + (size_t)grp * NMODC + pn * BM + cq) * coef;
    if (ps) gv = gv * *(const GAS f32x4*)((const GAS float*)ps + pn * BM + cq);
    const GAS float* sp = (const GAS float*)slab + (size_t)(4 * e) * 65536;
#pragma unroll 4
    for (int ps8 = 0; ps8 < 8; ++ps8) {
        const int r = 64 * qr + 8 * ps8 + r0;
        const size_t so = (size_t)r * 256 + cq;
        const f32x4 p0 = *(const GAS f32x4*)(sp + so), p1 = *(const GAS f32x4*)(sp + 65536 + so), p2 = *(const GAS f32x4*)(sp + 2 * 65536 + so), p3 = *(const GAS f32x4*)(sp + 3 * 65536 + so);
        GAS float* xp = (GAS float*)X + (size_t)(pm * BM + r) * D + pn * BM + cq;
        const f32x4 x = *(const GAS f32x4*)xp;
        const f32x4 xn = x + gv * ((p0 + p1) + (p2 + p3));
        *(GAS f32x4*)xp = xn;
        if (ssn) { float sq = (xn.x * xn.x + xn.y * xn.y) + (xn.z * xn.z + xn.w * xn.w);
#pragma unroll
            for (int o = 1; o < 64; o <<= 1) sq += __shfl_xor(sq, o);
            if ((tid & 63) == 0) atomicAdd((float*)ssn + pm * BM + r, sq); }
    }
}
struct EpiProj {
    static constexpr bool PERM = true;
    bf16_t* P; float* AB;
    __device__ __forceinline__ void operator()(const f32x4 (&acc)[2][2][4][2], const Unit& u, int wr, int wc, int fr, int fq) const {
        const int row0 = u.pm * BM + wr * 64 + fr;
        if (u.pn < 32) {
            const int col0 = u.pn * BM + wc * 32 + 8 * fq;
#pragma unroll
            for (int ai = 0; ai < 2; ++ai)
#pragma unroll
                for (int m = 0; m < 4; ++m) { GAS bf16_t* rowp = (GAS bf16_t*)P + (size_t)(row0 + ai * HALF + m * 16) * 8192 + col0;
#pragma unroll
                    for (int bj = 0; bj < 2; ++bj) { const f32x4 v0 = acc[ai][bj][m][0], v1 = acc[ai][bj][m][1];
                        u32x4 w; w.x = cvt_pk_bf16(v0[0], v0[1]); w.y = cvt_pk_bf16(v0[2], v0[3]); w.z = cvt_pk_bf16(v1[0], v1[1]); w.w = cvt_pk_bf16(v1[2], v1[3]);
                        *(GAS u32x4*)(rowp + bj * HALF) = w; } }
        } else if (wc < 2) {
            const int col0 = wc * 32 + 8 * fq;
#pragma unroll
            for (int ai = 0; ai < 2; ++ai)
#pragma unroll
                for (int m = 0; m < 4; ++m) { GAS float* rowp = (GAS float*)AB + (size_t)(row0 + ai * HALF + m * 16) * 64 + col0;
                    *(GAS f32x4*)rowp = acc[ai][0][m][0]; *(GAS f32x4*)(rowp + 4) = acc[ai][0][m][1]; }
        }
    }
};
}

struct Args {
    const float* x_prompt; const float* x_sample; const float* state_gdn; const float* c; const float* c_ctx;
    const float* w_mod; const float* b_mod; const float* norm_g; const float* ffn_w_in; const float* ffn_w_out;
    const float* gdn_w_in; const float* gdn_conv; const float* gdn_a_log; const float* gdn_dt_bias; const float* gdn_norm_g; const float* gdn_w_out;
    const float* pool_w; const float* pool_scale; const float* final_g;
    float* out; unsigned char* ws;
};

struct Frame {
    LAS unsigned char* lds;
    int tid, lane, wave, vcu, G;
};

#define OPAQUE_FRAME(F) Frame F = F##_in; asm volatile("" : "+s"(F.vcu), "+s"(F.wave) :: "memory"); F.lane = hw_lane(); F.tid = F.wave * 64 + F.lane
__device__ __forceinline__ void transpose_item(const float* src, int ld_src, int k0, int n0s, int nvalid, bf16_t* dst, int ld_dst, int n0d, LAS unsigned char* scr, int lane) {
    const int nq = lane & 31, kh = lane >> 5;
    const int nqc = (4 * nq < nvalid) ? nq : 0;
    const char* sb = (const char*)src + ((size_t)k0 * ld_src + n0s) * 4; const unsigned voff = ((unsigned)(32 * kh) * (unsigned)ld_src + 4u * (unsigned)nqc) * 4u;
    f32x4 tv[32];
#pragma unroll
    for (int i = 0; i < 32; ++i) { const char* bi = sb + (size_t)i * ld_src * 4; unsigned vo = voff; asm volatile("" : "+s"(bi), "+v"(vo));
        tv[i] = __builtin_nontemporal_load((const GAS f32x4*)(bi + vo)); }
#pragma unroll
    for (int c = 0; c < 4; ++c) { LAS unsigned char* wr = scr + (c * 32 + nq) * 144 + 64 * kh;
#pragma unroll
        for (int g = 0; g < 4; ++g) { u32x4 o; o.x = cvt_pk_bf16(tv[8 * g + 0][c], tv[8 * g + 1][c]); o.y = cvt_pk_bf16(tv[8 * g + 2][c], tv[8 * g + 3][c]); o.z = cvt_pk_bf16(tv[8 * g + 4][c], tv[8 * g + 5][c]); o.w = cvt_pk_bf16(tv[8 * g + 6][c], tv[8 * g + 7][c]);
            *(LAS u32x4*)(wr + 16 * g) = o; } }
    LDS_WAIT(); asm volatile("" ::: "memory");
#pragma unroll
    for (int t = 0; t < 16; ++t) { const int q = lane + 64 * t, r = q >> 3, ch = q & 7, nl = 4 * (r & 31) + (r >> 5);
        const u32x4 o = *(const LAS u32x4*)(scr + r * 144 + 16 * ch);
        if (nl < nvalid) __builtin_nontemporal_store(o, (GAS u32x4*)((GAS bf16_t*)dst + (size_t)(n0d + nl) * ld_dst + k0 + 8 * ch)); }
    LDS_WAIT(); asm volatile("" ::: "memory");
}

__device__ __forceinline__ void sincos_small(float x, float& s, float& c) {
    const float k = rintf(x * 0.636619772367581f);
    float y = fmaf(k, -1.57079637050628662109375f, x); y = fmaf(k, 4.37113882867379e-8f, y);
    const float y2 = y * y;
    float sp = fmaf(y2, 2.7557319e-6f, -1.9841270e-4f); sp = fmaf(sp, y2, 8.3333333e-3f); sp = fmaf(sp, y2, -1.6666667e-1f); sp = fmaf(sp * y2, y, y);
    float cp = fmaf(y2, -2.7557319e-7f, 2.4801587e-5f); cp = fmaf(cp, y2, -1.3888889e-3f); cp = fmaf(cp, y2, 4.1666667e-2f); cp = fmaf(cp, y2, -0.5f); cp = fmaf(cp, y2, 1.0f);
    const int q = ((int)k) & 3;
    s = (q == 0) ? sp : (q == 1) ? cp : (q == 2) ? -sp : -cp;
    c = (q == 0) ? cp : (q == 1) ? -sp : (q == 2) ? -cp : sp;
}

#ifndef PRO_SKIP
#define PRO_SKIP 5
#endif
#ifndef TAIL_NA
#define TAIL_NA 4
#endif
#ifndef TAIL_NC
#define TAIL_NC 3
#endif
constexpr int SEQ_TOTAL = 38560;
constexpr int CAPG = 576 * TAIL_NA, CAPC = 1728 * TAIL_NC;
constexpr int slot_cap(int j) { return (j == 1 || j == 6) ? CAPC : CAPG; }
constexpr int seq_need(int i) { return i == 0 ? 2752 : i == 1 ? 6768 : i == 2 ? 9520 : i == 3 ? 13648 : i == 4 ? 17904 : i == 5 ? 22032 : i == 6 ? 26048 : i == 7 ? 28800 : i == 8 ? 32928 : i == 9 ? 37184 : 38560; }
constexpr int seq_p0() { int p0 = 0, caps = 0; for (int i = 0; i <= 10; ++i) { const int v = seq_need(i) - caps; if (v > p0) p0 = v; if (i < 10) caps += slot_cap(i); } return p0; }
constexpr int SEQ_P0 = seq_p0();
__device__ __forceinline__ int slot_start(int j) { const int nc = (j > 1) + (j > 6); return SEQ_P0 + (j - nc) * CAPG + nc * CAPC; }
__device__ __forceinline__ void convert_seq_item(const Args& a, unsigned char* ws, LAS unsigned char* scr, int lane, int s) {
    const int L = (s >= 30176) ? 3 : (s >= 19280) ? 2 : (s >= 10896) ? 1 : 0;
    int it = s - ((L == 3) ? 30176 : (L == 2) ? 19280 : (L == 1) ? 10896 : 0);
    const int MS = (L & 1) ? 128 : 2640, mi = L >> 1;
    const float* src; bf16_t* dst; int ld_src, ld_dst, k0, n0s, n0d, nvalid = 128;
    if (it >= 4128 && it < 4128 + MS) {
        it -= 4128;
        if (L & 1) { const int gi = it >> 5, kb = (it & 31) >> 2, nb = it & 3;
            src = a.pool_w + (size_t)(mi * 4 + gi) * 512 * 512; ld_src = 512; k0 = 64 * kb; n0s = 128 * nb; dst = (bf16_t*)(ws + WS_BTP + mi * SZ_BTP); ld_dst = 512; n0d = gi * 512 + 128 * nb; }
        else if (it < 2080) { const int kb = it / 65, nb = it % 65;
            src = a.gdn_w_in + (size_t)mi * D * NPROJ; ld_src = NPROJ; k0 = 64 * kb; n0s = 128 * nb; dst = (bf16_t*)(ws + WS_BTG + mi * SZ_BTG); ld_dst = D; n0d = 128 * nb; nvalid = (nb == 64) ? 64 : 128; }
        else if (it < 2592) { it -= 2080; const int kb = it >> 4, nb = it & 15;
            src = a.gdn_w_out + (size_t)mi * D * D; ld_src = D; k0 = 64 * kb; n0s = 128 * nb; dst = (bf16_t*)(ws + WS_BTO + mi * SZ_BTO); ld_dst = D; n0d = 128 * nb; }
        else { it -= 2592;
#pragma unroll
            for (int rr = 0; rr < 4; ++rr) { GAS u32x4* p = (GAS u32x4*)((GAS bf16_t*)(ws + WS_BTG + mi * SZ_BTG) + (size_t)(NPROJ + 4 * it + rr) * D) + lane;
#pragma unroll
                for (int j = 0; j < 4; ++j) p[64 * j] = (u32x4){0u, 0u, 0u, 0u}; }
            return; }
    } else {
        int f = 0; if (it >= 4128) { it -= 4128 + MS; f = 1; }
        const int mt = 2 * L + f;
        if (it < 2752) { const int kb = it / 86, nb = it % 86;
            src = a.ffn_w_in + (size_t)mt * D * NGU; ld_src = NGU; k0 = 64 * kb; n0s = 128 * nb; dst = (bf16_t*)(ws + WS_BT1 + mt * SZ_BT1); ld_dst = D; n0d = (nb < 43) ? 256 * nb : 256 * (nb - 43) + 128; }
        else { it -= 2752; const int kb = it >> 4, nb = it & 15;
            src = a.ffn_w_out + (size_t)mt * DFF * D; ld_src = D; k0 = 64 * kb; n0s = 128 * nb; dst = (bf16_t*)(ws + WS_BT2 + mt * SZ_BT2); ld_dst = DFF; n0d = 128 * nb; }
    }
    transpose_item(src, ld_src, k0, n0s, nvalid, dst, ld_dst, n0d, scr, lane);
}
__device__ __forceinline__ void tail_convert(const Frame& F_in, const Args& a, int first, int n_per_wave, int wrank, int nw) {
    OPAQUE_FRAME(F);
    __syncthreads();
    LAS unsigned char* scr = F.lds + F.wave * 18432;
    for (int k = 0; k < n_per_wave; ++k) { const int s = first + wrank + nw * k; if (s < SEQ_TOTAL) convert_seq_item(a, a.ws, scr, F.lane, s); }
}
__device__ __forceinline__ void prologue_a(const Frame& F_in, const Args& a) {
    OPAQUE_FRAME(F);
    unsigned char* ws = a.ws;
    LAS unsigned char* scr = F.lds + F.wave * 18432;
    LAS float* sv = (LAS float*)(F.lds + 69632);
    for (int i = F.tid; i < 3 * D; i += NWAVES * 64) { const int g = i / D, k = i % D; const float v = (g == 0) ? a.c_ctx[k] : a.c[(g - 1) * D + k]; sv[i] = v / (1.0f + expf(-v)); }
    __syncthreads();
    const int gw = F.vcu * NWAVES + F.wave, NGW = F.G * NWAVES;
    for (int t = gw; t < 4 * 72 * 8; t += NGW) {
        const int l = t / 576, rem = t % 576, cb = rem >> 3, ks = rem & 7;
        const GAS float* wp = (const GAS float*)a.w_mod + ((size_t)l * D + ks * 256) * NMODC + cb * 256 + F.lane * 4;
        f32x4 acc0 = {0.f, 0.f, 0.f, 0.f}, acc1 = acc0, acc2 = acc0;
        const LAS float* s0 = sv + ks * 256, *s1 = sv + D + ks * 256, *s2 = sv + 2 * D + ks * 256;
#pragma unroll 8
        for (int k = 0; k < 256; ++k) { const f32x4 w = __builtin_nontemporal_load((const GAS f32x4*)(wp + (size_t)k * NMODC)); acc0 += w * s0[k]; acc1 += w * s1[k]; acc2 += w * s2[k]; }
        GAS float* pp = (GAS float*)(ws + WS_MODP) + ((size_t)(ks * 4 + l) * 3) * NMODC + cb * 256 + F.lane * 4;
        *(GAS f32x4*)pp = acc0; *(GAS f32x4*)(pp + NMODC) = acc1; *(GAS f32x4*)(pp + 2 * NMODC) = acc2;
    }
    for (int m = gw; m < MTOK; m += NGW) {
        GAS xres_t* xo = (GAS xres_t*)(ws + WS_X) + (size_t)m * D + 4 * F.lane;
        if (m < NCTX) { const GAS f32x4* xi = (const GAS f32x4*)a.x_prompt + (size_t)m * (D / 4) + F.lane;
#pragma unroll
            for (int j = 0; j < 8; ++j) st_x4(xo + 256 * j, xi[64 * j]);
        } else {
            const int tok = (m - NCTX) & (DSEQ - 1); const float rr = (float)(tok >> 6), cc = (float)(tok & 63);
            const GAS f32x4* xi = (const GAS f32x4*)a.x_sample + (size_t)(m - NCTX) * (D / 4) + F.lane;
#pragma unroll
            for (int j = 0; j < 8; ++j) { f32x4 v = xi[64 * j]; const int e0 = 4 * (F.lane + 64 * j), qd = e0 >> 9, f0 = e0 & 511; const float pos = (qd < 2) ? rr : cc;
#pragma unroll
                for (int i = 0; i < 4; ++i) { const float fr = expf(-9.210340371976184f * (float)(f0 + i) * (1.0f / 512.0f)); float s, c; sincos_small(pos * fr, s, c); v[i] += (qd & 1) ? c : s; }
                st_x4(xo + 256 * j, v); }
        }
    }
    __syncthreads();
    { const int p0 = (F.G == 256) ? SEQ_P0 : SEQ_TOTAL;
      if (F.G == 256) { for (int i = 0; ; ++i) { int s; if (i < PRO_SKIP) { if (gw < 256) continue; s = i * 1792 + gw - 256; } else s = PRO_SKIP * 1792 + (i - PRO_SKIP) * 2048 + gw; if (s >= p0) break; convert_seq_item(a, ws, scr, F.lane, s); } }
      else for (int s = gw; s < p0; s += NGW) convert_seq_item(a, ws, scr, F.lane, s); }
}
__device__ __forceinline__ void prologue_b(const Frame& F_in, const Args& a) {
    OPAQUE_FRAME(F);
    const GAS float* pp = (const GAS float*)(a.ws + WS_MODP); GAS float* mo = (GAS float*)(a.ws + WS_MODS);
    for (int i = F.vcu * 512 + F.tid; i < 4 * 3 * NMODC; i += F.G * 512) {
        const int l = i / (3 * NMODC), n = i % NMODC; float s = a.b_mod[l * NMODC + n];
#pragma unroll
        for (int ks = 0; ks < 8; ++ks) s += pp[(size_t)ks * (4 * 3 * NMODC) + i];
        mo[i] = s;
    }
}

__device__ __forceinline__ void norm_phase(const Frame& F_in, const Args& a, const float* ng, const float* modbase  , int s) {
    OPAQUE_FRAME(F);
    const int gw = F.vcu * NWAVES + F.wave, NGW = F.G * NWAVES;
    const GAS f32x4* g4 = (const GAS f32x4*)ng + F.lane;
    for (int m = gw; m < MTOK; m += NGW) {
        const int grp = m < NCTX ? 0 : 1 + ((m - NCTX) >> 10);
        const GAS xres_t* xr = (const GAS xres_t*)(a.ws + WS_X) + (size_t)m * D + 4 * F.lane;
        const GAS f32x4* sh = (const GAS f32x4*)((const GAS float*)modbase + (size_t)grp * NMODC + (3 * s) * D) + F.lane;
        const GAS f32x4* sc = sh + D / 4;
        f32x4 v[8]; float ss = 0.f;
#pragma unroll
        for (int j = 0; j < 8; ++j) { v[j] = ld_x4(xr + 256 * j); ss += (v[j].x * v[j].x + v[j].y * v[j].y) + (v[j].z * v[j].z + v[j].w * v[j].w); }
        const float r = rsqrt_f(wave_sum(ss) * (1.0f / D) + RMS_EPS);
        GAS u32x2* o = (GAS u32x2*)((GAS bf16_t*)(a.ws + WS_H) + (size_t)m * D) + F.lane;
#pragma unroll
        for (int j = 0; j < 8; ++j) { const f32x4 gg = g4[64 * j], s1 = sc[64 * j], s0 = sh[64 * j]; const f32x4 h = (v[j] * r * gg) * (s1 + 1.0f) + s0;
            u32x2 w; w.x = cvt_pk_bf16(h.x, h.y); w.y = cvt_pk_bf16(h.z, h.w); o[64 * j] = w; }
    }
}
__device__ __forceinline__ void final_phase(const Frame& F_in, const Args& a) {
    OPAQUE_FRAME(F);
    const int gw = F.vcu * NWAVES + F.wave, NGW = F.G * NWAVES;
    const GAS f32x4* g4 = (const GAS f32x4*)a.final_g + F.lane;
    for (int m = gw; m < MTOK; m += NGW) {
        const GAS xres_t* xr = (const GAS xres_t*)(a.ws + WS_X) + (size_t)m * D + 4 * F.lane;
        f32x4 v[8]; float ss = 0.f;
#pragma unroll
        for (int j = 0; j < 8; ++j) { v[j] = ld_x4(xr + 256 * j); ss += (v[j].x * v[j].x + v[j].y * v[j].y) + (v[j].z * v[j].z + v[j].w * v[j].w); }
        const float r = rsqrt_f(wave_sum(ss) * (1.0f / D) + RMS_EPS);
        GAS f32x4* o = (GAS f32x4*)a.out + (size_t)m * (D / 4) + F.lane;
#pragma unroll
        for (int j = 0; j < 8; ++j) o[64 * j] = v[j] * r * g4[64 * j];
    }
}
__device__ __forceinline__ void rstd_phase(const Frame& F_in, const Args& a) {
    OPAQUE_FRAME(F);
    const int gw = F.vcu * NWAVES + F.wave, NGW = F.G * NWAVES;
    for (int m = gw; m < MTOK; m += NGW) {
        const GAS xres_t* xr = (const GAS xres_t*)(a.ws + WS_X) + (size_t)m * D + 4 * F.lane;
        float ss = 0.f;
#pragma unroll
        for (int j = 0; j < 8; ++j) { const f32x4 v = ld_x4(xr + 256 * j); ss += (v.x * v.x + v.y * v.y) + (v.z * v.z + v.w * v.w); }
        const float r = rsqrt_f(wave_sum(ss) * (1.0f / D) + RMS_EPS);
        if (F.lane == 0) __hip_atomic_store((GAS float*)(a.ws + WS_RSTD) + m, r, __ATOMIC_RELAXED, __HIP_MEMORY_SCOPE_AGENT);
    }
}
template <int HALFW>
__device__ __forceinline__ void pool_task(const GAS xres_t* X, const GAS unsigned long long* RS, GAS bf16_t* Hout, int r0, int s0, int s1, int col, const f32x4 gs, int lane) {
    constexpr int NR = 16 + 2 * HALFW;
    float rl = 0.f; { const int r = r0 - HALFW + (lane & 31); if ((lane & 31) < NR && r >= s0 && r < s1) rl = rsqrt_f((float)RS[r] * (1.0f / 1048576.0f / D) + RMS_EPS); }
    f32x4 v[NR];
#pragma unroll
    for (int i = 0; i < NR; ++i) { int r = r0 - HALFW + i; r = r < 0 ? 0 : (r > MTOK - 1 ? MTOK - 1 : r);
        v[i] = ld_x4(X + (size_t)r * D + col) * __builtin_bit_cast(float, __builtin_amdgcn_readlane(__builtin_bit_cast(int, rl), i)); }
    f32x4 sum = {0.f, 0.f, 0.f, 0.f};
#pragma unroll
    for (int i = 0; i < 2 * HALFW; ++i) sum += v[i];
#pragma unroll
    for (int t = 0; t < 16; ++t) {
        int lo = r0 + t - HALFW; if (lo < s0) lo = s0; int hi = r0 + t + HALFW; if (hi > s1) hi = s1;
        const float inv = __builtin_amdgcn_rcpf((float)(hi - lo));
        const f32x4 o = gs * (sum * inv - v[t + HALFW]);
        u32x2 w; w.x = cvt_pk_bf16(o.x, o.y); w.y = cvt_pk_bf16(o.z, o.w);
        *(GAS u32x2*)(Hout + (size_t)(r0 + t) * D + col) = w;
        if (t < 15) sum += v[t + 2 * HALFW] - v[t];
    }
}
__device__ __forceinline__ void pool_pre_phase(const Frame& F_in, const Args& a, const float* ng, const float* modbase, const unsigned long long* ss) {
    OPAQUE_FRAME(F);
    const GAS xres_t* X = (const GAS xres_t*)(a.ws + WS_X); const GAS unsigned long long* RS = (const GAS unsigned long long*)ss; GAS bf16_t* Hout = (GAS bf16_t*)(a.ws + WS_H);
    for (int task = F.vcu * 512 + F.tid; task < 640 * 512; task += F.G * 512) {
        const int seg = task >> 9, cq = task & 511, r0 = seg * 16, col = cq * 4, gi = __builtin_amdgcn_readfirstlane(cq >> 7);
        const int s0 = r0 < NCTX ? (r0 & ~(SEQ - 1)) : NCTX + ((r0 - NCTX) & ~(DSEQ - 1));
        const int s1 = s0 + (r0 < NCTX ? SEQ : DSEQ);
        const int grp = r0 < NCTX ? 0 : 1 + ((r0 - NCTX) >> 10);
        const f32x4 gs = *(const GAS f32x4*)((const GAS float*)ng + col) * (*(const GAS f32x4*)((const GAS float*)modbase + (size_t)grp * NMODC + 4 * D + col) + 1.0f);
        if (gi == 0) pool_task<1>(X, RS, Hout, r0, s0, s1, col, gs, F.lane);
        else if (gi == 1) pool_task<2>(X, RS, Hout, r0, s0, s1, col, gs, F.lane);
        else if (gi == 2) pool_task<4>(X, RS, Hout, r0, s0, s1, col, gs, F.lane);
        else pool_task<8>(X, RS, Hout, r0, s0, s1, col, gs, F.lane);
    }
}

__device__ __forceinline__ void gdn_prep_phase(const Frame& F_in, const Args& a, int mi) {
    OPAQUE_FRAME(F);
    const GAS bf16_t* P = (const GAS bf16_t*)(a.ws + WS_P); GAS bf16_t* Q = (GAS bf16_t*)(a.ws + WS_QKV);
    const int ch8 = F.tid & 15, rr = F.tid >> 4;
    if (F.G != 256) {
        for (int unit = F.vcu; unit < 160 * 16; unit += F.G) {
            const int blk = unit >> 4, h = unit & 15, r0 = blk * 64;
            const int s0 = r0 < NCTX ? (r0 & ~(SEQ - 1)) : NCTX + ((r0 - NCTX) & ~(DSEQ - 1)), s1 = s0 + (r0 < NCTX ? SEQ : DSEQ);
            if (F.tid < 128) { const int c = F.tid & 63, dir = F.tid >> 6, tok = r0 + c;
                const GAS float* ab = (const GAS float*)(a.ws + WS_AB) + (size_t)tok * 64 + dir * 32 + h;
                const float xa = ab[0] + a.gdn_dt_bias[(mi * 2 + dir) * 16 + h], xb = ab[16];
                const float sp = softplus_f(xa);
                __hip_atomic_store((GAS float*)(a.ws + WS_GG) + ((size_t)dir * MTOK + tok) * 16 + h, -expf(a.gdn_a_log[(mi * 2 + dir) * 16 + h]) * sp, __ATOMIC_RELAXED, __HIP_MEMORY_SCOPE_AGENT);
                __hip_atomic_store((GAS float*)(a.ws + WS_GB) + ((size_t)dir * MTOK + tok) * 16 + h, 1.0f / (1.0f + expf(-xb)), __ATOMIC_RELAXED, __HIP_MEMORY_SCOPE_AGENT); }
            for (int ten = 0; ten < 3; ++ten) { const int chan = ten * D + h * DKV + ch8 * 8;
                for (int ps = 0; ps < 2; ++ps) { const int tok = r0 + rr + 32 * ps; float acc[8] = {0.f, 0.f, 0.f, 0.f, 0.f, 0.f, 0.f, 0.f};
                    for (int j = 0; j < 5; ++j) { const int t = tok + j - 2; u32x4 u = {0u, 0u, 0u, 0u}; if (t >= s0 && t < s1) u = *(const GAS u32x4*)(P + (size_t)t * 8192 + chan);
                        const GAS f32x4* wp = (const GAS f32x4*)((const GAS float*)a.gdn_conv + ((size_t)mi * 5 + j) * NQKV + chan); const f32x4 w0 = wp[0], w1 = wp[1];
                        acc[0] = fmaf(bf_lo(u.x), w0.x, acc[0]); acc[1] = fmaf(bf_hi(u.x), w0.y, acc[1]); acc[2] = fmaf(bf_lo(u.y), w0.z, acc[2]); acc[3] = fmaf(bf_hi(u.y), w0.w, acc[3]);
                        acc[4] = fmaf(bf_lo(u.z), w1.x, acc[4]); acc[5] = fmaf(bf_hi(u.z), w1.y, acc[5]); acc[6] = fmaf(bf_lo(u.w), w1.z, acc[6]); acc[7] = fmaf(bf_hi(u.w), w1.w, acc[7]); }
                    float ss = 0.f;
                    for (int i = 0; i < 8; ++i) { acc[i] = silu_f(acc[i]); ss += acc[i] * acc[i]; }
                    if (ten < 2) { ss += __shfl_xor(ss, 1); ss += __shfl_xor(ss, 2); ss += __shfl_xor(ss, 4); ss += __shfl_xor(ss, 8);
                        float sc = rsqrt_f(ss + L2_EPS); if (ten == 0) sc *= 0.08838834764831845f;
                        for (int i = 0; i < 8; ++i) acc[i] *= sc; }
                    u32x4 o; o.x = cvt_pk_bf16(acc[0], acc[1]); o.y = cvt_pk_bf16(acc[2], acc[3]); o.z = cvt_pk_bf16(acc[4], acc[5]); o.w = cvt_pk_bf16(acc[6], acc[7]);
                    *(GAS u32x4*)(Q + (size_t)tok * NQKV + chan) = o; } } }
        return;
    }
    const int h = F.vcu & 15, b0 = F.vcu >> 4;
    LAS float* wl = (LAS float*)F.lds;
    for (int i = F.tid; i < 3 * 5 * 128; i += NWAVES * 64) { const int ten = i / 640, j = (i % 640) >> 7, c = i & 127; wl[i] = a.gdn_conv[((size_t)mi * 5 + j) * NQKV + ten * D + h * DKV + c]; }
    __syncthreads();
    const float dtb0 = a.gdn_dt_bias[(mi * 2 + 0) * 16 + h], dtb1 = a.gdn_dt_bias[(mi * 2 + 1) * 16 + h];
    const float na0 = -expf(a.gdn_a_log[(mi * 2 + 0) * 16 + h]), na1 = -expf(a.gdn_a_log[(mi * 2 + 1) * 16 + h]);
#define PREP_LOAD(dst, hu) do { const int r0_ = (b0 + 16 * ((hu) >> 1)) * 64 + 32 * ((hu) & 1); \
        const int s0_ = r0_ < NCTX ? (r0_ & ~(SEQ - 1)) : NCTX + ((r0_ - NCTX) & ~(DSEQ - 1)), s1_ = s0_ + (r0_ < NCTX ? SEQ : DSEQ); \
        _Pragma("unroll") for (int ten = 0; ten < 3; ++ten) _Pragma("unroll") for (int j = 0; j < 5; ++j) { const int t = r0_ + rr + j - 2; dst[ten][j] = (u32x4){0u, 0u, 0u, 0u}; \
            if (t >= s0_ && t < s1_) dst[ten][j] = *(const GAS u32x4*)(P + (size_t)t * 8192 + ten * D + h * DKV + ch8 * 8); } } while (0)
#define PREP_COMPUTE(srcu, hu) do { const int r0_ = (b0 + 16 * ((hu) >> 1)) * 64 + 32 * ((hu) & 1); const int tok = r0_ + rr; \
        if (F.tid < 64) {     \
            const int c_ = F.tid & 31, dir = F.tid >> 5, tk = r0_ + c_; \
            const GAS float* ab = (const GAS float*)(a.ws + WS_AB) + (size_t)tk * 64 + dir * 32 + h; \
            const float xa = ab[0] + (dir ? dtb1 : dtb0), xb = ab[16]; \
            const float sp = softplus_f(xa); \
            __hip_atomic_store((GAS float*)(a.ws + WS_GG) + ((size_t)dir * MTOK + tk) * 16 + h, (dir ? na1 : na0) * sp, __ATOMIC_RELAXED, __HIP_MEMORY_SCOPE_AGENT); \
            __hip_atomic_store((GAS float*)(a.ws + WS_GB) + ((size_t)dir * MTOK + tk) * 16 + h, 1.0f / (1.0f + expf(-xb)), __ATOMIC_RELAXED, __HIP_MEMORY_SCOPE_AGENT); } \
        _Pragma("unroll") for (int ten = 0; ten < 3; ++ten) { \
            float acc[8] = {0.f, 0.f, 0.f, 0.f, 0.f, 0.f, 0.f, 0.f}; \
            _Pragma("unroll") for (int j = 0; j < 5; ++j) { const u32x4 u = srcu[ten][j]; const LAS f32x4* wp = (const LAS f32x4*)(wl + ten * 640 + j * 128 + ch8 * 8); const f32x4 w0 = wp[0], w1 = wp[1]; \
                acc[0] = fmaf(bf_lo(u.x), w0.x, acc[0]); acc[1] = fmaf(bf_hi(u.x), w0.y, acc[1]); acc[2] = fmaf(bf_lo(u.y), w0.z, acc[2]); acc[3] = fmaf(bf_hi(u.y), w0.w, acc[3]); \
                acc[4] = fmaf(bf_lo(u.z), w1.x, acc[4]); acc[5] = fmaf(bf_hi(u.z), w1.y, acc[5]); acc[6] = fmaf(bf_lo(u.w), w1.z, acc[6]); acc[7] = fmaf(bf_hi(u.w), w1.w, acc[7]); } \
            float ss = 0.f; \
            _Pragma("unroll") for (int i = 0; i < 8; ++i) { acc[i] = silu_f(acc[i]); ss += acc[i] * acc[i]; } \
            if (ten < 2) { ss += __shfl_xor(ss, 1); ss += __shfl_xor(ss, 2); ss += __shfl_xor(ss, 4); ss += __shfl_xor(ss, 8); \
                float sc = rsqrt_f(ss + L2_EPS); if (ten == 0) sc *= 0.08838834764831845f; \
                _Pragma("unroll") for (int i = 0; i < 8; ++i) acc[i] *= sc; } \
            u32x4 o; o.x = cvt_pk_bf16(acc[0], acc[1]); o.y = cvt_pk_bf16(acc[2], acc[3]); o.z = cvt_pk_bf16(acc[4], acc[5]); o.w = cvt_pk_bf16(acc[6], acc[7]); \
            *(GAS u32x4*)(Q + (size_t)tok * NQKV + ten * D + h * DKV + ch8 * 8) = o; } } while (0)
    u32x4 ua[3][5], ub[3][5];
    PREP_LOAD(ua, 0);
    for (int hu = 0; hu < 20; hu += 2) {
        PREP_LOAD(ub, hu + 1);
        PREP_COMPUTE(ua, hu);
        if (hu + 2 < 20) PREP_LOAD(ua, hu + 2);
        PREP_COMPUTE(ub, hu + 1);
    }
#undef PREP_LOAD
#undef PREP_COMPUTE
}
__device__ __forceinline__ void gdn_post_phase(const Frame& F_in, const Args& a, int mi) {
    OPAQUE_FRAME(F);
    const int gw = F.vcu * NWAVES + F.wave, NGW = F.G * NWAVES;
    const GAS bf16_t* O0 = (const GAS bf16_t*)(a.ws + WS_O); const GAS bf16_t* O1 = O0 + (size_t)MTOK * D;
    f32x4 ng[8];
#pragma unroll
    for (int j = 0; j < 8; ++j) ng[j] = *(const GAS f32x4*)((const GAS float*)a.gdn_norm_g + mi * DKV + ((4 * (F.lane + 64 * j)) & 127));
    for (int m = gw; m < MTOK; m += NGW) {
        u32x2 o[8], o1[8]; u32x2 zz[8];
#pragma unroll
        for (int j = 0; j < 8; ++j) { const int e0 = 4 * (F.lane + 64 * j);
            o[j] = *(const GAS u32x2*)(O0 + (size_t)m * D + e0); o1[j] = *(const GAS u32x2*)(O1 + (size_t)m * D + e0);
            zz[j] = *(const GAS u32x2*)((const GAS bf16_t*)(a.ws + WS_P) + (size_t)m * 8192 + NQKV + e0); }
#pragma unroll
        for (int j = 0; j < 8; ++j) { const int e0 = 4 * (F.lane + 64 * j);
            const f32x4 ov = {bf_lo(o[j].x) + bf_lo(o1[j].x), bf_hi(o[j].x) + bf_hi(o1[j].x), bf_lo(o[j].y) + bf_lo(o1[j].y), bf_hi(o[j].y) + bf_hi(o1[j].y)};
            float ss = (ov.x * ov.x + ov.y * ov.y) + (ov.z * ov.z + ov.w * ov.w);
            ss += __shfl_xor(ss, 1); ss += __shfl_xor(ss, 2); ss += __shfl_xor(ss, 4); ss += __shfl_xor(ss, 8); ss += __shfl_xor(ss, 16);
            const float r = rsqrt_f(ss * (1.0f / DKV) + RMS_EPS);
            f32x4 v = ov * r * ng[j]; v.x *= silu_f(bf_lo(zz[j].x)); v.y *= silu_f(bf_hi(zz[j].x)); v.z *= silu_f(bf_lo(zz[j].y)); v.w *= silu_f(bf_hi(zz[j].y));
            u32x2 w; w.x = cvt_pk_bf16(v.x, v.y); w.y = cvt_pk_bf16(v.z, v.w);
            *(GAS u32x2*)((GAS bf16_t*)(a.ws + WS_H) + (size_t)m * D + e0) = w;
        }
    }
}

constexpr int SC_Z = 0, SC_Q = 34816, SC_K = 52224, SC_V = 69632, SC_AKK = 88064, SC_TW = 106496, SC_TU = 115712, SC_AQK = 124928, SC_WN = 134144, SC_G = 151552, SC_XS = 153600, TKS = 272;
__device__ __forceinline__ int off256(int row, int cb) { return row * 272 + cb; }
__device__ __forceinline__ int off128(int row, int cb) { return row * 144 + cb; }
__device__ __forceinline__ bf16x8 ldf256(LAS unsigned char* base, int row0, int ks, int fr, int fq) { return *(const LAS bf16x8*)(base + off256(row0 + fr, 64 * ks + 16 * fq)); }
__device__ __forceinline__ bf16x8 ldf128(LAS unsigned char* base, int row0, int ks, int fr, int fq) { return *(const LAS bf16x8*)(base + off128(row0 + fr, 64 * ks + 16 * fq)); }
__device__ __forceinline__ bf16x8 ldtr256(LAS unsigned char* base, int n0, int ks, int fr, int fq) {
    const int q = fr >> 2, p = fr & 3, r = 32 * ks + 8 * fq + q, cb = 2 * (n0 + 4 * p);
    const bf16x4 lo = __builtin_amdgcn_ds_read_tr16_b64_v4i16((LAS bf16x4*)(base + off256(r, cb)));
    const bf16x4 hi = __builtin_amdgcn_ds_read_tr16_b64_v4i16((LAS bf16x4*)(base + off256(r + 4, cb)));
    return __builtin_shufflevector(lo, hi, 0, 1, 2, 3, 4, 5, 6, 7);
}
#define MFMA16(a, b, c) __builtin_amdgcn_mfma_f32_16x16x32_bf16(a, b, c, 0, 0, 0)

__device__ __forceinline__ void scan_item(const Frame& F, const Args& a, int mi, int islat, int b, int h, int dir) {
    LAS unsigned char* L = F.lds;
#define SCAN_BAR() do { asm volatile("s_waitcnt lgkmcnt(0)" ::: "memory"); __builtin_amdgcn_s_barrier(); asm volatile("" ::: "memory"); } while (0)
    const int w = F.wave; const int lane0 = hw_lane(), tid0 = w * 64 + lane0;
    const int T = islat ? DSEQ : SEQ, t0 = islat ? NCTX + b * DSEQ : b * SEQ, nchunk = T / CHUNK;
    const GAS bf16_t* Qc = (const GAS bf16_t*)(a.ws + WS_QKV);
    GAS bf16_t* Og = (GAS bf16_t*)(a.ws + WS_O) + (size_t)dir * MTOK * D;
    const GAS float* GGp = (const GAS float*)(a.ws + WS_GG) + (size_t)dir * MTOK * 16 + h;
    const GAS float* GBp = (const GAS float*)(a.ws + WS_GB) + (size_t)dir * MTOK * 16 + h;
    f32x4 accz[8];
    { const int fr = lane0 & 15, fq = lane0 >> 4;
    if (islat) {
        const GAS float* sp = (const GAS float*)a.state_gdn + ((((size_t)b * 2 + mi) * 2 + dir) * 16 + h) * (DKV * DKV);
#pragma unroll
        for (int dkt = 0; dkt < 8; ++dkt)
#pragma unroll
            for (int r = 0; r < 4; ++r) accz[dkt][r] = sp[(size_t)(16 * dkt + 4 * fq + r) * DKV + 16 * w + fr];
    } else {
#pragma unroll
        for (int dkt = 0; dkt < 8; ++dkt) accz[dkt] = (f32x4){0.f, 0.f, 0.f, 0.f};
    }
#pragma unroll
    for (int dkt = 0; dkt < 8; ++dkt) { u32x2 z; z.x = cvt_pk_bf16(accz[dkt][0], accz[dkt][1]); z.y = cvt_pk_bf16(accz[dkt][2], accz[dkt][3]);
        *(LAS u32x2*)(L + SC_Z + off256(16 * w + fr, 2 * (16 * dkt + 4 * fq))) = z; } }
    u32x4 pq[2], pk[2], pv[2]; float pg = 0.f, pb = 0.f;
#define SCAN_PREFETCH(nn) do { _Pragma("unroll") for (int ps = 0; ps < 2; ++ps) { const int c_ = rr + 32 * ps; const int tok_ = dir ? t0 + T - 1 - (64 * (nn) + c_) : t0 + 64 * (nn) + c_; \
            const GAS bf16_t* src_ = Qc + (size_t)tok_ * NQKV + h * DKV + ch8 * 8; pq[ps] = *(const GAS u32x4*)src_; pk[ps] = *(const GAS u32x4*)(src_ + D); pv[ps] = *(const GAS u32x4*)(src_ + 2 * D); } \
        if (w == 0) { const int tok_ = dir ? t0 + T - 1 - (64 * (nn) + lane) : t0 + 64 * (nn) + lane; pg = GGp[(size_t)tok_ * 16]; pb = GBp[(size_t)tok_ * 16]; } } while (0)
    { const int lane = lane0, ch8 = tid0 & 15, rr = tid0 >> 4; SCAN_PREFETCH(0); }

    for (int n = 0; n < nchunk; ++n) {
        LAS unsigned char *bZ = L + SC_Z, *bQ = L + SC_Q, *bK = L + SC_K, *bV = L + SC_V, *bAKK = L + SC_AKK, *bAQK = L + SC_AQK, *bWN = L + SC_WN, *bXS = L + SC_XS, *bG = L + SC_G;
        int lane = lane0, tid = tid0;
        asm volatile("" : "+v"(bZ), "+v"(bQ), "+v"(bK), "+v"(bV), "+v"(bAKK), "+v"(bAQK), "+v"(bWN), "+v"(bXS), "+v"(bG), "+v"(lane), "+v"(tid));
        const int fr = lane & 15, fq = lane >> 4, ch8 = tid & 15, rr = tid >> 4;
        LAS float* gam = (LAS float*)bG; LAS float* bet = gam + 64; LAS float* eg = gam + 128; LAS float* edl = gam + 192; LAS float* fwv = gam + 256; LAS float* fuv = gam + 320;
        if (w == 0) {
            float cs = pg;
#pragma unroll
            for (int o = 1; o < 64; o <<= 1) { const float t = __shfl_up(cs, o); if (lane >= o) cs += t; }
            const float last = __shfl(cs, 63);
            const float e = fast_exp(cs);
            gam[lane] = cs; bet[lane] = pb; eg[lane] = e; edl[lane] = fast_exp(last - cs); fwv[lane] = pb * e; fuv[lane] = pb;
        }
#pragma unroll
        for (int ps = 0; ps < 2; ++ps) { const int o = off256(rr + 32 * ps, ch8 * 16);
            *(LAS u32x4*)(bQ + o) = pq[ps]; *(LAS u32x4*)(bK + o) = pk[ps]; *(LAS u32x4*)(bV + o) = pv[ps]; }
        SCAN_BAR();
        if (n + 1 < nchunk) SCAN_PREFETCH(n + 1);
        {
            const int tsel = w >> 2, st = w & 3;
            LAS unsigned char* Bsrc = tsel ? bQ : bK;
            bf16x8 af[4], bfr[4][4];
#pragma unroll
            for (int ks = 0; ks < 4; ++ks) af[ks] = ldf256(bK, 16 * st, ks, fr, fq);
#pragma unroll
            for (int ct = 0; ct < 4; ++ct)
#pragma unroll
                for (int ks = 0; ks < 4; ++ks) bfr[ct][ks] = ldf256(Bsrc, 16 * ct, ks, fr, fq);
            const int s0 = 16 * st + 4 * fq;
            const f32x4 gs4 = *(const LAS f32x4*)(gam + s0);
            float gc[4], bc[4];
#pragma unroll
            for (int ct = 0; ct < 4; ++ct) { gc[ct] = gam[16 * ct + fr]; bc[ct] = bet[16 * ct + fr]; }
            f32x4 acc[4];
#pragma unroll
            for (int ct = 0; ct < 4; ++ct) { acc[ct] = (f32x4){0.f, 0.f, 0.f, 0.f};
#pragma unroll
                for (int ks = 0; ks < 4; ++ks) acc[ct] = MFMA16(af[ks], bfr[ct][ks], acc[ct]); }
#pragma unroll
            for (int ct = 0; ct < 4; ++ct) {
                const int c = 16 * ct + fr;
                f32x4 o;
#pragma unroll
                for (int r = 0; r < 4; ++r) { const int s = s0 + r; const float e = fast_exp(gc[ct] - gs4[r]);
                    const float vq = (c >= s) ? acc[ct][r] * e : 0.f, vk = (c > s) ? bc[ct] * acc[ct][r] * e : 0.f; o[r] = tsel ? vq : vk; }
                if (tsel) { u32x2 wv; wv.x = cvt_pk_bf16(o[0], o[1]); wv.y = cvt_pk_bf16(o[2], o[3]); *(LAS u32x2*)(bAQK + off128(c, 2 * s0)) = wv; }
                else *(LAS f32x4*)(bAKK + c * TKS + s0 * 4) = o;
            }
        }
        SCAN_BAR();
        if (w == 0) {
            const int g = fq, j = fr;
            {
                LAS unsigned char* bb = bAKK + g * (16 * TKS + 64);
                float t[16]; t[0] = 0.f;
#define D1_BATCH(c_lo, c_hi) { f32x4 rv[16][4]; float aj[16]; \
                    _Pragma("unroll") for (int c = c_lo; c < c_hi; ++c) { aj[c] = *(const LAS float*)(bb + c * TKS + j * 4); \
                        _Pragma("unroll") for (int q = 0; q < 4; ++q) if (4 * q < c) rv[c][q] = *(const LAS f32x4*)(bb + c * TKS + q * 16); } \
                    _Pragma("unroll") for (int c = c_lo; c < c_hi; ++c) { float a0 = -aj[c], a1 = 0.f; \
                        _Pragma("unroll") for (int s = 0; s < c; ++s) { if (s & 1) a1 = fmaf(-rv[c][s >> 2][s & 3], t[s], a1); else a0 = fmaf(-rv[c][s >> 2][s & 3], t[s], a0); } \
                        t[c] = a0 + a1; } \
                    asm volatile("" : "+v"(t[c_hi - 1])); }
                D1_BATCH(1, 6) D1_BATCH(6, 11) D1_BATCH(11, 16)
#undef D1_BATCH
#pragma unroll
                for (int c = 0; c < 16; ++c) *(LAS float*)(bb + c * TKS + j * 4) = t[c];
                *(LAS float*)(bb + j * TKS + j * 4) = 1.0f;
            }
#define TA(r_, c_) (*(const LAS float*)(bAKK + (r_) * TKS + (c_) * 4))
#define XSA(r_, c_) (*(LAS float*)(bXS + (r_) * 128 + (c_) * 4))
#define MF32(a_, b_, c_) __builtin_amdgcn_mfma_f32_16x16x4f32(a_, b_, c_, 0, 0, 0)
            {
                f32x4 x0 = {0.f, 0.f, 0.f, 0.f}, x1 = x0;
#pragma unroll
                for (int kk = 0; kk < 4; ++kk) { x0 = MF32(TA(16 + j, 4 * kk + g), TA(4 * kk + g, j), x0); x1 = MF32(TA(48 + j, 32 + 4 * kk + g), TA(32 + 4 * kk + g, 32 + j), x1); }
#pragma unroll
                for (int r = 0; r < 4; ++r) { XSA(4 * g + r, j) = x0[r]; XSA(16 + 4 * g + r, j) = x1[r]; }
                f32x4 y0 = {0.f, 0.f, 0.f, 0.f}, y1 = y0;
#pragma unroll
                for (int kk = 0; kk < 4; ++kk) { y0 = MF32(TA(16 + j, 16 + 4 * kk + g), XSA(4 * kk + g, j), y0); y1 = MF32(TA(48 + j, 48 + 4 * kk + g), XSA(16 + 4 * kk + g, j), y1); }
#pragma unroll
                for (int r = 0; r < 4; ++r) { *(LAS float*)(bAKK + (16 + 4 * g + r) * TKS + j * 4) = -y0[r]; *(LAS float*)(bAKK + (48 + 4 * g + r) * TKS + (32 + j) * 4) = -y1[r]; }
            }
            {
                f32x4 y[2][2];
#pragma unroll
                for (int rt = 0; rt < 2; ++rt)
#pragma unroll
                    for (int ct = 0; ct < 2; ++ct) { y[rt][ct] = (f32x4){0.f, 0.f, 0.f, 0.f};
#pragma unroll
                        for (int kk = 4 * ct; kk < 8; ++kk) y[rt][ct] = MF32(TA(32 + 16 * rt + j, 4 * kk + g), TA(4 * kk + g, 16 * ct + j), y[rt][ct]); }
#pragma unroll
                for (int rt = 0; rt < 2; ++rt)
#pragma unroll
                    for (int ct = 0; ct < 2; ++ct)
#pragma unroll
                        for (int r = 0; r < 4; ++r) XSA(16 * rt + 4 * g + r, 16 * ct + j) = y[rt][ct][r];
                f32x4 z[2][2];
#pragma unroll
                for (int rt = 0; rt < 2; ++rt)
#pragma unroll
                    for (int ct = 0; ct < 2; ++ct) { z[rt][ct] = (f32x4){0.f, 0.f, 0.f, 0.f};
#pragma unroll
                        for (int kk = 0; kk < 4 * (rt + 1); ++kk) z[rt][ct] = MF32(TA(32 + 16 * rt + j, 32 + 4 * kk + g), XSA(4 * kk + g, 16 * ct + j), z[rt][ct]); }
#pragma unroll
                for (int rt = 0; rt < 2; ++rt)
#pragma unroll
                    for (int ct = 0; ct < 2; ++ct)
#pragma unroll
                        for (int r = 0; r < 4; ++r) *(LAS float*)(bAKK + (32 + 16 * rt + 4 * g + r) * TKS + (16 * ct + j) * 4) = -z[rt][ct][r];
            }
#undef TA
#undef XSA
#undef MF32
        }
        SCAN_BAR();
        f32x4 accu[4];
        {
            bf16x8 kt[2], vt[2]; f32x4 tv[4][2][2], fw4[2][2], fu4[2][2];
#pragma unroll
            for (int ks = 0; ks < 2; ++ks) { kt[ks] = ldtr256(bK, 16 * w, ks, fr, fq); vt[ks] = ldtr256(bV, 16 * w, ks, fr, fq);
#pragma unroll
                for (int hh = 0; hh < 2; ++hh) { fw4[ks][hh] = *(const LAS f32x4*)(fwv + 32 * ks + 8 * fq + 4 * hh); fu4[ks][hh] = *(const LAS f32x4*)(fuv + 32 * ks + 8 * fq + 4 * hh); } }
#pragma unroll
            for (int ct = 0; ct < 4; ++ct)
#pragma unroll
                for (int ks = 0; ks < 2; ++ks) { const LAS f32x4* tp = (const LAS f32x4*)(bAKK + (16 * ct + fr) * TKS + (32 * ks + 8 * fq) * 4); tv[ct][ks][0] = tp[0]; tv[ct][ks][1] = tp[1]; }
            f32x4 aw[4];
#pragma unroll
            for (int ct = 0; ct < 4; ++ct) {
                aw[ct] = (f32x4){0.f, 0.f, 0.f, 0.f}; accu[ct] = (f32x4){0.f, 0.f, 0.f, 0.f};
#pragma unroll
                for (int ks = 0; ks < 2; ++ks) {
                    const f32x4 w0 = tv[ct][ks][0] * fw4[ks][0], w1 = tv[ct][ks][1] * fw4[ks][1], u0 = tv[ct][ks][0] * fu4[ks][0], u1 = tv[ct][ks][1] * fu4[ks][1];
                    u32x4 tw, tu; tw.x = cvt_pk_bf16(w0[0], w0[1]); tw.y = cvt_pk_bf16(w0[2], w0[3]); tw.z = cvt_pk_bf16(w1[0], w1[1]); tw.w = cvt_pk_bf16(w1[2], w1[3]);
                    tu.x = cvt_pk_bf16(u0[0], u0[1]); tu.y = cvt_pk_bf16(u0[2], u0[3]); tu.z = cvt_pk_bf16(u1[0], u1[1]); tu.w = cvt_pk_bf16(u1[2], u1[3]);
                    aw[ct] = MFMA16(kt[ks], __builtin_bit_cast(bf16x8, tw), aw[ct]); accu[ct] = MFMA16(__builtin_bit_cast(bf16x8, tu), vt[ks], accu[ct]);
                }
            }
#pragma unroll
            for (int ct = 0; ct < 4; ++ct) { u32x2 wv; wv.x = cvt_pk_bf16(-aw[ct][0], -aw[ct][1]); wv.y = cvt_pk_bf16(-aw[ct][2], -aw[ct][3]);
                *(LAS u32x2*)(bWN + off256(16 * ct + fr, 2 * (16 * w + 4 * fq))) = wv; }
        }
        SCAN_BAR();
        {
            bf16x8 zf[4];
            {
                bf16x8 wf[4][4]; f32x4 ed[4];
#pragma unroll
                for (int ks = 0; ks < 4; ++ks) zf[ks] = ldf256(bZ, 16 * w, ks, fr, fq);
#pragma unroll
                for (int ct = 0; ct < 4; ++ct) { ed[ct] = *(const LAS f32x4*)(edl + 16 * ct + 4 * fq);
#pragma unroll
                    for (int ks = 0; ks < 4; ++ks) wf[ct][ks] = ldf256(bWN, 16 * ct, ks, fr, fq); }
#pragma unroll
                for (int ct = 0; ct < 4; ++ct)
#pragma unroll
                    for (int ks = 0; ks < 4; ++ks) accu[ct] = MFMA16(wf[ct][ks], zf[ks], accu[ct]);
#pragma unroll
                for (int ct = 0; ct < 4; ++ct) {
                    const int c0 = 16 * ct + 4 * fq, dv = 16 * w + fr;
                    u32x2 v1, v2; v1.x = cvt_pk_bf16(accu[ct][0], accu[ct][1]); v1.y = cvt_pk_bf16(accu[ct][2], accu[ct][3]);
                    v2.x = cvt_pk_bf16(accu[ct][0] * ed[ct][0], accu[ct][1] * ed[ct][1]); v2.y = cvt_pk_bf16(accu[ct][2] * ed[ct][2], accu[ct][3] * ed[ct][3]);
                    *(LAS u32x2*)(bV + off128(dv, 2 * c0)) = v1; *(LAS u32x2*)(bAKK + off128(dv, 2 * c0)) = v2;
                }
            }
            f32x4 ao[4];
            {
                bf16x8 qf[4][4]; float egc[4];
#pragma unroll
                for (int ct = 0; ct < 4; ++ct) { egc[ct] = eg[16 * ct + fr];
#pragma unroll
                    for (int ks = 0; ks < 4; ++ks) qf[ct][ks] = ldf256(bQ, 16 * ct, ks, fr, fq); }
#pragma unroll
                for (int ct = 0; ct < 4; ++ct) { ao[ct] = (f32x4){0.f, 0.f, 0.f, 0.f};
#pragma unroll
                    for (int ks = 0; ks < 4; ++ks) ao[ct] = MFMA16(zf[ks], qf[ct][ks], ao[ct]);
                    ao[ct] = ao[ct] * egc[ct]; }
            }
            bf16x8 vd[2];
            {
                bf16x8 vf[2], aq[4][2];
#pragma unroll
                for (int ks = 0; ks < 2; ++ks) { vf[ks] = ldf128(bV, 16 * w, ks, fr, fq); vd[ks] = ldf128(bAKK, 16 * w, ks, fr, fq);
#pragma unroll
                    for (int ct = 0; ct < 4; ++ct) aq[ct][ks] = ldf128(bAQK, 16 * ct, ks, fr, fq); }
#pragma unroll
                for (int ct = 0; ct < 4; ++ct) {
#pragma unroll
                    for (int ks = 0; ks < 2; ++ks) ao[ct] = MFMA16(vf[ks], aq[ct][ks], ao[ct]);
                    const int c = 16 * ct + fr; const int tok = dir ? t0 + T - 1 - (64 * n + c) : t0 + 64 * n + c;
                    { u32x2 ow; ow.x = cvt_pk_bf16(ao[ct][0], ao[ct][1]); ow.y = cvt_pk_bf16(ao[ct][2], ao[ct][3]); *(GAS u32x2*)(Og + (size_t)tok * D + h * DKV + 16 * w + 4 * fq) = ow; }
                }
            }
            {
                const float cdec = eg[63];
                bf16x8 ktr[8][2];
#pragma unroll
                for (int dkt = 0; dkt < 8; ++dkt)
#pragma unroll
                    for (int ks = 0; ks < 2; ++ks) ktr[dkt][ks] = ldtr256(bK, 16 * dkt, ks, fr, fq);
#pragma unroll
                for (int dkt = 0; dkt < 8; ++dkt) {
                    accz[dkt] = accz[dkt] * cdec;
#pragma unroll
                    for (int ks = 0; ks < 2; ++ks) accz[dkt] = MFMA16(ktr[dkt][ks], vd[ks], accz[dkt]);
                }
#pragma unroll
                for (int dkt = 0; dkt < 8; ++dkt) { u32x2 z; z.x = cvt_pk_bf16(accz[dkt][0], accz[dkt][1]); z.y = cvt_pk_bf16(accz[dkt][2], accz[dkt][3]);
                    *(LAS u32x2*)(bZ + off256(16 * w + fr, 2 * (16 * dkt + 4 * fq))) = z; }
            }
        }
        SCAN_BAR();
    }
#undef SCAN_PREFETCH
#undef SCAN_BAR
    if (!islat) {
        const int fr = lane0 & 15, fq = lane0 >> 4;
        GAS float* sp = (GAS float*)a.out + (size_t)MTOK * D + ((((size_t)b * 2 + mi) * 2 + dir) * 16 + h) * (DKV * DKV);
#pragma unroll
        for (int dkt = 0; dkt < 8; ++dkt)
#pragma unroll
            for (int r = 0; r < 4; ++r) sp[(size_t)(16 * dkt + 4 * fq + r) * DKV + 16 * w + fr] = accz[dkt][r];
    }
}
__device__ __forceinline__ void gdn_scan_phase(const Frame& F, const Args& a, int mi) {
    const int c = F.vcu;
    const int nit = (F.G == 256) ? (c < 64 ? 2 : 5) : (64 + 1024 - c + F.G - 1) / F.G;
    for (int j = 0; j < nit; ++j) {
        int i;
        if (F.G == 256) i = (c < 64) ? (j == 0 ? c : 64 + c) : 64 + 64 + (c - 64) * 5 + j; else i = c + j * F.G;
        const int islat = i < 64; const int q = islat ? i : i - 64;
        scan_item(F, a, mi, islat, q >> 5, (q >> 1) & 15, q & 1);
    }
}

__global__ void __launch_bounds__(NWAVES * 64, 2) fwd_kernel(Args a) {
    extern __shared__ __attribute__((aligned(16))) unsigned char lds_raw[];
    Frame F;
    F.lds = (LAS unsigned char*)lds_raw;
    F.tid = threadIdx.x; F.lane = F.tid & 63; F.wave = __builtin_amdgcn_readfirstlane(F.tid >> 6);
    F.G = gridDim.x; { const int bx = blockIdx.x; F.vcu = (F.G % 8 == 0) ? (bx % 8) * (F.G / 8) + bx / 8 : bx; }
    volatile LAS unsigned* MISC = (volatile LAS unsigned*)(F.lds + MISC_OFF);
    for (int u = F.tid; u < (LDS_BYTES - MISC_OFF) / 4; u += NWAVES * 64) MISC[u] = 0u;
    __syncthreads();
    unsigned char* ws = a.ws;
    XcdBarrier bar = xcd_barrier_post((unsigned*)(ws + WS_CTL) + 4096, MISC + 8);
#define GRID_BAR() xcd_barrier(bar, F.wave)
    const float* mods = (const float*)(ws + WS_MODS);

    prologue_a(F, a);
    GRID_BAR();
    prologue_b(F, a);
    GRID_BAR();

    for (int l = 0; l < DEPTH; ++l) {
        const float* modl = mods + (size_t)l * 3 * NMODC;
        const int mi = l >> 1;
        norm_phase(F, a, a.norm_g + (size_t)(l * 3 + 0) * D, modl, 0);
        GRID_BAR();
        { pg8::Gemm g{(const bf16_t*)(ws + WS_H), (const bf16_t*)(ws + WS_BT1 + (size_t)(l * 2 + 0) * SZ_BT1), D, D, D};
          pg8::StaticOrder S; S.init(MTOK / 256, NGU / 256, F.G, (int)blockIdx.x, 0, 0, D);
          pg8::EpiSwiGLU E{(bf16_t*)(ws + WS_ACT)};
          pg8::gemm_phase<pg8::EpiSwiGLU>(F.lds, g, S, E, F.wave); }
        if (F.G == 256 && blockIdx.x >= 184) tail_convert(F, a, slot_start((l >> 1) * 5 + (l & 1) * 3), TAIL_NA, ((int)blockIdx.x - 184) * NWAVES + F.wave, 576);
        GRID_BAR();
        { pg8::Gemm g{(const bf16_t*)(ws + WS_ACT), (const bf16_t*)(ws + WS_BT2 + (size_t)(l * 2 + 0) * SZ_BT2), DFF, DFF, DFF};
          pg8::StaticOrder S; S.init(MTOK / 320, D / 256, F.G, (int)blockIdx.x, 0, 0, DFF);
          unsigned long long* ssn = (l & 1) ? (unsigned long long*)((unsigned*)(ws + WS_CTL) + CW_SS) + (size_t)mi * MTOK : nullptr;
          pg8::EpiResid5 E{(xres_t*)(ws + WS_X), modl + 2 * D, nullptr, ssn, 0.5f, 0};
          pg8::gemm_phase<pg8::EpiResid5, true, 5>(F.lds, g, S, E, F.wave); }
        GRID_BAR();
        if ((l & 1) == 0) {
            norm_phase(F, a, a.norm_g + (size_t)(l * 3 + 1) * D, modl, 1);
            GRID_BAR();
            { pg8::Gemm g{(const bf16_t*)(ws + WS_H), (const bf16_t*)(ws + WS_BTG + (size_t)mi * SZ_BTG), D, D, D};
              pg8::StaticOrder S; S.init(MTOK / 256, NPROJ_PAD / 256, F.G, (int)blockIdx.x, 0, 0, D);
              pg8::EpiProj E{(bf16_t*)(ws + WS_P), (float*)(ws + WS_AB)};
              pg8::gemm_phase<pg8::EpiProj>(F.lds, g, S, E, F.wave); }
            if (F.G == 256 && blockIdx.x >= 40) tail_convert(F, a, slot_start((l >> 1) * 5 + 1), TAIL_NC, ((int)blockIdx.x - 40) * NWAVES + F.wave, 1728);
            GRID_BAR();
            gdn_prep_phase(F, a, mi);
            GRID_BAR();
            gdn_scan_phase(F, a, mi);
            GRID_BAR();
            gdn_post_phase(F, a, mi);
            GRID_BAR();
            { pg8::Gemm g{(const bf16_t*)(ws + WS_H), (const bf16_t*)(ws + WS_BTO + (size_t)mi * SZ_BTO), D, D, D};
              pg8::StaticOrder S; S.init(MTOK / 320, D / 256, F.G, (int)blockIdx.x, 0, 0, D);
              pg8::EpiResid5 E{(xres_t*)(ws + WS_X), modl + 5 * D, nullptr, nullptr, 1.0f, 0};
              pg8::gemm_phase<pg8::EpiResid5, true, 5>(F.lds, g, S, E, F.wave); }
            GRID_BAR();
        } else {
            pool_pre_phase(F, a, a.norm_g + (size_t)(l * 3 + 1) * D, modl, (const unsigned long long*)((const unsigned*)(ws + WS_CTL) + CW_SS) + (size_t)mi * MTOK);
            GRID_BAR();
            { pg8::Gemm g{(const bf16_t*)(ws + WS_H), (const bf16_t*)(ws + WS_BTP + (size_t)mi * SZ_BTP), D, 512, 512};
              pg8::StaticOrder S; S.init(MTOK / 320, D / 256, F.G, (int)blockIdx.x, 1, 0, 512);
              pg8::EpiResid5 E{(xres_t*)(ws + WS_X), modl + 5 * D, a.pool_scale + (size_t)mi * D, nullptr, 1.0f, 0};
              pg8::gemm_phase<pg8::EpiResid5, true, 5>(F.lds, g, S, E, F.wave); }
            GRID_BAR();
        }
        norm_phase(F, a, a.norm_g + (size_t)(l * 3 + 2) * D, modl, 2);
        GRID_BAR();
        { pg8::Gemm g{(const bf16_t*)(ws + WS_H), (const bf16_t*)(ws + WS_BT1 + (size_t)(l * 2 + 1) * SZ_BT1), D, D, D};
          pg8::StaticOrder S; S.init(MTOK / 256, NGU / 256, F.G, (int)blockIdx.x, 0, 0, D);
          pg8::EpiSwiGLU E{(bf16_t*)(ws + WS_ACT)};
          pg8::gemm_phase<pg8::EpiSwiGLU>(F.lds, g, S, E, F.wave); }
        if (F.G == 256 && blockIdx.x >= 184) tail_convert(F, a, slot_start((l >> 1) * 5 + (l & 1) * 3 + ((l & 1) ? 1 : 2)), TAIL_NA, ((int)blockIdx.x - 184) * NWAVES + F.wave, 576);
        GRID_BAR();
        { pg8::Gemm g{(const bf16_t*)(ws + WS_ACT), (const bf16_t*)(ws + WS_BT2 + (size_t)(l * 2 + 1) * SZ_BT2), DFF, DFF, DFF};
          pg8::StaticOrder S; S.init(MTOK / 320, D / 256, F.G, (int)blockIdx.x, 0, 0, DFF);
          pg8::EpiResid5 E{(xres_t*)(ws + WS_X), modl + 8 * D, nullptr, nullptr, 0.5f, 0};
          pg8::gemm_phase<pg8::EpiResid5, true, 5>(F.lds, g, S, E, F.wave); }
        GRID_BAR();
    }
    final_phase(F, a);
}

extern "C" void kernel_launch(void* const* d_in, const int* in_sizes, int n_in, void* d_out, int out_size, void* d_ws, size_t ws_size, hipStream_t stream) {
    static int grid = 0;
    if (grid == 0) {
        if (n_in != 19 || ws_size < WS_END) { fprintf(stderr, "kernel_launch: unexpected n_in %d or ws_size %zu (need %zu)\n", n_in, ws_size, (size_t)WS_END); grid = -1; return; }
        int dev = 0, cus = 0, per_cu = 0;
        if (hipGetDevice(&dev) != hipSuccess || hipDeviceGetAttribute(&cus, hipDeviceAttributeMultiprocessorCount, dev) != hipSuccess) { grid = -1; return; }
        if (hipFuncSetAttribute((const void*)fwd_kernel, hipFuncAttributeMaxDynamicSharedMemorySize, LDS_BYTES) != hipSuccess) { fprintf(stderr, "kernel_launch: hipFuncSetAttribute failed\n"); grid = -1; return; }
        if (hipOccupancyMaxActiveBlocksPerMultiprocessor(&per_cu, (const void*)fwd_kernel, NWAVES * 64, LDS_BYTES) != hipSuccess || per_cu < 1) { fprintf(stderr, "kernel_launch: occupancy query says %d\n", per_cu); }
        (void)hipGetLastError();
        grid = cus;
    }
    if (grid < 0) return;
    (void)hipMemsetAsync((char*)d_ws + WS_CTL, 0, CTL_ZERO_BYTES, stream);
    Args a{};
    a.x_prompt = (const float*)d_in[0]; a.x_sample = (const float*)d_in[1]; a.state_gdn = (const float*)d_in[2]; a.c = (const float*)d_in[3]; a.c_ctx = (const float*)d_in[4];
    a.w_mod = (const float*)d_in[5]; a.b_mod = (const float*)d_in[6]; a.norm_g = (const float*)d_in[7]; a.ffn_w_in = (const float*)d_in[8]; a.ffn_w_out = (const float*)d_in[9];
    a.gdn_w_in = (const float*)d_in[10]; a.gdn_conv = (const float*)d_in[11]; a.gdn_a_log = (const float*)d_in[12]; a.gdn_dt_bias = (const float*)d_in[13]; a.gdn_norm_g = (const float*)d_in[14]; a.gdn_w_out = (const float*)d_in[15];
    a.pool_w = (const float*)d_in[16]; a.pool_scale = (const float*)d_in[17]; a.final_g = (const float*)d_in[18];
    a.out = (float*)d_out; a.ws = (unsigned char*)d_ws;
    hipLaunchKernelGGL(fwd_kernel, dim3(grid), dim3(NWAVES * 64), LDS_BYTES, stream, a);
}
```

```cpp
#include <hip/hip_runtime.h>
#include <cstdio>
#include <cstdint>

#define GAS __attribute__((address_space(1)))
#define LAS __attribute__((address_space(3)))
typedef unsigned short bf16_t;
typedef short bf16x8 __attribute__((ext_vector_type(8)));
typedef short bf16x4 __attribute__((ext_vector_type(4)));
typedef float f32x4 __attribute__((ext_vector_type(4)));
typedef float f32x2 __attribute__((ext_vector_type(2)));
typedef unsigned u32x4 __attribute__((ext_vector_type(4)));
typedef unsigned u32x2 __attribute__((ext_vector_type(2)));

constexpr int D = 2048, NCTX = 8192, NLAT = 2048, MTOK = 10240, DEPTH = 4, DFF = 5504, NGU = 11008;
constexpr int NPROJ = 8256, NPROJ_PAD = 8448, NMOD = 9, NQKV = 6144, NMODC = NMOD * D;
constexpr int SEQ = 256, DSEQ = 1024, NB = 32, NDB = 2, HEADS = 16, DKV = 128, CHUNK = 64;
constexpr float RMS_EPS = 1e-6f, L2_EPS = 1e-6f;

constexpr size_t MiB = 1u << 20;
constexpr size_t WS_CTL = 0, CTL_ZERO_BYTES = 1 * MiB;
constexpr size_t WS_MODP = 1 * MiB;
constexpr size_t WS_MODS = 8 * MiB;
constexpr size_t WS_RSTD = 9 * MiB;
constexpr size_t WS_GG = 10 * MiB;
constexpr size_t WS_GB = 12 * MiB;
constexpr size_t WS_AB = 14 * MiB;
constexpr size_t WS_BT1 = 32 * MiB;
constexpr size_t SZ_BT1 = (size_t)NGU * D * 2;
constexpr size_t WS_BT2 = WS_BT1 + 8 * SZ_BT1;
constexpr size_t SZ_BT2 = (size_t)D * DFF * 2;
constexpr size_t WS_BTG = WS_BT2 + 8 * SZ_BT2;
constexpr size_t SZ_BTG = (size_t)NPROJ_PAD * D * 2;
constexpr size_t WS_BTO = WS_BTG + 2 * SZ_BTG;
constexpr size_t SZ_BTO = (size_t)D * D * 2;
constexpr size_t WS_BTP = WS_BTO + 2 * SZ_BTO;
constexpr size_t SZ_BTP = (size_t)D * 512 * 2;
constexpr size_t WS_X = ((WS_BTP + 2 * SZ_BTP + MiB - 1) / MiB) * MiB;
constexpr size_t WS_H = WS_X + (size_t)MTOK * D * 4;
constexpr size_t WS_ACT = WS_H + (size_t)MTOK * D * 2;
constexpr size_t WS_P = WS_ACT + (size_t)MTOK * DFF * 2;
constexpr size_t WS_QKV = WS_P + (size_t)MTOK * 8192 * 2;
constexpr size_t WS_O = WS_QKV + (size_t)MTOK * NQKV * 2;
constexpr size_t WS_SLAB = WS_O + (size_t)2 * MTOK * D * 4;
constexpr size_t WS_END = WS_SLAB + (size_t)256 * 65536 * 4;
constexpr int CW_SS = 65536;
constexpr int CW_CNT = 16384;

constexpr int LDS_BYTES = 163840;
constexpr int MISC_OFF = 163328;
constexpr int NWAVES = 8;

#define LDS_WAIT() asm volatile("s_waitcnt lgkmcnt(0)" ::: "memory")
#define VM_WAIT() asm volatile("s_waitcnt vmcnt(0)" ::: "memory")
typedef __bf16 bf16x2_t __attribute__((ext_vector_type(2)));
__device__ __forceinline__ unsigned cvt_pk_bf16(float lo, float hi) { const f32x2 v = {lo, hi}; const bf16x2_t b = __builtin_convertvector(v, bf16x2_t); return __builtin_bit_cast(unsigned, b); }
__device__ __forceinline__ float bf_lo(unsigned u) { return __uint_as_float(u << 16); }
__device__ __forceinline__ float bf_hi(unsigned u) { return __uint_as_float(u & 0xffff0000u); }
__device__ __forceinline__ f32x4 ld_bf4(const GAS bf16_t* p) { const u32x2 u = *(const GAS u32x2*)p; return (f32x4){bf_lo(u.x), bf_hi(u.x), bf_lo(u.y), bf_hi(u.y)}; }
__device__ __forceinline__ void st_bf4(GAS bf16_t* p, const f32x4 v) { u32x2 w; w.x = cvt_pk_bf16(v.x, v.y); w.y = cvt_pk_bf16(v.z, v.w); *(GAS u32x2*)p = w; }
#ifndef X_BF16
#define X_BF16 1
#endif
#if X_BF16
typedef bf16_t xres_t;
__device__ __forceinline__ f32x4 ld_x4(const GAS xres_t* p) { return ld_bf4(p); }
__device__ __forceinline__ void st_x4(GAS xres_t* p, const f32x4 v) { st_bf4(p, v); }
#else
typedef float xres_t;
__device__ __forceinline__ f32x4 ld_x4(const GAS xres_t* p) { return *(const GAS f32x4*)p; }
__device__ __forceinline__ void st_x4(GAS xres_t* p, const f32x4 v) { *(GAS f32x4*)p = v; }
#endif
__device__ __forceinline__ void ld_x8(const GAS xres_t* p, f32x4& a, f32x4& b) {
#if X_BF16
    const u32x4 u = *(const GAS u32x4*)p; a = (f32x4){bf_lo(u.x), bf_hi(u.x), bf_lo(u.y), bf_hi(u.y)}; b = (f32x4){bf_lo(u.z), bf_hi(u.z), bf_lo(u.w), bf_hi(u.w)};
#else
    a = *(const GAS f32x4*)p; b = *(const GAS f32x4*)(p + 4);
#endif
}
#if X_BF16
typedef u32x4 xraw8;
__device__ __forceinline__ xraw8 ld_x8raw(const GAS xres_t* p) { return *(const GAS u32x4*)p; }
__device__ __forceinline__ void unpack_x8(const xraw8 u, f32x4& a, f32x4& b) { a = (f32x4){bf_lo(u.x), bf_hi(u.x), bf_lo(u.y), bf_hi(u.y)}; b = (f32x4){bf_lo(u.z), bf_hi(u.z), bf_lo(u.w), bf_hi(u.w)}; }
#else
struct xraw8 { f32x4 a, b; };
__device__ __forceinline__ xraw8 ld_x8raw(const GAS xres_t* p) { xraw8 r; r.a = *(const GAS f32x4*)p; r.b = *(const GAS f32x4*)(p + 4); return r; }
__device__ __forceinline__ void unpack_x8(const xraw8 u, f32x4& a, f32x4& b) { a = u.a; b = u.b; }
#endif
__device__ __forceinline__ void st_x8(GAS xres_t* p, const f32x4 a, const f32x4 b) {
#if X_BF16
    u32x4 w; w.x = cvt_pk_bf16(a.x, a.y); w.y = cvt_pk_bf16(a.z, a.w); w.z = cvt_pk_bf16(b.x, b.y); w.w = cvt_pk_bf16(b.z, b.w); *(GAS u32x4*)p = w;
#else
    *(GAS f32x4*)p = a; *(GAS f32x4*)(p + 4) = b;
#endif
}
__device__ __forceinline__ int hw_lane() { int l; asm volatile("v_mbcnt_lo_u32_b32 %0, -1, 0\n\tv_mbcnt_hi_u32_b32 %0, -1, %0" : "=v"(l)); return l; }
__device__ __forceinline__ float fast_exp(float x) { return __builtin_amdgcn_exp2f(x * 1.44269504089f); }
__device__ __forceinline__ float rsqrt_f(float x) { return __builtin_amdgcn_rsqf(x); }
__device__ __forceinline__ float silu_f(float x) { return x * __builtin_amdgcn_rcpf(1.0f + fast_exp(-x)); }
__device__ __forceinline__ float softplus_f(float x) { const float t = fast_exp(-fabsf(x)); return fmaxf(x, 0.f) + 0.6931471805599453f * __builtin_amdgcn_logf(1.0f + t); }
__device__ __forceinline__ float wave_sum(float v) {
#pragma unroll
    for (int o = 1; o < 64; o <<= 1) v += __shfl_xor(v, o);
    return v;
}

#define XB_TMO      128
#define XB_XCNT(j)  (256  + 64 * (j))
#define XB_XSUB(j)  (1280 + 64 * (j))
#define XB_XGEN(j)  (2304 + 64 * (j))
#define XB_TOP      3328
#define XB_TOPGEN   3392
#define XCD_BAR_WORDS 3456
#define XB_SPIN_CAP (1u << 20)

__device__ __forceinline__ unsigned xb_ld(unsigned* p)              { return __hip_atomic_load(p, __ATOMIC_RELAXED, __HIP_MEMORY_SCOPE_AGENT); }
__device__ __forceinline__ unsigned xb_add(unsigned* p, unsigned v) { return __hip_atomic_fetch_add(p, v, __ATOMIC_RELAXED, __HIP_MEMORY_SCOPE_AGENT); }
__device__ __forceinline__ unsigned xb_xcc_id() { return (unsigned)__builtin_amdgcn_s_getreg((3 << 11) | 20) & 0xFu; }
#define XB_SPIN(cond, bar) do { unsigned _sp = 0; while (cond) { __builtin_amdgcn_s_sleep(1); \
    if ((++_sp & 255u) == 0u) { if (xb_ld(&(bar)[XB_TMO])) break; if (_sp > XB_SPIN_CAP) { atomicAdd(&(bar)[XB_TMO], 1u); break; } } } } while (0)

struct XcdBarrier { unsigned* bar; unsigned x; volatile LAS unsigned* st; };

__device__ __forceinline__ XcdBarrier xcd_barrier_post(unsigned* bar, volatile LAS unsigned* st) {
    XcdBarrier b; b.bar = bar; b.x = xb_xcc_id(); b.st = st;
    if (threadIdx.x == 0) (void)xb_add(&bar[XB_XCNT(b.x)], 1u);
    return b;
}
__device__ __forceinline__ void xcd_barrier_complete(unsigned* bar, unsigned x, unsigned& nloc, unsigned& nx) {
    const unsigned G = gridDim.x * gridDim.y * gridDim.z;
    unsigned sum, cnt, mine, sp = 0u;
    for (;;) {
        sum = 0u; cnt = 0u; mine = 0u;
#pragma unroll
        for (unsigned j = 0; j < 16; ++j) { const unsigned c = xb_ld(&bar[XB_XCNT(j)]); sum += c; cnt += (c > 0u) ? 1u : 0u; mine = (j == x) ? c : mine; }
        if (sum == G) break;
        __builtin_amdgcn_s_sleep(1);
        if ((++sp & 255u) == 0u) { if (xb_ld(&bar[XB_TMO])) break; if (sp > XB_SPIN_CAP) { atomicAdd(&bar[XB_TMO], 1u); break; } }
    }
    nloc = mine > 0u ? mine : 1u; nx = cnt > 0u ? cnt : 1u;
}
__device__ __forceinline__ void xcd_barrier(const XcdBarrier& b, int wave) {
    asm volatile("s_waitcnt vmcnt(0)" ::: "memory");
    __syncthreads();
    int t0_ = wave * 64 + hw_lane();
    if (t0_ == 0) {
        unsigned* bar = b.bar; unsigned bx = b.x;
        asm volatile("" : "+s"(bar), "+s"(bx));
        __builtin_amdgcn_s_waitcnt(0);
        unsigned nloc = b.st[0], nx = b.st[1];
        if (nloc == 0u) { xcd_barrier_complete(bar, bx, nloc, nx); b.st[0] = nloc; b.st[1] = nx; }
        const unsigned old = xb_add(&bar[XB_XSUB(bx)], 1u);
        const unsigned gen = old / nloc;
        if (old + 1u == (gen + 1u) * nloc) {
            __builtin_amdgcn_fence(__ATOMIC_RELEASE, "agent");
            asm volatile("s_waitcnt vmcnt(0)" ::: "memory");
            const unsigned og = xb_add(&bar[XB_TOP], 1u);
            const unsigned tg = og / nx;
            if (og + 1u == (tg + 1u) * nx) xb_add(&bar[XB_TOPGEN], 1u);
            else XB_SPIN(xb_ld(&bar[XB_TOPGEN]) == tg, bar);
            __builtin_amdgcn_fence(__ATOMIC_ACQUIRE, "agent");
            xb_add(&bar[XB_XGEN(bx)], 1u);
            asm volatile("s_waitcnt vmcnt(0)" ::: "memory");
        } else {
            XB_SPIN(xb_ld(&bar[XB_XGEN(bx)]) == gen, bar);
            __builtin_amdgcn_fence(__ATOMIC_ACQUIRE, "agent");
            asm volatile("s_waitcnt vmcnt(0)" ::: "memory");
        }
    }
    __syncthreads();
}

namespace pg8 {
constexpr int BM = 256, BK = 64, HALF = 128, HTB = HALF * BK * 2, STAGE_BYTES = 8 * HTB, NXCD = 8, WGM = 4;
__device__ __forceinline__ int lds_byte(int r, int c) { const int st = (r >> 4) * 2 + (c >> 5), rr = r & 15, cc = c & 31, ob = rr * 64 + cc * 2; return st * 1024 + (ob ^ (((ob >> 9) & 1) << 5)); }
__device__ __forceinline__ void stage_rc(int b, int& R, int& C) { const int st = b / 1024, sb = b % 1024, swz = sb ^ (((sb >> 9) & 1) << 5); R = (st >> 1) * 16 + swz / 64; C = (st & 1) * 32 + (swz % 64) / 2; }
__device__ __forceinline__ int perm32(int rho) { const int n = rho >> 4, i = rho & 15; return 8 * (i >> 2) + 4 * n + (i & 3); }

struct Unit { int pm, pn, ak, bk, nt, slab; };
struct Gemm { const bf16_t* A; const bf16_t* Bt; int lda, ldb, K; };

struct StaticOrder {
    int nM, nN, nwg, G, c, pool, split, ntFull;
    __device__ __forceinline__ void init(int nM_, int nN_, int G_, int c_, int pool_, int split_, int K_) { nM = nM_; nN = nN_; nwg = nM * nN; G = G_; c = c_; pool = pool_; split = split_; ntFull = K_ / BK; }
    __device__ __forceinline__ void tile2(int L, int& pm, int& pn) const {
        int wgid = L; { const int q = nwg / NXCD, r = nwg % NXCD, xcd = wgid % NXCD, off = wgid / NXCD; wgid = (xcd < r ? xcd * (q + 1) : r * (q + 1) + (xcd - r) * q) + off; }
        const int nig = WGM * nN, gid = wgid / nig, fm = gid * WGM, gsz = (nM - fm) < WGM ? (nM - fm) : WGM;
        pm = fm + ((wgid % nig) % gsz); pn = (wgid % nig) / gsz;
    }
    __device__ __forceinline__ void tile(int L, Unit& u) const { int pm, pn; tile2(L, pm, pn); u.pm = pm; u.pn = pn; }
    __device__ __forceinline__ bool next(int i, Unit& u) const {
        if (split) {
            if (i > 1) return false;
            if (i == 0) { const int e = c >> 2, q = c & 3, nq = ((ntFull + 7) >> 3) << 1;
                tile(256 + e, u); u.ak = u.bk = q * nq * BK; u.nt = (q < 3) ? nq : ntFull - 3 * nq; u.slab = c; return true; }
            tile(c, u); u.ak = u.bk = 0; u.nt = ntFull; u.slab = -1; return true;
        }
        const long L = (long)i * G + c; if (L >= nwg) return false;
        tile((int)L, u); u.ak = pool ? (u.pn >> 1) * 512 : 0; u.bk = 0; u.nt = ntFull; u.slab = -1; return true;
    }
};

template <class Epi, bool ALIGN_EPI, int MT, bool W3>
__device__ __forceinline__ void gemm_phase_impl(LAS unsigned char* lds, const Gemm g, const StaticOrder& S, const Epi& E, int wave_) {
    int wid = wave_; asm volatile("" : "+s"(wid)); const int lane = hw_lane(), tid = wid * 64 + lane, wr = wid >> 2, wc = wid & 3, fr = lane & 15, fq = lane >> 4;
    unsigned voffA_, voffB_;
    { int R, C; stage_rc(tid * 16, R, C); const int Rb = Epi::PERM ? ((R & ~31) + perm32(R & 31)) : R;
      voffA_ = (unsigned)(R * g.lda + C) * 2u; voffB_ = (unsigned)(Rb * g.ldb + C) * 2u; }
    const size_t r64voffA = (size_t)64 * g.lda * 2, r64voffB = (size_t)64 * g.ldb * 2; const unsigned vvoffA = voffA_, vvoffB = voffB_;
    const size_t r3voffA = (size_t)128 * g.lda * 2; const unsigned lds3 = 16384u + (unsigned)(wid & 3) * 1024u;
    constexpr int HALF_A = MT * 32, HTA = HALF_A * BK * 2;
    const size_t kstep = (size_t)(BK * 2);
    const size_t hstepA = (size_t)HALF_A * g.lda * 2, hstepB = (size_t)HALF * g.ldb * 2;
    const size_t tstepA = 2 * hstepA, tstepB = 2 * hstepB;
    const unsigned ldsw = (unsigned)wid * 1024u;
    const int aoff = lds_byte(wr * (MT * 16) + fr, fq * 8), boff = lds_byte(wc * 32 + fr, fq * 8);
#define PG8_SA(b, h) (((b) * 2 + (h)) * HTA)
#define PG8_SB(b, h) (4 * HTA + ((b) * 2 + (h)) * HTB)
#define PG8_LD1(gb_, vo_, ldsoff) do { const char* _gb = (gb_); unsigned _vo = (vo_); asm volatile("" : "+s"(_gb), "+v"(_vo)); \
        __builtin_amdgcn_global_load_lds((const GAS unsigned*)(_gb + _vo), (LAS unsigned*)(lds + (ldsoff)), 16, 0, 0); } while (0)
#define PG8_STAGE(bufoff, gbase, voff) do { PG8_LD1((const char*)(gbase), v##voff, (bufoff) + ldsw); PG8_LD1((const char*)(gbase) + r64##voff, v##voff, (bufoff) + ldsw + 8192); } while (0)
#define PG8_STAGE_A(bufoff, gbase) do { PG8_STAGE(bufoff, gbase, voffA); if constexpr (MT == 5 && W3) PG8_LD1((const char*)(gbase) + r3voffA, vvoffA, (bufoff) + lds3); } while (0)
#define PG8_LDA(dst, b, h) do { _Pragma("unroll") for (int m = 0; m < MT; ++m) _Pragma("unroll") for (int k = 0; k < 2; ++k) dst[m][k] = *(const LAS bf16x8*)(lds + PG8_SA(b, h) + aoff + m * 2048 + k * 1024); } while (0)
#define PG8_LDB(dst, b, h) do { _Pragma("unroll") for (int n = 0; n < 2; ++n) _Pragma("unroll") for (int k = 0; k < 2; ++k) dst[n][k] = *(const LAS bf16x8*)(lds + PG8_SB(b, h) + boff + n * 2048 + k * 1024); } while (0)
#define PG8_MMA(ai, bj, At, Bt) do { __builtin_amdgcn_s_setprio(1); _Pragma("unroll") for (int m = 0; m < MT; ++m) _Pragma("unroll") for (int n = 0; n < 2; ++n) _Pragma("unroll") for (int k = 0; k < 2; ++k) \
        acc[ai][bj][m][n] = __builtin_amdgcn_mfma_f32_16x16x32_bf16(Bt[n][k], At[m][k], acc[ai][bj][m][n], 0, 0, 0); __builtin_amdgcn_s_setprio(0); } while (0)
#define PG8_WAIT_V(n) asm volatile("s_waitcnt vmcnt(" #n ")" ::: "memory")
#define PG8_WAIT_V2(n4, n5) do { if constexpr (MT == 5 && W3) PG8_WAIT_V(n5); else PG8_WAIT_V(n4); } while (0)
#define PG8_WAIT_L(n) asm volatile("s_waitcnt lgkmcnt(" #n ")" ::: "memory")
#define PG8_BAR __builtin_amdgcn_s_barrier()
#define PG8_SCHED __builtin_amdgcn_sched_barrier(0)
    Unit cur, nxt; int ui = 0;
    if (!S.next(0, cur)) return;
    f32x4 acc[2][2][MT][2];
    bf16x8 At[MT][2], B0[2][2], B1[2][2];
    const char* cA = (const char*)g.A + (size_t)cur.pm * tstepA + (size_t)cur.ak * 2; const char* cB = (const char*)g.Bt + (size_t)cur.pn * tstepB + (size_t)cur.bk * 2;
    PG8_STAGE(PG8_SB(0, 0), cB, voffB); PG8_STAGE(PG8_SB(0, 1), cB + hstepB, voffB); PG8_STAGE_A(PG8_SA(0, 0), cA); PG8_STAGE_A(PG8_SA(0, 1), cA + hstepA);
    if (wr == 1) PG8_BAR;
    PG8_WAIT_V2(2, 3); PG8_BAR;
    PG8_STAGE(PG8_SB(1, 0), cB + kstep, voffB); PG8_STAGE_A(PG8_SA(1, 0), cA + kstep); PG8_STAGE(PG8_SB(1, 1), cB + hstepB + kstep, voffB);
    PG8_WAIT_V2(6, 7); PG8_BAR;
#pragma unroll
    for (int a = 0; a < 2; ++a)
#pragma unroll
        for (int b = 0; b < 2; ++b)
#pragma unroll
            for (int m = 0; m < MT; ++m)
#pragma unroll
                for (int n = 0; n < 2; ++n) acc[a][b][m][n] = (f32x4){0.f, 0.f, 0.f, 0.f};
    for (;;) {
        const bool has_next = S.next(ui + 1, nxt);
        const char* nA = has_next ? (const char*)g.A + (size_t)nxt.pm * tstepA + (size_t)nxt.ak * 2 : cA; const char* nB = has_next ? (const char*)g.Bt + (size_t)nxt.pn * tstepB + (size_t)nxt.bk * 2 : cB;
        const int nt = cur.nt;
        for (int t = 0; t < nt; t += 2) {
            const bool last = (t == nt - 2);
            const char* a1 = cA + (size_t)(t + 1) * kstep;
            const char* a2 = last ? nA : cA + (size_t)(t + 2) * kstep; const char* b2 = last ? nB : cB + (size_t)(t + 2) * kstep;
            const char* a3 = a2 + kstep; const char* b3 = b2 + kstep;
            PG8_LDB(B0, 0, 0); PG8_LDB(B1, 0, 1); PG8_SCHED; PG8_LDA(At, 0, 0); PG8_STAGE_A(PG8_SA(1, 1), a1 + hstepA);
            PG8_WAIT_V2(8, 10); PG8_WAIT_L(0); PG8_BAR; PG8_MMA(0, 0, At, B0); PG8_MMA(0, 1, At, B1); PG8_BAR; PG8_SCHED;
            PG8_LDA(At, 0, 1); PG8_STAGE(PG8_SB(0, 0), b2, voffB); PG8_STAGE(PG8_SB(0, 1), b2 + hstepB, voffB); PG8_STAGE_A(PG8_SA(0, 0), a2);
            PG8_WAIT_V2(8, 10); PG8_WAIT_L(0); PG8_BAR; PG8_MMA(1, 0, At, B0); PG8_MMA(1, 1, At, B1); PG8_BAR; PG8_SCHED;
            PG8_LDB(B0, 1, 0); PG8_LDB(B1, 1, 1); PG8_SCHED; PG8_LDA(At, 1, 0); PG8_STAGE_A(PG8_SA(0, 1), a2 + hstepA);
            PG8_WAIT_V2(8, 10); PG8_WAIT_L(0); PG8_BAR; PG8_MMA(0, 0, At, B0); PG8_MMA(0, 1, At, B1); PG8_BAR; PG8_SCHED;
            PG8_LDA(At, 1, 1); PG8_STAGE(PG8_SB(1, 0), b3, voffB); PG8_STAGE(PG8_SB(1, 1), b3 + hstepB, voffB); PG8_STAGE_A(PG8_SA(1, 0), a3);
            PG8_WAIT_V2(8, 10); PG8_WAIT_L(0); PG8_BAR; PG8_MMA(1, 0, At, B0); PG8_MMA(1, 1, At, B1); PG8_BAR; PG8_SCHED;
        }
        if constexpr (ALIGN_EPI) { if (wr == 0) PG8_BAR; }
        { const int te = hw_lane(); E(acc, cur, wr, wc, te & 15, (te >> 4) & 3); }
        if (!has_next) break;
#pragma unroll
        for (int a = 0; a < 2; ++a)
#pragma unroll
            for (int b = 0; b < 2; ++b)
#pragma unroll
                for (int m = 0; m < MT; ++m)
#pragma unroll
                    for (int n = 0; n < 2; ++n) acc[a][b][m][n] = (f32x4){0.f, 0.f, 0.f, 0.f};
        cur = nxt; cA = nA; cB = nB; ++ui;
        if constexpr (ALIGN_EPI) { if (wr == 1) PG8_BAR; }
    }
    PG8_WAIT_V(0);
    if constexpr (!ALIGN_EPI) { if (wr == 0) PG8_BAR; }
    PG8_BAR;
#undef PG8_SA
#undef PG8_SB
#undef PG8_STAGE
#undef PG8_LD1
#undef PG8_STAGE_A
#undef PG8_WAIT_V2
#undef PG8_LDA
#undef PG8_LDB
#undef PG8_MMA
#undef PG8_WAIT_V
#undef PG8_WAIT_L
#undef PG8_BAR
#undef PG8_SCHED
}
template <class Epi, bool ALIGN_EPI = true, int MT = 4>
__device__ __forceinline__ void gemm_phase(LAS unsigned char* lds, const Gemm g, const StaticOrder& S, const Epi& E, int wave_) {
    if constexpr (MT == 5) { if (wave_ < 4) gemm_phase_impl<Epi, ALIGN_EPI, 5, true>(lds, g, S, E, wave_); else gemm_phase_impl<Epi, ALIGN_EPI, 5, false>(lds, g, S, E, wave_); }
    else gemm_phase_impl<Epi, ALIGN_EPI, MT, true>(lds, g, S, E, wave_);
}

struct EpiSwiGLU {
    static constexpr bool PERM = true;
    bf16_t* O;
    __device__ __forceinline__ void operator()(const f32x4 (&acc)[2][2][4][2], const Unit& u, int wr, int wc, int fr, int fq) const {
        const int row0 = u.pm * BM + wr * 64 + fr, col0 = u.pn * 128 + wc * 32 + 8 * fq;
#pragma unroll
        for (int ai = 0; ai < 2; ++ai)
#pragma unroll
            for (int m = 0; m < 4; ++m) {
                GAS bf16_t* rowp = (GAS bf16_t*)O + (size_t)(row0 + ai * HALF + m * 16) * DFF + col0;
                float v[8];
#pragma unroll
                for (int n = 0; n < 2; ++n)
#pragma unroll
                    for (int j = 0; j < 4; ++j) { const float gt = acc[ai][0][m][n][j], up = acc[ai][1][m][n][j]; v[n * 4 + j] = (gt * up) * __builtin_amdgcn_rcpf(1.0f + __builtin_amdgcn_exp2f(gt)); }
                u32x4 w; w.x = cvt_pk_bf16(v[0], v[1]); w.y = cvt_pk_bf16(v[2], v[3]); w.z = cvt_pk_bf16(v[4], v[5]); w.w = cvt_pk_bf16(v[6], v[7]);
                *(GAS u32x4*)rowp = w;
            }
    }
};
struct EpiResid {
    static constexpr bool PERM = false;
    float* X; const float* gate; const float* ps; float* slab; unsigned* cnt; float* ssn; float coef; int pad_;
    __device__ __forceinline__ void operator()(const f32x4 (&acc)[2][2][4][2], const Unit& u, int wr, int wc, int fr, int fq) const {
        if (u.slab >= 0) {
            GAS float* sp = (GAS float*)slab + (size_t)u.slab * 65536 + (size_t)(wr * 64 + fr) * 256 + wc * 32 + 4 * fq;
#pragma unroll
            for (int ai = 0; ai < 2; ++ai)
#pragma unroll
                for (int m = 0; m < 4; ++m)
#pragma unroll
                    for (int bj = 0; bj < 2; ++bj)
#pragma unroll
                        for (int n = 0; n < 2; ++n) { GAS float* p = sp + (size_t)(ai * HALF + m * 16) * 256 + bj * HALF + n * 16; const f32x4 v = acc[ai][bj][m][n];
                            asm volatile("global_store_dwordx4 %0, %1, off sc1\n\ts_nop 1" :: "v"(p), "v"(v) : "memory"); }
            asm volatile("s_waitcnt vmcnt(0)" ::: "memory");
            if ((fr | fq) == 0) __hip_atomic_fetch_add(cnt + 64 * (u.slab >> 2), 1u, __ATOMIC_RELAXED, __HIP_MEMORY_SCOPE_AGENT);
            return;
        }
        const int row0 = u.pm * BM + wr * 64 + fr, col0 = u.pn * BM + wc * 32 + 4 * fq;
        const int grp = u.pm < 32 ? 0 : 1 + ((u.pm - 32) >> 2);
        const GAS float* gp = (const GAS float*)gate + (size_t)grp * NMODC + col0;
        f32x4 bv[2][2];
#pragma unroll
        for (int bj = 0; bj < 2; ++bj)
#pragma unroll
            for (int n = 0; n < 2; ++n) { f32x4 t = *(const GAS f32x4*)(gp + bj * HALF + n * 16) * coef; if (ps) t = t * *(const GAS f32x4*)((const GAS float*)ps + col0 + bj * HALF + n * 16); bv[bj][n] = t; }
#pragma unroll
        for (int ai = 0; ai < 2; ++ai)
#pragma unroll
            for (int mp = 0; mp < 2; ++mp) {
                f32x4 xr[2][2][2];
#pragma unroll
                for (int mm = 0; mm < 2; ++mm) { const GAS float* rowp = (const GAS float*)X + (size_t)(row0 + ai * HALF + (2 * mp + mm) * 16) * D + col0;
#pragma unroll
                    for (int bj = 0; bj < 2; ++bj)
#pragma unroll
                        for (int n = 0; n < 2; ++n) xr[mm][bj][n] = *(const GAS f32x4*)(rowp + bj * HALF + n * 16); }
#pragma unroll
                for (int mm = 0; mm < 2; ++mm) { const int m = 2 * mp + mm; const int row = row0 + ai * HALF + m * 16; GAS float* rowp = (GAS float*)X + (size_t)row * D + col0; float sq = 0.f;
#pragma unroll
                    for (int bj = 0; bj < 2; ++bj)
#pragma unroll
                        for (int n = 0; n < 2; ++n) { const f32x4 xn = xr[mm][bj][n] + bv[bj][n] * acc[ai][bj][m][n]; *(GAS f32x4*)(rowp + bj * HALF + n * 16) = xn;
                            sq += (xn.x * xn.x + xn.y * xn.y) + (xn.z * xn.z + xn.w * xn.w); }
                    if (ssn) { sq += __shfl_xor(sq, 16); sq += __shfl_xor(sq, 32); if (fq == 0) atomicAdd((float*)ssn + row, sq); } }
                asm volatile("" ::: "memory");
            }
    }
};
struct EpiResid5 {
    static constexpr bool PERM = true;
    xres_t* X; const float* gate; const float* ps; unsigned long long* ssn; float coef; int pad_;
    __device__ __forceinline__ void operator()(const f32x4 (&acc)[2][2][5][2], const Unit& u, int wr, int wc, int fr, int fq) const {
        asm volatile("" ::: "memory");
        const int rowt = u.pm * 320 + wr * 80, row0 = rowt + fr, col0 = u.pn * BM + wc * 32 + 8 * fq;
        const int rlo = u.pm * 320, rhi = rlo + 319;
        const int g0 = rlo < NCTX ? 0 : 1 + ((rlo - NCTX) >> 10), g1 = rhi < NCTX ? 0 : 1 + ((rhi - NCTX) >> 10);
        const int rb = (g1 == 0) ? (1 << 30) : NCTX + (g1 - 1) * 1024;
        f32x4 bvA[2][2], bvB[2][2];
#pragma unroll
        for (int bj = 0; bj < 2; ++bj)
#pragma unroll
            for (int n = 0; n < 2; ++n) { f32x4 sc = (f32x4){coef, coef, coef, coef}; if (ps) sc = sc * *(const GAS f32x4*)((const GAS float*)ps + col0 + bj * HALF + n * 4);
                bvA[bj][n] = *(const GAS f32x4*)((const GAS float*)gate + (size_t)g0 * NMODC + col0 + bj * HALF + n * 4) * sc;
                bvB[bj][n] = *(const GAS f32x4*)((const GAS float*)gate + (size_t)g1 * NMODC + col0 + bj * HALF + n * 4) * sc; }
#pragma unroll
        for (int pr = 0; pr < 5; ++pr) {
            xraw8 xq[2][2];
#pragma unroll
            for (int mm = 0; mm < 2; ++mm) { const int ai = (2 * pr + mm) / 5, m = (2 * pr + mm) % 5; const GAS xres_t* rowp = (const GAS xres_t*)X + (size_t)(row0 + ai * 160 + m * 16) * D + col0;
#pragma unroll
                for (int bj = 0; bj < 2; ++bj) xq[mm][bj] = ld_x8raw(rowp + bj * HALF); }
#pragma unroll
            for (int mm = 0; mm < 2; ++mm) { const int ai = (2 * pr + mm) / 5, m = (2 * pr + mm) % 5; const int row = row0 + ai * 160 + m * 16; const bool hi = (rowt + ai * 160 + m * 16) >= rb;
                GAS xres_t* rowp = (GAS xres_t*)X + (size_t)row * D + col0; float sq = 0.f;
#pragma unroll
                for (int bj = 0; bj < 2; ++bj) { f32x4 xn[2], xo[2]; unpack_x8(xq[mm][bj], xo[0], xo[1]);
#pragma unroll
                    for (int n = 0; n < 2; ++n) { const f32x4 bv = hi ? bvB[bj][n] : bvA[bj][n]; xn[n] = xo[n] + bv * acc[ai][bj][m][n];
                        sq += (xn[n].x * xn[n].x + xn[n].y * xn[n].y) + (xn[n].z * xn[n].z + xn[n].w * xn[n].w); }
                    st_x8(rowp + bj * HALF, xn[0], xn[1]); }
                if (ssn) { sq += __shfl_xor(sq, 16); sq += __shfl_xor(sq, 32); if (fq == 0) __hip_atomic_fetch_add(ssn + row, (unsigned long long)(sq * 1048576.0f + 0.5f), __ATOMIC_RELAXED, __HIP_MEMORY_SCOPE_AGENT); } }
            asm volatile("" ::: "memory");
        }
    }
};
__device__ __forceinline__ void combine_split(float* X, const float* gate, const float* ps, float coef, const float* slab, unsigned* cnt, const StaticOrder& S, float* ssn) {
    const int c = S.c, e = c >> 2, qr = c & 3; int tid = threadIdx.x;
    int pm, pn; S.tile2(256 + e, pm, pn);
    if (tid < 64) {
        const unsigned long long t0 = __builtin_amdgcn_s_memrealtime();
        while ((unsigned)__builtin_amdgcn_readfirstlane(__hip_atomic_load(cnt + 64 * e, __ATOMIC_RELAXED, __HIP_MEMORY_SCOPE_AGENT)) < 32u) {
            if (__builtin_amdgcn_s_memrealtime() - t0 > 20000000ull) break;
            __builtin_amdgcn_s_sleep(2); }
        __builtin_amdgcn_fence(__ATOMIC_ACQUIRE, "agent");
        asm volatile("s_waitcnt vmcnt(0)" ::: "memory");
    }
    __syncthreads();
    const int grp = pm < 32 ? 0 : 1 + ((pm - 32) >> 2);
    const int cq = (tid & 63) * 4, r0 = tid >> 6;
    f32x4 gv = *(const GAS f32x4*)((const GAS float*)gate + (size_t)grp * NMODC + pn * BM + cq) * coef;
    if (ps) gv = gv * *(const GAS f32x4*)((const GAS float*)ps + pn * BM + cq);
    const GAS float* sp = (const GAS float*)slab + (size_t)(4 * e) * 65536;
#pragma unroll 4
    for (int ps8 = 0; ps8 < 8; ++ps8) {
        const int r = 64 * qr + 8 * ps8 + r0;
        const size_t so = (size_t)r * 256 + cq;
        const f32x4 p0 = *(const GAS f32x4*)(sp + so), p1 = *(const GAS f32x4*)(sp + 65536 + so), p2 = *(const GAS f32x4*)(sp + 2 * 65536 + so), p3 = *(const GAS f32x4*)(sp + 3 * 65536 + so);
        GAS float* xp = (GAS float*)X + (size_t)(pm * BM + r) * D + pn * BM + cq;
        const f32x4 x = *(const GAS f32x4*)xp;
        const f32x4 xn = x + gv * ((p0 + p1) + (p2 + p3));
        *(GAS f32x4*)xp = xn;
        if (ssn) { float sq = (xn.x * xn.x + xn.y * xn.y) + (xn.z * xn.z + xn.w * xn.w);
#pragma unroll
            for (int o = 1; o < 64; o <<= 1) sq += __shfl_xor(sq, o);
            if ((tid & 63) == 0) atomicAdd((float*)ssn + pm * BM + r, sq); }
    }
}
struct EpiProj {
    static constexpr bool PERM = true;
    bf16_t* P; float* AB;
    __device__ __forceinline__ void operator()(const f32x4 (&acc)[2][2][4][2], const Unit& u, int wr, int wc, int fr, int fq) const {
        const int row0 = u.pm * BM + wr * 64 + fr;
        if (u.pn < 32) {
            const int col0 = u.pn * BM + wc * 32 + 8 * fq;
#pragma unroll
            for (int ai = 0; ai < 2; ++ai)
#pragma unroll
                for (int m = 0; m < 4; ++m) { GAS bf16_t* rowp = (GAS bf16_t*)P + (size_t)(row0 + ai * HALF + m * 16) * 8192 + col0;
#pragma unroll
                    for (int bj = 0; bj < 2; ++bj) { const f32x4 v0 = acc[ai][bj][m][0], v1 = acc[ai][bj][m][1];
                        u32x4 w; w.x = cvt_pk_bf16(v0[0], v0[1]); w.y = cvt_pk_bf16(v0[2], v0[3]); w.z = cvt_pk_bf16(v1[0], v1[1]); w.w = cvt_pk_bf16(v1[2], v1[3]);
                        *(GAS u32x4*)(rowp + bj * HALF) = w; } }
        } else if (wc < 2) {
            const int col0 = wc * 32 + 8 * fq;
#pragma unroll
            for (int ai = 0; ai < 2; ++ai)
#pragma unroll
                for (int m = 0; m < 4; ++m) { GAS float* rowp = (GAS float*)AB + (size_t)(row0 + ai * HALF + m * 16) * 64 + col0;
                    *(GAS f32x4*)rowp = acc[ai][0][m][0]; *(GAS f32x4*)(rowp + 4) = acc[ai][0][m][1]; }
        }
    }
};
}

struct Args {
    const float* x_prompt; const float* x_sample; const float* state_gdn; const float* c; const float* c_ctx;
    const float* w_mod; const float* b_mod; const float* norm_g; const float* ffn_w_in; const float* ffn_w_out;
    const float* gdn_w_in; const float* gdn_conv; const float* gdn_a_log; const float* gdn_dt_bias; const float* gdn_norm_g; const float* gdn_w_out;
    const float* pool_w; const float* pool_scale; const float* final_g;
    float* out; unsigned char* ws;
};

struct Frame {
    LAS unsigned char* lds;
    int tid, lane, wave, vcu, G;
};

#define OPAQUE_FRAME(F) Frame F = F##_in; asm volatile("" : "+s"(F.vcu), "+s"(F.wave) :: "memory"); F.lane = hw_lane(); F.tid = F.wave * 64 + F.lane
__device__ __forceinline__ void transpose_item(const float* src, int ld_src, int k0, int n0s, int nvalid, bf16_t* dst, int ld_dst, int n0d, LAS unsigned char* scr, int lane, float scale) {
    const int nq = lane & 31, kh = lane >> 5;
    const int nqc = (4 * nq < nvalid) ? nq : 0;
    const char* sb = (const char*)src + ((size_t)k0 * ld_src + n0s) * 4; const unsigned voff = ((unsigned)(32 * kh) * (unsigned)ld_src + 4u * (unsigned)nqc) * 4u;
    f32x4 tv[32];
#pragma unroll
    for (int i = 0; i < 32; ++i) { const char* bi = sb + (size_t)i * ld_src * 4; unsigned vo = voff; asm volatile("" : "+s"(bi), "+v"(vo));
        tv[i] = __builtin_nontemporal_load((const GAS f32x4*)(bi + vo)); }
#pragma unroll
    for (int c = 0; c < 4; ++c) { LAS unsigned char* wr = scr + (c * 32 + nq) * 144 + 64 * kh;
#pragma unroll
        for (int g = 0; g < 4; ++g) { u32x4 o; o.x = cvt_pk_bf16(tv[8 * g + 0][c] * scale, tv[8 * g + 1][c] * scale); o.y = cvt_pk_bf16(tv[8 * g + 2][c] * scale, tv[8 * g + 3][c] * scale); o.z = cvt_pk_bf16(tv[8 * g + 4][c] * scale, tv[8 * g + 5][c] * scale); o.w = cvt_pk_bf16(tv[8 * g + 6][c] * scale, tv[8 * g + 7][c] * scale);
            *(LAS u32x4*)(wr + 16 * g) = o; } }
    LDS_WAIT(); asm volatile("" ::: "memory");
#pragma unroll
    for (int t = 0; t < 16; ++t) { const int q = lane + 64 * t, r = q >> 3, ch = q & 7, nl = 4 * (r & 31) + (r >> 5);
        const u32x4 o = *(const LAS u32x4*)(scr + r * 144 + 16 * ch);
        if (nl < nvalid) __builtin_nontemporal_store(o, (GAS u32x4*)((GAS bf16_t*)dst + (size_t)(n0d + nl) * ld_dst + k0 + 8 * ch)); }
    LDS_WAIT(); asm volatile("" ::: "memory");
}

__device__ __forceinline__ void sincos_small(float x, float& s, float& c) {
    const float k = rintf(x * 0.636619772367581f);
    float y = fmaf(k, -1.57079637050628662109375f, x); y = fmaf(k, 4.37113882867379e-8f, y);
    const float y2 = y * y;
    float sp = fmaf(y2, 2.7557319e-6f, -1.9841270e-4f); sp = fmaf(sp, y2, 8.3333333e-3f); sp = fmaf(sp, y2, -1.6666667e-1f); sp = fmaf(sp * y2, y, y);
    float cp = fmaf(y2, -2.7557319e-7f, 2.4801587e-5f); cp = fmaf(cp, y2, -1.3888889e-3f); cp = fmaf(cp, y2, 4.1666667e-2f); cp = fmaf(cp, y2, -0.5f); cp = fmaf(cp, y2, 1.0f);
    const int q = ((int)k) & 3;
    s = (q == 0) ? sp : (q == 1) ? cp : (q == 2) ? -sp : -cp;
    c = (q == 0) ? cp : (q == 1) ? -sp : (q == 2) ? -cp : sp;
}

#ifndef PRO_SKIP
#define PRO_SKIP 5
#endif
#ifndef TAIL_NA
#define TAIL_NA 4
#endif
#ifndef TAIL_NC
#define TAIL_NC 4
#endif
constexpr int SEQ_TOTAL = 38560;
constexpr int CAPG = 576 * TAIL_NA, CAPC = 1728 * TAIL_NC;
constexpr int slot_cap(int j) { return (j == 1 || j == 6) ? CAPC : CAPG; }
constexpr int seq_need(int i) { return i == 0 ? 2752 : i == 1 ? 6256 : i == 2 ? 9520 : i == 3 ? 13648 : i == 4 ? 17904 : i == 5 ? 22032 : i == 6 ? 25536 : i == 7 ? 28800 : i == 8 ? 32928 : i == 9 ? 37184 : 38560; }
constexpr int seq_p0() { int p0 = 0, caps = 0; for (int i = 0; i <= 10; ++i) { const int v = seq_need(i) - caps; if (v > p0) p0 = v; if (i < 10) caps += slot_cap(i); } return p0; }
constexpr int SEQ_P0 = seq_p0();
__device__ __forceinline__ int slot_start(int j) { const int nc = (j > 1) + (j > 6); return SEQ_P0 + (j - nc) * CAPG + nc * CAPC; }
__device__ __forceinline__ void convert_seq_item(const Args& a, unsigned char* ws, LAS unsigned char* scr, int lane, int s) {
    const int L = (s >= 30176) ? 3 : (s >= 19280) ? 2 : (s >= 10896) ? 1 : 0;
    int it = s - ((L == 3) ? 30176 : (L == 2) ? 19280 : (L == 1) ? 10896 : 0);
    const int MS = (L & 1) ? 128 : 2640, mi = L >> 1;
    const float* src; bf16_t* dst; int ld_src, ld_dst, k0, n0s, n0d, nvalid = 128; float scale = 1.0f;
    if (it >= 4128 && it < 4128 + MS) {
        it -= 4128;
        if (L & 1) { const int gi = it >> 5, kb = (it & 31) >> 2, nb = it & 3;
            src = a.pool_w + (size_t)(mi * 4 + gi) * 512 * 512; ld_src = 512; k0 = 64 * kb; n0s = 128 * nb; dst = (bf16_t*)(ws + WS_BTP + mi * SZ_BTP); ld_dst = 512; n0d = gi * 512 + 128 * nb; }
        else if (it < 2080) { const int kb = it / 65, nb = it % 65;
            src = a.gdn_w_in + (size_t)mi * D * NPROJ; ld_src = NPROJ; k0 = 64 * kb; n0s = 128 * nb; dst = (bf16_t*)(ws + WS_BTG + mi * SZ_BTG); ld_dst = D; n0d = 128 * nb; nvalid = (nb == 64) ? 64 : 128; }
        else if (it < 2128) { it -= 2080;
#pragma unroll
            for (int rr = 0; rr < 4; ++rr) { GAS u32x4* p = (GAS u32x4*)((GAS bf16_t*)(ws + WS_BTG + mi * SZ_BTG) + (size_t)(NPROJ + 4 * it + rr) * D) + lane;
#pragma unroll
                for (int j = 0; j < 4; ++j) p[64 * j] = (u32x4){0u, 0u, 0u, 0u}; }
            return; }
        else { it -= 2128; const int kb = it >> 4, nb = it & 15;
            src = a.gdn_w_out + (size_t)mi * D * D; ld_src = D; k0 = 64 * kb; n0s = 128 * nb; dst = (bf16_t*)(ws + WS_BTO + mi * SZ_BTO); ld_dst = D; n0d = 128 * nb; }
    } else {
        int f = 0; if (it >= 4128) { it -= 4128 + MS; f = 1; }
        const int mt = 2 * L + f;
        if (it < 2752) { const int kb = it / 86, nb = it % 86;
            src = a.ffn_w_in + (size_t)mt * D * NGU; ld_src = NGU; k0 = 64 * kb; n0s = 128 * nb; dst = (bf16_t*)(ws + WS_BT1 + mt * SZ_BT1); ld_dst = D; n0d = (nb < 43) ? 256 * nb : 256 * (nb - 43) + 128;
            scale = (nb < 43) ? -1.4426950408889634f : -0.6931471805599453f; }
        else { it -= 2752; const int kb = it >> 4, nb = it & 15;
            src = a.ffn_w_out + (size_t)mt * DFF * D; ld_src = D; k0 = 64 * kb; n0s = 128 * nb; dst = (bf16_t*)(ws + WS_BT2 + mt * SZ_BT2); ld_dst = DFF; n0d = 128 * nb; }
    }
    transpose_item(src, ld_src, k0, n0s, nvalid, dst, ld_dst, n0d, scr, lane, scale);
}
__device__ __forceinline__ void tail_convert(const Frame& F_in, const Args& a, int first, int n_per_wave, int wrank, int nw) {
    OPAQUE_FRAME(F);
    __syncthreads();
    LAS unsigned char* scr = F.lds + F.wave * 18432;
    for (int k = 0; k < n_per_wave; ++k) { const int s = first + wrank + nw * k; if (s < SEQ_TOTAL) convert_seq_item(a, a.ws, scr, F.lane, s); }
}
__device__ __forceinline__ void prologue_a(const Frame& F_in, const Args& a) {
    OPAQUE_FRAME(F);
    unsigned char* ws = a.ws;
    LAS unsigned char* scr = F.lds + F.wave * 18432;
    LAS float* sv = (LAS float*)(F.lds + 69632);
    for (int i = F.tid; i < 3 * D; i += NWAVES * 64) { const int g = i / D, k = i % D; const float v = (g == 0) ? a.c_ctx[k] : a.c[(g - 1) * D + k]; sv[i] = v / (1.0f + expf(-v)); }
    __syncthreads();
    const int gw = F.vcu * NWAVES + F.wave, NGW = F.G * NWAVES;
    for (int t = gw; t < 4 * 72 * 8; t += NGW) {
        const int l = t / 576, rem = t % 576, cb = rem >> 3, ks = rem & 7;
        const GAS float* wp = (const GAS float*)a.w_mod + ((size_t)l * D + ks * 256) * NMODC + cb * 256 + F.lane * 4;
        f32x4 acc0 = {0.f, 0.f, 0.f, 0.f}, acc1 = acc0, acc2 = acc0;
        const LAS float* s0 = sv + ks * 256, *s1 = sv + D + ks * 256, *s2 = sv + 2 * D + ks * 256;
#pragma unroll 8
        for (int k = 0; k < 256; ++k) { const f32x4 w = __builtin_nontemporal_load((const GAS f32x4*)(wp + (size_t)k * NMODC)); acc0 += w * s0[k]; acc1 += w * s1[k]; acc2 += w * s2[k]; }
        GAS float* pp = (GAS float*)(ws + WS_MODP) + ((size_t)(ks * 4 + l) * 3) * NMODC + cb * 256 + F.lane * 4;
        *(GAS f32x4*)pp = acc0; *(GAS f32x4*)(pp + NMODC) = acc1; *(GAS f32x4*)(pp + 2 * NMODC) = acc2;
    }
    for (int m = gw; m < MTOK; m += NGW) {
        GAS xres_t* xo = (GAS xres_t*)(ws + WS_X) + (size_t)m * D + 4 * F.lane;
        if (m < NCTX) { const GAS f32x4* xi = (const GAS f32x4*)a.x_prompt + (size_t)m * (D / 4) + F.lane;
#pragma unroll
            for (int j = 0; j < 8; ++j) st_x4(xo + 256 * j, xi[64 * j]);
        } else {
            const int tok = (m - NCTX) & (DSEQ - 1); const float rr = (float)(tok >> 6), cc = (float)(tok & 63);
            const GAS f32x4* xi = (const GAS f32x4*)a.x_sample + (size_t)(m - NCTX) * (D / 4) + F.lane;
#pragma unroll
            for (int j = 0; j < 8; ++j) { f32x4 v = xi[64 * j]; const int e0 = 4 * (F.lane + 64 * j), qd = e0 >> 9, f0 = e0 & 511; const float pos = (qd < 2) ? rr : cc;
#pragma unroll
                for (int i = 0; i < 4; ++i) { const float fr = expf(-9.210340371976184f * (float)(f0 + i) * (1.0f / 512.0f)); float s, c; sincos_small(pos * fr, s, c); v[i] += (qd & 1) ? c : s; }
                st_x4(xo + 256 * j, v); }
        }
    }
    __syncthreads();
    { const int p0 = (F.G == 256) ? SEQ_P0 : SEQ_TOTAL;
      if (F.G == 256) { for (int i = 0; ; ++i) { int s; if (i < PRO_SKIP) { if (gw < 256) continue; s = i * 1792 + gw - 256; } else s = PRO_SKIP * 1792 + (i - PRO_SKIP) * 2048 + gw; if (s >= p0) break; convert_seq_item(a, ws, scr, F.lane, s); } }
      else for (int s = gw; s < p0; s += NGW) convert_seq_item(a, ws, scr, F.lane, s); }
}
__device__ __forceinline__ void prologue_b(const Frame& F_in, const Args& a) {
    OPAQUE_FRAME(F);
    const GAS float* pp = (const GAS float*)(a.ws + WS_MODP); GAS float* mo = (GAS float*)(a.ws + WS_MODS);
    for (int i = F.vcu * 512 + F.tid; i < 4 * 3 * NMODC; i += F.G * 512) {
        const int l = i / (3 * NMODC), n = i % NMODC; float s = a.b_mod[l * NMODC + n];
#pragma unroll
        for (int ks = 0; ks < 8; ++ks) s += pp[(size_t)ks * (4 * 3 * NMODC) + i];
        mo[i] = s;
    }
}

__device__ __forceinline__ void norm_phase(const Frame& F_in, const Args& a, const float* ng, const float* modbase  , int s) {
    OPAQUE_FRAME(F);
    const int gw = F.vcu * NWAVES + F.wave, NGW = F.G * NWAVES;
    const GAS f32x4* g4 = (const GAS f32x4*)ng + F.lane;
    f32x4 gg[8];
#pragma unroll
    for (int j = 0; j < 8; ++j) gg[j] = g4[64 * j];
    for (int m = gw; m < MTOK; m += NGW) {
        const int grp = m < NCTX ? 0 : 1 + ((m - NCTX) >> 10);
        const GAS xres_t* xr = (const GAS xres_t*)(a.ws + WS_X) + (size_t)m * D + 4 * F.lane;
        const GAS f32x4* sh = (const GAS f32x4*)((const GAS float*)modbase + (size_t)grp * NMODC + (3 * s) * D) + F.lane;
        const GAS f32x4* sc = sh + D / 4;
        f32x4 v[8], s0[8], s1[8]; float ss = 0.f;
#pragma unroll
        for (int j = 0; j < 8; ++j) { v[j] = ld_x4(xr + 256 * j); s0[j] = sh[64 * j]; s1[j] = sc[64 * j]; }
        __builtin_amdgcn_sched_barrier(0);
#pragma unroll
        for (int j = 0; j < 8; ++j) ss += (v[j].x * v[j].x + v[j].y * v[j].y) + (v[j].z * v[j].z + v[j].w * v[j].w);
        const float r = rsqrt_f(wave_sum(ss) * (1.0f / D) + RMS_EPS);
        GAS u32x2* o = (GAS u32x2*)((GAS bf16_t*)(a.ws + WS_H) + (size_t)m * D) + F.lane;
#pragma unroll
        for (int j = 0; j < 8; ++j) { const f32x4 h = (v[j] * r * gg[j]) * (s1[j] + 1.0f) + s0[j];
            u32x2 w; w.x = cvt_pk_bf16(h.x, h.y); w.y = cvt_pk_bf16(h.z, h.w); o[64 * j] = w; }
    }
}
__device__ __forceinline__ void final_phase(const Frame& F_in, const Args& a) {
    OPAQUE_FRAME(F);
    const int gw = F.vcu * NWAVES + F.wave, NGW = F.G * NWAVES;
    const GAS f32x4* g4 = (const GAS f32x4*)a.final_g + F.lane;
    f32x4 gg[8];
#pragma unroll
    for (int j = 0; j < 8; ++j) gg[j] = g4[64 * j];
    for (int m = gw; m < MTOK; m += NGW) {
        const GAS xres_t* xr = (const GAS xres_t*)(a.ws + WS_X) + (size_t)m * D + 4 * F.lane;
        f32x4 v[8]; float ss = 0.f;
#pragma unroll
        for (int j = 0; j < 8; ++j) { v[j] = ld_x4(xr + 256 * j); ss += (v[j].x * v[j].x + v[j].y * v[j].y) + (v[j].z * v[j].z + v[j].w * v[j].w); }
        const float r = rsqrt_f(wave_sum(ss) * (1.0f / D) + RMS_EPS);
        GAS f32x4* o = (GAS f32x4*)a.out + (size_t)m * (D / 4) + F.lane;
#pragma unroll
        for (int j = 0; j < 8; ++j) o[64 * j] = v[j] * r * gg[j];
    }
}
__device__ __forceinline__ void rstd_phase(const Frame& F_in, const Args& a) {
    OPAQUE_FRAME(F);
    const int gw = F.vcu * NWAVES + F.wave, NGW = F.G * NWAVES;
    for (int m = gw; m < MTOK; m += NGW) {
        const GAS xres_t* xr = (const GAS xres_t*)(a.ws + WS_X) + (size_t)m * D + 4 * F.lane;
        float ss = 0.f;
#pragma unroll
        for (int j = 0; j < 8; ++j) { const f32x4 v = ld_x4(xr + 256 * j); ss += (v.x * v.x + v.y * v.y) + (v.z * v.z + v.w * v.w); }
        const float r = rsqrt_f(wave_sum(ss) * (1.0f / D) + RMS_EPS);
        if (F.lane == 0) __hip_atomic_store((GAS float*)(a.ws + WS_RSTD) + m, r, __ATOMIC_RELAXED, __HIP_MEMORY_SCOPE_AGENT);
    }
}
template <int HALFW>
__device__ __forceinline__ void pool_task(const GAS xres_t* X, const GAS unsigned long long* RS, GAS bf16_t* Hout, int r0, int s0, int s1, int col, const f32x4 gs, int lane) {
    constexpr int NR = 16 + 2 * HALFW;
    float rl = 0.f; { const int r = r0 - HALFW + (lane & 31); if ((lane & 31) < NR && r >= s0 && r < s1) rl = rsqrt_f((float)RS[r] * (1.0f / 1048576.0f / D) + RMS_EPS); }
    f32x4 v[NR];
#pragma unroll
    for (int i = 0; i < NR; ++i) { int r = r0 - HALFW + i; r = r < 0 ? 0 : (r > MTOK - 1 ? MTOK - 1 : r);
        v[i] = ld_x4(X + (size_t)r * D + col) * __builtin_bit_cast(float, __builtin_amdgcn_readlane(__builtin_bit_cast(int, rl), i)); }
    f32x4 sum = {0.f, 0.f, 0.f, 0.f};
#pragma unroll
    for (int i = 0; i < 2 * HALFW; ++i) sum += v[i];
#pragma unroll
    for (int t = 0; t < 16; ++t) {
        int lo = r0 + t - HALFW; if (lo < s0) lo = s0; int hi = r0 + t + HALFW; if (hi > s1) hi = s1;
        const float inv = __builtin_amdgcn_rcpf((float)(hi - lo));
        const f32x4 o = gs * (sum * inv - v[t + HALFW]);
        u32x2 w; w.x = cvt_pk_bf16(o.x, o.y); w.y = cvt_pk_bf16(o.z, o.w);
        *(GAS u32x2*)(Hout + (size_t)(r0 + t) * D + col) = w;
        if (t < 15) sum += v[t + 2 * HALFW] - v[t];
    }
}
__device__ __forceinline__ void pool_pre_phase(const Frame& F_in, const Args& a, const float* ng, const float* modbase, const unsigned long long* ss) {
    OPAQUE_FRAME(F);
    const GAS xres_t* X = (const GAS xres_t*)(a.ws + WS_X); const GAS unsigned long long* RS = (const GAS unsigned long long*)ss; GAS bf16_t* Hout = (GAS bf16_t*)(a.ws + WS_H);
    for (int task = F.vcu * 512 + F.tid; task < 640 * 512; task += F.G * 512) {
        const int seg = task >> 9, cq = task & 511, r0 = seg * 16, col = cq * 4, gi = __builtin_amdgcn_readfirstlane(cq >> 7);
        const int s0 = r0 < NCTX ? (r0 & ~(SEQ - 1)) : NCTX + ((r0 - NCTX) & ~(DSEQ - 1));
        const int s1 = s0 + (r0 < NCTX ? SEQ : DSEQ);
        const int grp = r0 < NCTX ? 0 : 1 + ((r0 - NCTX) >> 10);
        const f32x4 gs = *(const GAS f32x4*)((const GAS float*)ng + col) * (*(const GAS f32x4*)((const GAS float*)modbase + (size_t)grp * NMODC + 4 * D + col) + 1.0f);
        if (gi == 0) pool_task<1>(X, RS, Hout, r0, s0, s1, col, gs, F.lane);
        else if (gi == 1) pool_task<2>(X, RS, Hout, r0, s0, s1, col, gs, F.lane);
        else if (gi == 2) pool_task<4>(X, RS, Hout, r0, s0, s1, col, gs, F.lane);
        else pool_task<8>(X, RS, Hout, r0, s0, s1, col, gs, F.lane);
    }
}

__device__ __forceinline__ void gdn_prep_phase(const Frame& F_in, const Args& a, int mi) {
    OPAQUE_FRAME(F);
    const GAS bf16_t* P = (const GAS bf16_t*)(a.ws + WS_P); GAS bf16_t* Q = (GAS bf16_t*)(a.ws + WS_QKV);
    const int ch8 = F.tid & 15, rr = F.tid >> 4;
    if (F.G != 256) {
        for (int unit = F.vcu; unit < 160 * 16; unit += F.G) {
            const int blk = unit >> 4, h = unit & 15, r0 = blk * 64;
            const int s0 = r0 < NCTX ? (r0 & ~(SEQ - 1)) : NCTX + ((r0 - NCTX) & ~(DSEQ - 1)), s1 = s0 + (r0 < NCTX ? SEQ : DSEQ);
            if (F.tid < 128) { const int c = F.tid & 63, dir = F.tid >> 6, tok = r0 + c;
                const GAS float* ab = (const GAS float*)(a.ws + WS_AB) + (size_t)tok * 64 + dir * 32 + h;
                const float xa = ab[0] + a.gdn_dt_bias[(mi * 2 + dir) * 16 + h], xb = ab[16];
                const float sp = softplus_f(xa);
                __hip_atomic_store((GAS float*)(a.ws + WS_GG) + ((size_t)dir * MTOK + tok) * 16 + h, -expf(a.gdn_a_log[(mi * 2 + dir) * 16 + h]) * sp, __ATOMIC_RELAXED, __HIP_MEMORY_SCOPE_AGENT);
                __hip_atomic_store((GAS float*)(a.ws + WS_GB) + ((size_t)dir * MTOK + tok) * 16 + h, 1.0f / (1.0f + expf(-xb)), __ATOMIC_RELAXED, __HIP_MEMORY_SCOPE_AGENT); }
            for (int ten = 0; ten < 3; ++ten) { const int chan = ten * D + h * DKV + ch8 * 8;
                for (int ps = 0; ps < 2; ++ps) { const int tok = r0 + rr + 32 * ps; float acc[8] = {0.f, 0.f, 0.f, 0.f, 0.f, 0.f, 0.f, 0.f};
                    for (int j = 0; j < 5; ++j) { const int t = tok + j - 2; u32x4 u = {0u, 0u, 0u, 0u}; if (t >= s0 && t < s1) u = *(const GAS u32x4*)(P + (size_t)t * 8192 + chan);
                        const GAS f32x4* wp = (const GAS f32x4*)((const GAS float*)a.gdn_conv + ((size_t)mi * 5 + j) * NQKV + chan); const f32x4 w0 = wp[0], w1 = wp[1];
                        acc[0] = fmaf(bf_lo(u.x), w0.x, acc[0]); acc[1] = fmaf(bf_hi(u.x), w0.y, acc[1]); acc[2] = fmaf(bf_lo(u.y), w0.z, acc[2]); acc[3] = fmaf(bf_hi(u.y), w0.w, acc[3]);
                        acc[4] = fmaf(bf_lo(u.z), w1.x, acc[4]); acc[5] = fmaf(bf_hi(u.z), w1.y, acc[5]); acc[6] = fmaf(bf_lo(u.w), w1.z, acc[6]); acc[7] = fmaf(bf_hi(u.w), w1.w, acc[7]); }
                    float ss = 0.f;
                    for (int i = 0; i < 8; ++i) { acc[i] = silu_f(acc[i]); ss += acc[i] * acc[i]; }
                    if (ten < 2) { ss += __shfl_xor(ss, 1); ss += __shfl_xor(ss, 2); ss += __shfl_xor(ss, 4); ss += __shfl_xor(ss, 8);
                        float sc = rsqrt_f(ss + L2_EPS); if (ten == 0) sc *= 0.08838834764831845f;
                        for (int i = 0; i < 8; ++i) acc[i] *= sc; }
                    u32x4 o; o.x = cvt_pk_bf16(acc[0], acc[1]); o.y = cvt_pk_bf16(acc[2], acc[3]); o.z = cvt_pk_bf16(acc[4], acc[5]); o.w = cvt_pk_bf16(acc[6], acc[7]);
                    *(GAS u32x4*)(Q + (size_t)tok * NQKV + chan) = o; } } }
        return;
    }
    const int h = F.vcu & 15, b0 = F.vcu >> 4;
    LAS float* wl = (LAS float*)F.lds;
    for (int i = F.tid; i < 3 * 5 * 128; i += NWAVES * 64) { const int ten = i / 640, j = (i % 640) >> 7, c = i & 127; wl[i] = a.gdn_conv[((size_t)mi * 5 + j) * NQKV + ten * D + h * DKV + c]; }
    __syncthreads();
    const float dtb0 = a.gdn_dt_bias[(mi * 2 + 0) * 16 + h], dtb1 = a.gdn_dt_bias[(mi * 2 + 1) * 16 + h];
    const float na0 = -expf(a.gdn_a_log[(mi * 2 + 0) * 16 + h]), na1 = -expf(a.gdn_a_log[(mi * 2 + 1) * 16 + h]);
#define PREP_LOAD(dst, hu) do { const int r0_ = (b0 + 16 * ((hu) >> 1)) * 64 + 32 * ((hu) & 1); \
        const int s0_ = r0_ < NCTX ? (r0_ & ~(SEQ - 1)) : NCTX + ((r0_ - NCTX) & ~(DSEQ - 1)), s1_ = s0_ + (r0_ < NCTX ? SEQ : DSEQ); \
        _Pragma("unroll") for (int ten = 0; ten < 3; ++ten) _Pragma("unroll") for (int j = 0; j < 5; ++j) { const int t = r0_ + rr + j - 2; dst[ten][j] = (u32x4){0u, 0u, 0u, 0u}; \
            if (t >= s0_ && t < s1_) dst[ten][j] = *(const GAS u32x4*)(P + (size_t)t * 8192 + ten * D + h * DKV + ch8 * 8); } } while (0)
#define PREP_COMPUTE(srcu, hu) do { const int r0_ = (b0 + 16 * ((hu) >> 1)) * 64 + 32 * ((hu) & 1); const int tok = r0_ + rr; \
        if (F.tid < 64) {     \
            const int c_ = F.tid & 31, dir = F.tid >> 5, tk = r0_ + c_; \
            const GAS float* ab = (const GAS float*)(a.ws + WS_AB) + (size_t)tk * 64 + dir * 32 + h; \
            const float xa = ab[0] + (dir ? dtb1 : dtb0), xb = ab[16]; \
            const float sp = softplus_f(xa); \
            __hip_atomic_store((GAS float*)(a.ws + WS_GG) + ((size_t)dir * MTOK + tk) * 16 + h, (dir ? na1 : na0) * sp, __ATOMIC_RELAXED, __HIP_MEMORY_SCOPE_AGENT); \
            __hip_atomic_store((GAS float*)(a.ws + WS_GB) + ((size_t)dir * MTOK + tk) * 16 + h, 1.0f / (1.0f + expf(-xb)), __ATOMIC_RELAXED, __HIP_MEMORY_SCOPE_AGENT); } \
        _Pragma("unroll") for (int ten = 0; ten < 3; ++ten) { \
            float acc[8] = {0.f, 0.f, 0.f, 0.f, 0.f, 0.f, 0.f, 0.f}; \
            _Pragma("unroll") for (int j = 0; j < 5; ++j) { const u32x4 u = srcu[ten][j]; const LAS f32x4* wp = (const LAS f32x4*)(wl + ten * 640 + j * 128 + ch8 * 8); const f32x4 w0 = wp[0], w1 = wp[1]; \
                acc[0] = fmaf(bf_lo(u.x), w0.x, acc[0]); acc[1] = fmaf(bf_hi(u.x), w0.y, acc[1]); acc[2] = fmaf(bf_lo(u.y), w0.z, acc[2]); acc[3] = fmaf(bf_hi(u.y), w0.w, acc[3]); \
                acc[4] = fmaf(bf_lo(u.z), w1.x, acc[4]); acc[5] = fmaf(bf_hi(u.z), w1.y, acc[5]); acc[6] = fmaf(bf_lo(u.w), w1.z, acc[6]); acc[7] = fmaf(bf_hi(u.w), w1.w, acc[7]); } \
            float ss = 0.f; \
            _Pragma("unroll") for (int i = 0; i < 8; ++i) { acc[i] = silu_f(acc[i]); ss += acc[i] * acc[i]; } \
            if (ten < 2) { ss += __shfl_xor(ss, 1); ss += __shfl_xor(ss, 2); ss += __shfl_xor(ss, 4); ss += __shfl_xor(ss, 8); \
                float sc = rsqrt_f(ss + L2_EPS); if (ten == 0) sc *= 0.08838834764831845f; \
                _Pragma("unroll") for (int i = 0; i < 8; ++i) acc[i] *= sc; } \
            u32x4 o; o.x = cvt_pk_bf16(acc[0], acc[1]); o.y = cvt_pk_bf16(acc[2], acc[3]); o.z = cvt_pk_bf16(acc[4], acc[5]); o.w = cvt_pk_bf16(acc[6], acc[7]); \
            *(GAS u32x4*)(Q + (size_t)tok * NQKV + ten * D + h * DKV + ch8 * 8) = o; } } while (0)
    u32x4 ua[3][5], ub[3][5];
    PREP_LOAD(ua, 0);
    for (int hu = 0; hu < 20; hu += 2) {
        PREP_LOAD(ub, hu + 1);
        PREP_COMPUTE(ua, hu);
        if (hu + 2 < 20) PREP_LOAD(ua, hu + 2);
        PREP_COMPUTE(ub, hu + 1);
    }
#undef PREP_LOAD
#undef PREP_COMPUTE
}
__device__ __forceinline__ void gdn_post_phase(const Frame& F_in, const Args& a, int mi) {
    OPAQUE_FRAME(F);
    const int gw = F.vcu * NWAVES + F.wave, NGW = F.G * NWAVES;
    const GAS bf16_t* O0 = (const GAS bf16_t*)(a.ws + WS_O); const GAS bf16_t* O1 = O0 + (size_t)MTOK * D;
    f32x4 ng[8];
#pragma unroll
    for (int j = 0; j < 8; ++j) ng[j] = *(const GAS f32x4*)((const GAS float*)a.gdn_norm_g + mi * DKV + ((4 * (F.lane + 64 * j)) & 127));
    for (int m = gw; m < MTOK; m += NGW) {
        u32x2 o[8], o1[8]; u32x2 zz[8];
#pragma unroll
        for (int j = 0; j < 8; ++j) { const int e0 = 4 * (F.lane + 64 * j);
            o[j] = *(const GAS u32x2*)(O0 + (size_t)m * D + e0); o1[j] = *(const GAS u32x2*)(O1 + (size_t)m * D + e0);
            zz[j] = *(const GAS u32x2*)((const GAS bf16_t*)(a.ws + WS_P) + (size_t)m * 8192 + NQKV + e0); }
#pragma unroll
        for (int j = 0; j < 8; ++j) { const int e0 = 4 * (F.lane + 64 * j);
            const f32x4 ov = {bf_lo(o[j].x) + bf_lo(o1[j].x), bf_hi(o[j].x) + bf_hi(o1[j].x), bf_lo(o[j].y) + bf_lo(o1[j].y), bf_hi(o[j].y) + bf_hi(o1[j].y)};
            float ss = (ov.x * ov.x + ov.y * ov.y) + (ov.z * ov.z + ov.w * ov.w);
            ss += __shfl_xor(ss, 1); ss += __shfl_xor(ss, 2); ss += __shfl_xor(ss, 4); ss += __shfl_xor(ss, 8); ss += __shfl_xor(ss, 16);
            const float r = rsqrt_f(ss * (1.0f / DKV) + RMS_EPS);
            f32x4 v = ov * r * ng[j]; v.x *= silu_f(bf_lo(zz[j].x)); v.y *= silu_f(bf_hi(zz[j].x)); v.z *= silu_f(bf_lo(zz[j].y)); v.w *= silu_f(bf_hi(zz[j].y));
            u32x2 w; w.x = cvt_pk_bf16(v.x, v.y); w.y = cvt_pk_bf16(v.z, v.w);
            *(GAS u32x2*)((GAS bf16_t*)(a.ws + WS_H) + (size_t)m * D + e0) = w;
        }
    }
}

constexpr int SC_Z = 0, SC_Q = 34816, SC_K = 52224, SC_V = 69632, SC_AKK = 88064, SC_TW = 106496, SC_TU = 115712, SC_AQK = 124928, SC_WN = 134144, SC_G = 151552, SC_XS = 153600, TKS = 272;
__device__ __forceinline__ int off256(int row, int cb) { return row * 272 + cb; }
__device__ __forceinline__ int off128(int row, int cb) { return row * 144 + cb; }
__device__ __forceinline__ bf16x8 ldf256(LAS unsigned char* base, int row0, int ks, int fr, int fq) { return *(const LAS bf16x8*)(base + off256(row0 + fr, 64 * ks + 16 * fq)); }
__device__ __forceinline__ bf16x8 ldf128(LAS unsigned char* base, int row0, int ks, int fr, int fq) { return *(const LAS bf16x8*)(base + off128(row0 + fr, 64 * ks + 16 * fq)); }
__device__ __forceinline__ bf16x8 ldtr256(LAS unsigned char* base, int n0, int ks, int fr, int fq) {
    const int q = fr >> 2, p = fr & 3, r = 32 * ks + 8 * fq + q, cb = 2 * (n0 + 4 * p);
    const bf16x4 lo = __builtin_amdgcn_ds_read_tr16_b64_v4i16((LAS bf16x4*)(base + off256(r, cb)));
    const bf16x4 hi = __builtin_amdgcn_ds_read_tr16_b64_v4i16((LAS bf16x4*)(base + off256(r + 4, cb)));
    return __builtin_shufflevector(lo, hi, 0, 1, 2, 3, 4, 5, 6, 7);
}
#define MFMA16(a, b, c) __builtin_amdgcn_mfma_f32_16x16x32_bf16(a, b, c, 0, 0, 0)

struct ScanPre { u32x4 pq[2], pk[2], pv[2]; float pg, pb; };
__device__ __forceinline__ void scan_item(const Frame& F, const Args& a, int mi, int islat, int b, int h, int dir, ScanPre& P, bool preloaded, int nx_valid, int nx_islat, int nx_b, int nx_h, int nx_dir) {
    LAS unsigned char* L = F.lds;
#define SCAN_BAR() do { asm volatile("s_waitcnt lgkmcnt(0)" ::: "memory"); __builtin_amdgcn_s_barrier(); asm volatile("" ::: "memory"); } while (0)
    const int w = F.wave; const int lane0 = hw_lane(), tid0 = w * 64 + lane0;
    const int T = islat ? DSEQ : SEQ, t0 = islat ? NCTX + b * DSEQ : b * SEQ, nchunk = T / CHUNK;
    const GAS bf16_t* Qc = (const GAS bf16_t*)(a.ws + WS_QKV);
    GAS bf16_t* Og = (GAS bf16_t*)(a.ws + WS_O) + (size_t)dir * MTOK * D;
    const GAS float* GGp = (const GAS float*)(a.ws + WS_GG) + (size_t)dir * MTOK * 16 + h;
    const GAS float* GBp = (const GAS float*)(a.ws + WS_GB) + (size_t)dir * MTOK * 16 + h;
    f32x4 accz[8];
    { const int fr = lane0 & 15, fq = lane0 >> 4;
    if (islat) {
        const GAS float* sp = (const GAS float*)a.state_gdn + ((((size_t)b * 2 + mi) * 2 + dir) * 16 + h) * (DKV * DKV);
#pragma unroll
        for (int dkt = 0; dkt < 8; ++dkt)
#pragma unroll
            for (int r = 0; r < 4; ++r) accz[dkt][r] = sp[(size_t)(16 * dkt + 4 * fq + r) * DKV + 16 * w + fr];
    } else {
#pragma unroll
        for (int dkt = 0; dkt < 8; ++dkt) accz[dkt] = (f32x4){0.f, 0.f, 0.f, 0.f};
    }
#pragma unroll
    for (int dkt = 0; dkt < 8; ++dkt) { u32x2 z; z.x = cvt_pk_bf16(accz[dkt][0], accz[dkt][1]); z.y = cvt_pk_bf16(accz[dkt][2], accz[dkt][3]);
        *(LAS u32x2*)(L + SC_Z + off256(16 * w + fr, 2 * (16 * dkt + 4 * fq))) = z; } }
    u32x4 (&pq)[2] = P.pq; u32x4 (&pk)[2] = P.pk; u32x4 (&pv)[2] = P.pv; float& pg = P.pg; float& pb = P.pb;
#define SCAN_PREFETCH(nn) do { _Pragma("unroll") for (int ps = 0; ps < 2; ++ps) { const int c_ = rr + 32 * ps; const int tok_ = dir ? t0 + T - 1 - (64 * (nn) + c_) : t0 + 64 * (nn) + c_; \
            const GAS bf16_t* src_ = Qc + (size_t)tok_ * NQKV + h * DKV + ch8 * 8; pq[ps] = *(const GAS u32x4*)src_; pk[ps] = *(const GAS u32x4*)(src_ + D); pv[ps] = *(const GAS u32x4*)(src_ + 2 * D); } \
        if (w == 0) { const int tok_ = dir ? t0 + T - 1 - (64 * (nn) + lane) : t0 + 64 * (nn) + lane; pg = GGp[(size_t)tok_ * 16]; pb = GBp[(size_t)tok_ * 16]; } } while (0)
    if (!preloaded) { const int lane = lane0, ch8 = tid0 & 15, rr = tid0 >> 4; SCAN_PREFETCH(0); }
    const int nT = nx_islat ? DSEQ : SEQ, nt0 = nx_islat ? NCTX + nx_b * DSEQ : nx_b * SEQ;
#define SCAN_PREFETCH_NEXT() do { _Pragma("unroll") for (int ps = 0; ps < 2; ++ps) { const int c_ = rr + 32 * ps; const int tok_ = nx_dir ? nt0 + nT - 1 - c_ : nt0 + c_; \
            const GAS bf16_t* src_ = Qc + (size_t)tok_ * NQKV + nx_h * DKV + ch8 * 8; pq[ps] = *(const GAS u32x4*)src_; pk[ps] = *(const GAS u32x4*)(src_ + D); pv[ps] = *(const GAS u32x4*)(src_ + 2 * D); } \
        if (w == 0) { const int tok_ = nx_dir ? nt0 + nT - 1 - lane : nt0 + lane; pg = ((const GAS float*)(a.ws + WS_GG) + (size_t)nx_dir * MTOK * 16 + nx_h)[(size_t)tok_ * 16]; pb = ((const GAS float*)(a.ws + WS_GB) + (size_t)nx_dir * MTOK * 16 + nx_h)[(size_t)tok_ * 16]; } } while (0)

    for (int n = 0; n < nchunk; ++n) {
        LAS unsigned char *bZ = L + SC_Z, *bQ = L + SC_Q, *bK = L + SC_K, *bV = L + SC_V, *bAKK = L + SC_AKK, *bAQK = L + SC_AQK, *bWN = L + SC_WN, *bXS = L + SC_XS, *bG = L + SC_G;
        int lane = lane0, tid = tid0;
        asm volatile("" : "+v"(bZ), "+v"(bQ), "+v"(bK), "+v"(bV), "+v"(bAKK), "+v"(bAQK), "+v"(bWN), "+v"(bXS), "+v"(bG), "+v"(lane), "+v"(tid));
        const int fr = lane & 15, fq = lane >> 4, ch8 = tid & 15, rr = tid >> 4;
        LAS float* gam = (LAS float*)bG; LAS float* bet = gam + 64; LAS float* eg = gam + 128; LAS float* edl = gam + 192; LAS float* fwv = gam + 256; LAS float* fuv = gam + 320;
        if (w == 0) {
            float cs = pg;
#pragma unroll
            for (int o = 1; o < 64; o <<= 1) { const float t = __shfl_up(cs, o); if (lane >= o) cs += t; }
            const float last = __shfl(cs, 63);
            const float e = fast_exp(cs);
            gam[lane] = cs; bet[lane] = pb; eg[lane] = e; edl[lane] = fast_exp(last - cs); fwv[lane] = pb * e; fuv[lane] = pb;
        }
#pragma unroll
        for (int ps = 0; ps < 2; ++ps) { const int o = off256(rr + 32 * ps, ch8 * 16);
            *(LAS u32x4*)(bQ + o) = pq[ps]; *(LAS u32x4*)(bK + o) = pk[ps]; *(LAS u32x4*)(bV + o) = pv[ps]; }
        SCAN_BAR();
        if (n + 1 < nchunk) SCAN_PREFETCH(n + 1); else if (nx_valid) SCAN_PREFETCH_NEXT();
        {
            const int tsel = w >> 2, st = w & 3;
            LAS unsigned char* Bsrc = tsel ? bQ : bK;
            bf16x8 af[4], bfr[4][4];
#pragma unroll
            for (int ks = 0; ks < 4; ++ks) af[ks] = ldf256(bK, 16 * st, ks, fr, fq);
#pragma unroll
            for (int ct = 0; ct < 4; ++ct)
#pragma unroll
                for (int ks = 0; ks < 4; ++ks) bfr[ct][ks] = ldf256(Bsrc, 16 * ct, ks, fr, fq);
            const int s0 = 16 * st + 4 * fq;
            const f32x4 gs4 = *(const LAS f32x4*)(gam + s0);
            float gc[4], bc[4];
#pragma unroll
            for (int ct = 0; ct < 4; ++ct) { gc[ct] = gam[16 * ct + fr]; bc[ct] = bet[16 * ct + fr]; }
            f32x4 acc[4];
#pragma unroll
            for (int ct = 0; ct < 4; ++ct) { acc[ct] = (f32x4){0.f, 0.f, 0.f, 0.f};
#pragma unroll
                for (int ks = 0; ks < 4; ++ks) acc[ct] = MFMA16(af[ks], bfr[ct][ks], acc[ct]); }
#pragma unroll
            for (int ct = 0; ct < 4; ++ct) {
                const int c = 16 * ct + fr;
                f32x4 o;
#pragma unroll
                for (int r = 0; r < 4; ++r) { const int s = s0 + r; const float e = fast_exp(gc[ct] - gs4[r]);
                    const float vq = (c >= s) ? acc[ct][r] * e : 0.f, vk = (c > s) ? bc[ct] * acc[ct][r] * e : 0.f; o[r] = tsel ? vq : vk; }
                if (tsel) { u32x2 wv; wv.x = cvt_pk_bf16(o[0], o[1]); wv.y = cvt_pk_bf16(o[2], o[3]); *(LAS u32x2*)(bAQK + off128(c, 2 * s0)) = wv; }
                else *(LAS f32x4*)(bAKK + c * TKS + s0 * 4) = o;
            }
        }
        SCAN_BAR();
        if (w == 0) {
            const int g = fq, j = fr;
            {
                LAS unsigned char* bb = bAKK + g * (16 * TKS + 64);
                float t[16]; t[0] = 0.f;
#define D1_BATCH(c_lo, c_hi) { f32x4 rv[16][4]; float aj[16]; \
                    _Pragma("unroll") for (int c = c_lo; c < c_hi; ++c) { aj[c] = *(const LAS float*)(bb + c * TKS + j * 4); \
                        _Pragma("unroll") for (int q = 0; q < 4; ++q) if (4 * q < c) rv[c][q] = *(const LAS f32x4*)(bb + c * TKS + q * 16); } \
                    _Pragma("unroll") for (int c = c_lo; c < c_hi; ++c) { float a0 = -aj[c], a1 = 0.f; \
                        _Pragma("unroll") for (int s = 0; s < c; ++s) { if (s & 1) a1 = fmaf(-rv[c][s >> 2][s & 3], t[s], a1); else a0 = fmaf(-rv[c][s >> 2][s & 3], t[s], a0); } \
                        t[c] = a0 + a1; } \
                    asm volatile("" : "+v"(t[c_hi - 1])); }
                D1_BATCH(1, 6) D1_BATCH(6, 11) D1_BATCH(11, 16)
#undef D1_BATCH
#pragma unroll
                for (int c = 0; c < 16; ++c) *(LAS float*)(bb + c * TKS + j * 4) = t[c];
                *(LAS float*)(bb + j * TKS + j * 4) = 1.0f;
            }
#define TA(r_, c_) (*(const LAS float*)(bAKK + (r_) * TKS + (c_) * 4))
#define XSA(r_, c_) (*(LAS float*)(bXS + (r_) * 128 + (c_) * 4))
#define MF32(a_, b_, c_) __builtin_amdgcn_mfma_f32_16x16x4f32(a_, b_, c_, 0, 0, 0)
            {
                f32x4 x0 = {0.f, 0.f, 0.f, 0.f}, x1 = x0;
#pragma unroll
                for (int kk = 0; kk < 4; ++kk) { x0 = MF32(TA(16 + j, 4 * kk + g), TA(4 * kk + g, j), x0); x1 = MF32(TA(48 + j, 32 + 4 * kk + g), TA(32 + 4 * kk + g, 32 + j), x1); }
#pragma unroll
                for (int r = 0; r < 4; ++r) { XSA(4 * g + r, j) = x0[r]; XSA(16 + 4 * g + r, j) = x1[r]; }
                f32x4 y0 = {0.f, 0.f, 0.f, 0.f}, y1 = y0;
#pragma unroll
                for (int kk = 0; kk < 4; ++kk) { y0 = MF32(TA(16 + j, 16 + 4 * kk + g), XSA(4 * kk + g, j), y0); y1 = MF32(TA(48 + j, 48 + 4 * kk + g), XSA(16 + 4 * kk + g, j), y1); }
#pragma unroll
                for (int r = 0; r < 4; ++r) { *(LAS float*)(bAKK + (16 + 4 * g + r) * TKS + j * 4) = -y0[r]; *(LAS float*)(bAKK + (48 + 4 * g + r) * TKS + (32 + j) * 4) = -y1[r]; }
            }
            {
                f32x4 y[2][2];
#pragma unroll
                for (int rt = 0; rt < 2; ++rt)
#pragma unroll
                    for (int ct = 0; ct < 2; ++ct) { y[rt][ct] = (f32x4){0.f, 0.f, 0.f, 0.f};
#pragma unroll
                        for (int kk = 4 * ct; kk < 8; ++kk) y[rt][ct] = MF32(TA(32 + 16 * rt + j, 4 * kk + g), TA(4 * kk + g, 16 * ct + j), y[rt][ct]); }
#pragma unroll
                for (int rt = 0; rt < 2; ++rt)
#pragma unroll
                    for (int ct = 0; ct < 2; ++ct)
#pragma unroll
                        for (int r = 0; r < 4; ++r) XSA(16 * rt + 4 * g + r, 16 * ct + j) = y[rt][ct][r];
                f32x4 z[2][2];
#pragma unroll
                for (int rt = 0; rt < 2; ++rt)
#pragma unroll
                    for (int ct = 0; ct < 2; ++ct) { z[rt][ct] = (f32x4){0.f, 0.f, 0.f, 0.f};
#pragma unroll
                        for (int kk = 0; kk < 4 * (rt + 1); ++kk) z[rt][ct] = MF32(TA(32 + 16 * rt + j, 32 + 4 * kk + g), XSA(4 * kk + g, 16 * ct + j), z[rt][ct]); }
#pragma unroll
                for (int rt = 0; rt < 2; ++rt)
#pragma unroll
                    for (int ct = 0; ct < 2; ++ct)
#pragma unroll
                        for (int r = 0; r < 4; ++r) *(LAS float*)(bAKK + (32 + 16 * rt + 4 * g + r) * TKS + (16 * ct + j) * 4) = -z[rt][ct][r];
            }
#undef TA
#undef XSA
#undef MF32
        }
        SCAN_BAR();
        f32x4 accu[4];
        {
            bf16x8 kt[2], vt[2]; f32x4 tv[4][2][2], fw4[2][2], fu4[2][2];
#pragma unroll
            for (int ks = 0; ks < 2; ++ks) { kt[ks] = ldtr256(bK, 16 * w, ks, fr, fq); vt[ks] = ldtr256(bV, 16 * w, ks, fr, fq);
#pragma unroll
                for (int hh = 0; hh < 2; ++hh) { fw4[ks][hh] = *(const LAS f32x4*)(fwv + 32 * ks + 8 * fq + 4 * hh); fu4[ks][hh] = *(const LAS f32x4*)(fuv + 32 * ks + 8 * fq + 4 * hh); } }
#pragma unroll
            for (int ct = 0; ct < 4; ++ct)
#pragma unroll
                for (int ks = 0; ks < 2; ++ks) { const LAS f32x4* tp = (const LAS f32x4*)(bAKK + (16 * ct + fr) * TKS + (32 * ks + 8 * fq) * 4); tv[ct][ks][0] = tp[0]; tv[ct][ks][1] = tp[1]; }
            f32x4 aw[4];
#pragma unroll
            for (int ct = 0; ct < 4; ++ct) {
                aw[ct] = (f32x4){0.f, 0.f, 0.f, 0.f}; accu[ct] = (f32x4){0.f, 0.f, 0.f, 0.f};
#pragma unroll
                for (int ks = 0; ks < 2; ++ks) {
                    const f32x4 w0 = tv[ct][ks][0] * fw4[ks][0], w1 = tv[ct][ks][1] * fw4[ks][1], u0 = tv[ct][ks][0] * fu4[ks][0], u1 = tv[ct][ks][1] * fu4[ks][1];
                    u32x4 tw, tu; tw.x = cvt_pk_bf16(w0[0], w0[1]); tw.y = cvt_pk_bf16(w0[2], w0[3]); tw.z = cvt_pk_bf16(w1[0], w1[1]); tw.w = cvt_pk_bf16(w1[2], w1[3]);
                    tu.x = cvt_pk_bf16(u0[0], u0[1]); tu.y = cvt_pk_bf16(u0[2], u0[3]); tu.z = cvt_pk_bf16(u1[0], u1[1]); tu.w = cvt_pk_bf16(u1[2], u1[3]);
                    aw[ct] = MFMA16(kt[ks], __builtin_bit_cast(bf16x8, tw), aw[ct]); accu[ct] = MFMA16(__builtin_bit_cast(bf16x8, tu), vt[ks], accu[ct]);
                }
            }
#pragma unroll
            for (int ct = 0; ct < 4; ++ct) { u32x2 wv; wv.x = cvt_pk_bf16(-aw[ct][0], -aw[ct][1]); wv.y = cvt_pk_bf16(-aw[ct][2], -aw[ct][3]);
                *(LAS u32x2*)(bWN + off256(16 * ct + fr, 2 * (16 * w + 4 * fq))) = wv; }
        }
        SCAN_BAR();
        {
            bf16x8 zf[4];
            {
                bf16x8 wf[4][4]; f32x4 ed[4];
#pragma unroll
                for (int ks = 0; ks < 4; ++ks) zf[ks] = ldf256(bZ, 16 * w, ks, fr, fq);
#pragma unroll
                for (int ct = 0; ct < 4; ++ct) { ed[ct] = *(const LAS f32x4*)(edl + 16 * ct + 4 * fq);
#pragma unroll
                    for (int ks = 0; ks < 4; ++ks) wf[ct][ks] = ldf256(bWN, 16 * ct, ks, fr, fq); }
#pragma unroll
                for (int ct = 0; ct < 4; ++ct)
#pragma unroll
                    for (int ks = 0; ks < 4; ++ks) accu[ct] = MFMA16(wf[ct][ks], zf[ks], accu[ct]);
#pragma unroll
                for (int ct = 0; ct < 4; ++ct) {
                    const int c0 = 16 * ct + 4 * fq, dv = 16 * w + fr;
                    u32x2 v1, v2; v1.x = cvt_pk_bf16(accu[ct][0], accu[ct][1]); v1.y = cvt_pk_bf16(accu[ct][2], accu[ct][3]);
                    v2.x = cvt_pk_bf16(accu[ct][0] * ed[ct][0], accu[ct][1] * ed[ct][1]); v2.y = cvt_pk_bf16(accu[ct][2] * ed[ct][2], accu[ct][3] * ed[ct][3]);
                    *(LAS u32x2*)(bV + off128(dv, 2 * c0)) = v1; *(LAS u32x2*)(bAKK + off128(dv, 2 * c0)) = v2;
                }
            }
            f32x4 ao[4];
            {
                bf16x8 qf[4][4]; float egc[4];
#pragma unroll
                for (int ct = 0; ct < 4; ++ct) { egc[ct] = eg[16 * ct + fr];
#pragma unroll
                    for (int ks = 0; ks < 4; ++ks) qf[ct][ks] = ldf256(bQ, 16 * ct, ks, fr, fq); }
#pragma unroll
                for (int ct = 0; ct < 4; ++ct) { ao[ct] = (f32x4){0.f, 0.f, 0.f, 0.f};
#pragma unroll
                    for (int ks = 0; ks < 4; ++ks) ao[ct] = MFMA16(zf[ks], qf[ct][ks], ao[ct]);
                    ao[ct] = ao[ct] * egc[ct]; }
            }
            bf16x8 vd[2];
            {
                bf16x8 vf[2], aq[4][2];
#pragma unroll
                for (int ks = 0; ks < 2; ++ks) { vf[ks] = ldf128(bV, 16 * w, ks, fr, fq); vd[ks] = ldf128(bAKK, 16 * w, ks, fr, fq);
#pragma unroll
                    for (int ct = 0; ct < 4; ++ct) aq[ct][ks] = ldf128(bAQK, 16 * ct, ks, fr, fq); }
#pragma unroll
                for (int ct = 0; ct < 4; ++ct) {
#pragma unroll
                    for (int ks = 0; ks < 2; ++ks) ao[ct] = MFMA16(vf[ks], aq[ct][ks], ao[ct]);
                    const int c = 16 * ct + fr; const int tok = dir ? t0 + T - 1 - (64 * n + c) : t0 + 64 * n + c;
                    { u32x2 ow; ow.x = cvt_pk_bf16(ao[ct][0], ao[ct][1]); ow.y = cvt_pk_bf16(ao[ct][2], ao[ct][3]); *(GAS u32x2*)(Og + (size_t)tok * D + h * DKV + 16 * w + 4 * fq) = ow; }
                }
            }
            {
                const float cdec = eg[63];
                bf16x8 ktr[8][2];
#pragma unroll
                for (int dkt = 0; dkt < 8; ++dkt)
#pragma unroll
                    for (int ks = 0; ks < 2; ++ks) ktr[dkt][ks] = ldtr256(bK, 16 * dkt, ks, fr, fq);
#pragma unroll
                for (int dkt = 0; dkt < 8; ++dkt) {
                    accz[dkt] = accz[dkt] * cdec;
#pragma unroll
                    for (int ks = 0; ks < 2; ++ks) accz[dkt] = MFMA16(ktr[dkt][ks], vd[ks], accz[dkt]);
                }
#pragma unroll
                for (int dkt = 0; dkt < 8; ++dkt) { u32x2 z; z.x = cvt_pk_bf16(accz[dkt][0], accz[dkt][1]); z.y = cvt_pk_bf16(accz[dkt][2], accz[dkt][3]);
                    *(LAS u32x2*)(bZ + off256(16 * w + fr, 2 * (16 * dkt + 4 * fq))) = z; }
            }
        }
        SCAN_BAR();
    }
#undef SCAN_PREFETCH
#undef SCAN_PREFETCH_NEXT
#undef SCAN_BAR
    if (!islat) {
        const int fr = lane0 & 15, fq = lane0 >> 4;
        GAS float* sp = (GAS float*)a.out + (size_t)MTOK * D + ((((size_t)b * 2 + mi) * 2 + dir) * 16 + h) * (DKV * DKV);
#pragma unroll
        for (int dkt = 0; dkt < 8; ++dkt)
#pragma unroll
            for (int r = 0; r < 4; ++r) sp[(size_t)(16 * dkt + 4 * fq + r) * DKV + 16 * w + fr] = accz[dkt][r];
    }
}
__device__ __forceinline__ void gdn_scan_phase(const Frame& F, const Args& a, int mi) {
    const int c = F.vcu;
    const int nit = (F.G == 256) ? (c < 64 ? 2 : 5) : (64 + 1024 - c + F.G - 1) / F.G;
    ScanPre P; P.pg = 0.f; P.pb = 0.f;
    for (int j = 0; j < nit; ++j) {
        int i, in;
        if (F.G == 256) { i = (c < 64) ? (j == 0 ? c : 64 + c) : 64 + 64 + (c - 64) * 5 + j; in = (c < 64) ? 64 + c : i + 1; } else { i = c + j * F.G; in = i + F.G; }
        const int islat = i < 64; const int q = islat ? i : i - 64;
        const int nv = (j + 1 < nit); const int nislat = in < 64; const int qn = nislat ? in : in - 64;
        scan_item(F, a, mi, islat, q >> 5, (q >> 1) & 15, q & 1, P, j > 0, nv, nislat, qn >> 5, (qn >> 1) & 15, qn & 1);
    }
}

__global__ void __launch_bounds__(NWAVES * 64, 2) fwd_kernel(Args a) {
    extern __shared__ __attribute__((aligned(16))) unsigned char lds_raw[];
    Frame F;
    F.lds = (LAS unsigned char*)lds_raw;
    F.tid = threadIdx.x; F.lane = F.tid & 63; F.wave = __builtin_amdgcn_readfirstlane(F.tid >> 6);
    F.G = gridDim.x; { const int bx = blockIdx.x; F.vcu = (F.G % 8 == 0) ? (bx % 8) * (F.G / 8) + bx / 8 : bx; }
    volatile LAS unsigned* MISC = (volatile LAS unsigned*)(F.lds + MISC_OFF);
    for (int u = F.tid; u < (LDS_BYTES - MISC_OFF) / 4; u += NWAVES * 64) MISC[u] = 0u;
    __syncthreads();
    unsigned char* ws = a.ws;
    XcdBarrier bar = xcd_barrier_post((unsigned*)(ws + WS_CTL) + 4096, MISC + 8);
#define GRID_BAR() xcd_barrier(bar, F.wave)
    const float* mods = (const float*)(ws + WS_MODS);

    prologue_a(F, a);
    GRID_BAR();
    prologue_b(F, a);
    GRID_BAR();

    for (int l = 0; l < DEPTH; ++l) {
        const float* modl = mods + (size_t)l * 3 * NMODC;
        const int mi = l >> 1;
        norm_phase(F, a, a.norm_g + (size_t)(l * 3 + 0) * D, modl, 0);
        GRID_BAR();
        { pg8::Gemm g{(const bf16_t*)(ws + WS_H), (const bf16_t*)(ws + WS_BT1 + (size_t)(l * 2 + 0) * SZ_BT1), D, D, D};
          pg8::StaticOrder S; S.init(MTOK / 256, NGU / 256, F.G, (int)blockIdx.x, 0, 0, D);
          pg8::EpiSwiGLU E{(bf16_t*)(ws + WS_ACT)};
          pg8::gemm_phase<pg8::EpiSwiGLU>(F.lds, g, S, E, F.wave); }
        if (F.G == 256 && blockIdx.x >= 184) tail_convert(F, a, slot_start((l >> 1) * 5 + (l & 1) * 3), TAIL_NA, ((int)blockIdx.x - 184) * NWAVES + F.wave, 576);
        GRID_BAR();
        { pg8::Gemm g{(const bf16_t*)(ws + WS_ACT), (const bf16_t*)(ws + WS_BT2 + (size_t)(l * 2 + 0) * SZ_BT2), DFF, DFF, DFF};
          pg8::StaticOrder S; S.init(MTOK / 320, D / 256, F.G, (int)blockIdx.x, 0, 0, DFF);
          unsigned long long* ssn = (l & 1) ? (unsigned long long*)((unsigned*)(ws + WS_CTL) + CW_SS) + (size_t)mi * MTOK : nullptr;
          pg8::EpiResid5 E{(xres_t*)(ws + WS_X), modl + 2 * D, nullptr, ssn, 0.5f, 0};
          pg8::gemm_phase<pg8::EpiResid5, true, 5>(F.lds, g, S, E, F.wave); }
        GRID_BAR();
        if ((l & 1) == 0) {
            norm_phase(F, a, a.norm_g + (size_t)(l * 3 + 1) * D, modl, 1);
            GRID_BAR();
            { pg8::Gemm g{(const bf16_t*)(ws + WS_H), (const bf16_t*)(ws + WS_BTG + (size_t)mi * SZ_BTG), D, D, D};
              pg8::StaticOrder S; S.init(MTOK / 256, NPROJ_PAD / 256, F.G, (int)blockIdx.x, 0, 0, D);
              pg8::EpiProj E{(bf16_t*)(ws + WS_P), (float*)(ws + WS_AB)};
              pg8::gemm_phase<pg8::EpiProj>(F.lds, g, S, E, F.wave); }
            if (F.G == 256 && blockIdx.x >= 40) tail_convert(F, a, slot_start((l >> 1) * 5 + 1), TAIL_NC, ((int)blockIdx.x - 40) * NWAVES + F.wave, 1728);
            GRID_BAR();
            gdn_prep_phase(F, a, mi);
            GRID_BAR();
            gdn_scan_phase(F, a, mi);
            GRID_BAR();
            gdn_post_phase(F, a, mi);
            GRID_BAR();
            { pg8::Gemm g{(const bf16_t*)(ws + WS_H), (const bf16_t*)(ws + WS_BTO + (size_t)mi * SZ_BTO), D, D, D};
              pg8::StaticOrder S; S.init(MTOK / 320, D / 256, F.G, (int)blockIdx.x, 0, 0, D);
              pg8::EpiResid5 E{(xres_t*)(ws + WS_X), modl + 5 * D, nullptr, nullptr, 1.0f, 0};
              pg8::gemm_phase<pg8::EpiResid5, true, 5>(F.lds, g, S, E, F.wave); }
            GRID_BAR();
        } else {
            pool_pre_phase(F, a, a.norm_g + (size_t)(l * 3 + 1) * D, modl, (const unsigned long long*)((const unsigned*)(ws + WS_CTL) + CW_SS) + (size_t)mi * MTOK);
            GRID_BAR();
            { pg8::Gemm g{(const bf16_t*)(ws + WS_H), (const bf16_t*)(ws + WS_BTP + (size_t)mi * SZ_BTP), D, 512, 512};
              pg8::StaticOrder S; S.init(MTOK / 320, D / 256, F.G, (int)blockIdx.x, 1, 0, 512);
              pg8::EpiResid5 E{(xres_t*)(ws + WS_X), modl + 5 * D, a.pool_scale + (size_t)mi * D, nullptr, 1.0f, 0};
              pg8::gemm_phase<pg8::EpiResid5, true, 5>(F.lds, g, S, E, F.wave); }
            GRID_BAR();
        }
        norm_phase(F, a, a.norm_g + (size_t)(l * 3 + 2) * D, modl, 2);
        GRID_BAR();
        { pg8::Gemm g{(const bf16_t*)(ws + WS_H), (const bf16_t*)(ws + WS_BT1 + (size_t)(l * 2 + 1) * SZ_BT1), D, D, D};
          pg8::StaticOrder S; S.init(MTOK / 256, NGU / 256, F.G, (int)blockIdx.x, 0, 0, D);
          pg8::EpiSwiGLU E{(bf16_t*)(ws + WS_ACT)};
          pg8::gemm_phase<pg8::EpiSwiGLU>(F.lds, g, S, E, F.wave); }
        if (F.G == 256 && blockIdx.x >= 184) tail_convert(F, a, slot_start((l >> 1) * 5 + (l & 1) * 3 + ((l & 1) ? 1 : 2)), TAIL_NA, ((int)blockIdx.x - 184) * NWAVES + F.wave, 576);
        GRID_BAR();
        { pg8::Gemm g{(const bf16_t*)(ws + WS_ACT), (const bf16_t*)(ws + WS_BT2 + (size_t)(l * 2 + 1) * SZ_BT2), DFF, DFF, DFF};
          pg8::StaticOrder S; S.init(MTOK / 320, D / 256, F.G, (int)blockIdx.x, 0, 0, DFF);
          pg8::EpiResid5 E{(xres_t*)(ws + WS_X), modl + 8 * D, nullptr, nullptr, 0.5f, 0};
          pg8::gemm_phase<pg8::EpiResid5, true, 5>(F.lds, g, S, E, F.wave); }
        GRID_BAR();
    }
    final_phase(F, a);
}

extern "C" void kernel_launch(void* const* d_in, const int* in_sizes, int n_in, void* d_out, int out_size, void* d_ws, size_t ws_size, hipStream_t stream) {
    static int grid = 0;
    if (grid == 0) {
        if (n_in != 19 || ws_size < WS_END) { fprintf(stderr, "kernel_launch: unexpected n_in %d or ws_size %zu (need %zu)\n", n_in, ws_size, (size_t)WS_END); grid = -1; return; }
        int dev = 0, cus = 0, per_cu = 0;
        if (hipGetDevice(&dev) != hipSuccess || hipDeviceGetAttribute(&cus, hipDeviceAttributeMultiprocessorCount, dev) != hipSuccess) { grid = -1; return; }
        if (hipFuncSetAttribute((const void*)fwd_kernel, hipFuncAttributeMaxDynamicSharedMemorySize, LDS_BYTES) != hipSuccess) { fprintf(stderr, "kernel_launch: hipFuncSetAttribute failed\n"); grid = -1; return; }
        if (hipOccupancyMaxActiveBlocksPerMultiprocessor(&per_cu, (const void*)fwd_kernel, NWAVES * 64, LDS_BYTES) != hipSuccess || per_cu < 1) { fprintf(stderr, "kernel_launch: occupancy query says %d\n", per_cu); }
        (void)hipGetLastError();
        grid = cus;
    }
    if (grid < 0) return;
    (void)hipMemsetAsync((char*)d_ws + WS_CTL, 0, CTL_ZERO_BYTES, stream);
    Args a{};
    a.x_prompt = (const float*)d_in[0]; a.x_sample = (const float*)d_in[1]; a.state_gdn = (const float*)d_in[2]; a.c = (const float*)d_in[3]; a.c_ctx = (const float*)d_in[4];
    a.w_mod = (const float*)d_in[5]; a.b_mod = (const float*)d_in[6]; a.norm_g = (const float*)d_in[7]; a.ffn_w_in = (const float*)d_in[8]; a.ffn_w_out = (const float*)d_in[9];
    a.gdn_w_in = (const float*)d_in[10]; a.gdn_conv = (const float*)d_in[11]; a.gdn_a_log = (const float*)d_in[12]; a.gdn_dt_bias = (const float*)d_in[13]; a.gdn_norm_g = (const float*)d_in[14]; a.gdn_w_out = (const float*)d_in[15];
    a.pool_w = (const float*)d_in[16]; a.pool_scale = (const float*)d_in[17]; a.final_g = (const float*)d_in[18];
    a.out = (float*)d_out; a.ws = (unsigned char*)d_ws;
    hipLaunchKernelGGL(fwd_kernel, dim3(grid), dim3(NWAVES * 64), LDS_BYTES, stream, a);
}
```
